# Optimizing an MI355X kernel written in HIP

```python
import jax
import jax.numpy as jnp
from jax import lax
import numpy as np

D_MODEL = 1024
BATCH = 2
SEQ = 16384
DEPTH = 2

N_A_LAYERS = DEPTH // 2
N_B_LAYERS = DEPTH - N_A_LAYERS
N_DENSE = (DEPTH + 1) // 2
N_MOE = DEPTH // 2

RWKV_HEAD = 64
RWKV_HEADS = D_MODEL // RWKV_HEAD
DECAY_LORA = 64
AAA_LORA = 64
GATE_LORA = 160
LNX_EPS = 64e-5

ATTN_HEAD = 64
GROUP_HEADS = 8
DILATED_GROUPS = ((128, 1), (512, 4), (2048, 16))
N_GROUPS = len(DILATED_GROUPS)
Q_WIDTH = N_GROUPS * GROUP_HEADS * ATTN_HEAD
ATTN_OUT = GROUP_HEADS * ATTN_HEAD
Q_BLOCK = 128
ROPE_THETA = 10000.0

D_FF = 2816
N_EXPERTS = 8
TOP_K = 2
D_FF_EXPERT = 3584
MOE_BLOCK = 256

DEEPNORM_ALPHA = (2 * DEPTH) ** 0.25
DEEPNORM_BETA = (8 * DEPTH) ** -0.25
LN_EPS = 1e-5
SUB_MOD = DEPTH * 2 * 3 * D_MODEL
ADA_WIDTH = SUB_MOD + 2 * D_MODEL

kernel_name = 'yoco_rwkv7_dilated_attn_moe'


def layer_norm(x, g, b):
    xf = x.astype(jnp.float32)
    mu = xf.mean(-1, keepdims=True)
    var = jnp.square(xf - mu).mean(-1, keepdims=True)
    return ((xf - mu) * lax.rsqrt(var + LN_EPS) * g + b).astype(x.dtype)


def rope(t):
    s_len, dh = t.shape[1], t.shape[-1]
    half = dh // 2
    inv_freq = ROPE_THETA ** (-jnp.arange(half, dtype=jnp.float32) / half)
    ang = jnp.arange(s_len, dtype=jnp.float32)[:, None] * inv_freq[None, :]
    cos = jnp.cos(ang)[None, :, None, :]
    sin = jnp.sin(ang)[None, :, None, :]
    tf = t.astype(jnp.float32)
    t1, t2 = tf[..., :half], tf[..., half:]
    return jnp.concatenate([t1 * cos - t2 * sin, t2 * cos + t1 * sin], axis=-1).astype(t.dtype)


def rwkv7_time_mix(h, mu, w_rkv, w0, w1, w2, a0, a1, a2, g1, g2, k_k, k_a, r_k, lnx_g, lnx_b, w_out):
    B, S, D = h.shape
    H, N = RWKV_HEADS, RWKV_HEAD
    xx = jnp.pad(h, ((0, 0), (1, 0), (0, 0)))[:, :-1] - h
    w_lerp = (w_rkv.reshape(D, 3, D) * mu[:3].T[:, :, None]).reshape(D, 3 * D)
    r, k, v = jnp.split(h @ w_rkv + xx @ w_lerp, 3, axis=-1)
    xw = h + xx * mu[3]
    xa = h + xx * mu[4]
    xg = h + xx * mu[5]
    w = -jax.nn.softplus(-(w0 + jnp.tanh(xw @ w1) @ w2)) - 0.5
    a = jax.nn.sigmoid(a0 + (xa @ a1) @ a2)
    g = jax.nn.sigmoid(xg @ g1) @ g2

    def heads(t):
        return t.reshape(B, S, H, N).astype(jnp.float32)

    kk = heads(k * k_k)
    kk = kk / jnp.maximum(jnp.linalg.norm(kk, axis=-1, keepdims=True), 1e-12)
    k = k * (1.0 + (a - 1.0) * k_a)
    rh, kh, vh, ah = heads(r), heads(k), heads(v), heads(a)
    decay = jnp.exp(-jnp.exp(heads(w)))
    seq_in = tuple(jnp.moveaxis(t, 1, 0) for t in (rh, decay, kh, vh, -kk, kk * ah))

    def step(state, inp):
        r_t, w_t, k_t, v_t, a_t, b_t = inp
        sa = jnp.einsum('bhvk,bhk->bhv', state, a_t)
        state = state * w_t[:, :, None, :] + sa[..., None] * b_t[:, :, None, :] + v_t[..., None] * k_t[:, :, None, :]
        return state, jnp.einsum('bhvk,bhk->bhv', state, r_t)

    s0 = jnp.zeros((B, H, N, N), jnp.float32)
    _, y = lax.scan(step, s0, seq_in)
    y = jnp.moveaxis(y, 0, 1)
    mu_y = y.mean(-1, keepdims=True)
    var_y = jnp.square(y - mu_y).mean(-1, keepdims=True)
    y = ((y - mu_y) * lax.rsqrt(var_y + LNX_EPS)).reshape(B, S, D) * lnx_g + lnx_b
    bonus = (rh * kh * r_k).sum(-1, keepdims=True) * vh
    y = y + bonus.reshape(B, S, D)
    return (y * g).astype(h.dtype) @ w_out


def shared_kv(h, w_kv):
    B, S, _ = h.shape
    kv = (h @ w_kv).reshape(B, S, 2, N_GROUPS * GROUP_HEADS, ATTN_HEAD)
    k = rope(kv[:, :, 0]).reshape(B, S, N_GROUPS, GROUP_HEADS, ATTN_HEAD)
    v = kv[:, :, 1].reshape(B, S, N_GROUPS, GROUP_HEADS, ATTN_HEAD)
    return k, v


def dilated_branch(q, k, v, window, dilation):
    B, S, H, Dh = q.shape
    steps = window // dilation
    L = S // dilation
    nb = -(-L // Q_BLOCK)
    Lp = nb * Q_BLOCK

    def by_phase(t):
        t = t.reshape(B, L, dilation, H, Dh).transpose(0, 2, 1, 3, 4)
        t = jnp.pad(t, ((0, 0), (0, 0), (0, Lp - L), (0, 0), (0, 0)))
        return t.reshape(B, dilation, nb, Q_BLOCK, H, Dh)

    def with_prev(t):
        prev = jnp.pad(t, ((0, 0), (0, 0), (1, 0), (0, 0), (0, 0), (0, 0)))[:, :, :nb]
        return jnp.concatenate([prev, t], axis=3)

    qb = by_phase(q)
    kc = with_prev(by_phase(k))
    vc = with_prev(by_phase(v)).astype(jnp.float32)
    s = jnp.einsum('bpnqhd,bpnkhd->bpnhqk', qb, kc).astype(jnp.float32) * (Dh ** -0.5)
    qi = jnp.arange(Q_BLOCK)[:, None] + Q_BLOCK
    ki = jnp.arange(2 * Q_BLOCK)[None, :]
    dist = qi - ki
    band = (dist >= 0) & (dist <= steps)
    valid = (jnp.arange(nb)[:, None] > 0) | (ki >= Q_BLOCK)
    mask = band[None] & valid[:, None, :]
    s = jnp.where(mask[None, None, :, None], s, -jnp.inf)
    m = s.max(-1, keepdims=True)
    e = jnp.exp(s - m)
    l = e.sum(-1, keepdims=True)
    o = jnp.einsum('bpnhqk,bpnkhd->bpnqhd', e, vc) / jnp.swapaxes(l[..., 0], -1, -2)[..., None]
    lse = jnp.swapaxes((m + jnp.log(l))[..., 0], -1, -2)

    def from_phase(t):
        t = t.reshape((B, dilation, Lp) + t.shape[4:])[:, :, :L]
        return jnp.moveaxis(t, 1, 2).reshape((B, S) + t.shape[3:])

    return from_phase(o), from_phase(lse)


def dilated_attention(h, k_sh, v_sh, w_q, w_o):
    B, S, _ = h.shape
    q = rope((h @ w_q).reshape(B, S, N_GROUPS * GROUP_HEADS, ATTN_HEAD))
    q = q.reshape(B, S, N_GROUPS, GROUP_HEADS, ATTN_HEAD)
    outs, lses = [], []
    for gi, (win, dil) in enumerate(DILATED_GROUPS):
        o, lse = dilated_branch(q[:, :, gi], k_sh[:, :, gi], v_sh[:, :, gi], win, dil)
        outs.append(o)
        lses.append(lse)
    wts = jax.nn.softmax(jnp.stack(lses), axis=0)
    o = jnp.sum(wts[..., None] * jnp.stack(outs), axis=0)
    return o.reshape(B, S, ATTN_OUT).astype(h.dtype) @ w_o


def swiglu(h, w_gu, w_down):
    gt, up = jnp.split(h @ w_gu, 2, axis=-1)
    return (jax.nn.silu(gt) * up) @ w_down


def moe_swiglu(h, router, w_gu, w_down):
    B, S, D = h.shape
    T = B * S
    A = T * TOP_K
    ht = h.reshape(T, D)
    logits = (ht @ router).astype(jnp.float32)
    top_logit, top_idx = lax.top_k(logits, TOP_K)
    top_w = jax.nn.softmax(top_logit, axis=-1)
    e_flat = top_idx.reshape(-1)
    t_flat = jnp.repeat(jnp.arange(T, dtype=jnp.int32), TOP_K)
    w_flat = top_w.reshape(-1)
    order = jnp.argsort(e_flat)
    e_sorted = e_flat[order]
    counts = jnp.bincount(e_flat, length=N_EXPERTS)
    padded = (counts + MOE_BLOCK - 1) // MOE_BLOCK * MOE_BLOCK
    start = jnp.cumsum(counts) - counts
    pad_end = jnp.cumsum(padded)
    pad_start = pad_end - padded
    dest = pad_start[e_sorted] + jnp.arange(A) - start[e_sorted]
    n_blocks = -(-A // MOE_BLOCK) + N_EXPERTS
    R = n_blocks * MOE_BLOCK
    row_tok = jnp.full((R,), T, jnp.int32).at[dest].set(t_flat[order])
    row_w = jnp.zeros((R,), jnp.float32).at[dest].set(w_flat[order])
    block_exp = jnp.minimum(jnp.searchsorted(pad_end, jnp.arange(n_blocks) * MOE_BLOCK, side='right'), N_EXPERTS - 1)
    h_pad = jnp.concatenate([ht, jnp.zeros((1, D), ht.dtype)], axis=0)
    xb = h_pad[row_tok].reshape(n_blocks, MOE_BLOCK, D)

    def expert_block(args):
        xe, e = args
        gt, up = jnp.split(xe @ w_gu[e], 2, axis=-1)
        return (jax.nn.silu(gt) * up) @ w_down[e]

    yb = lax.map(expert_block, (xb, block_exp))
    y = yb.reshape(R, D) * row_w[:, None].astype(yb.dtype)
    out = jnp.zeros((T + 1, D), y.dtype).at[row_tok].add(y)[:T]
    return out.reshape(B, S, D)


def setup_inputs(seed: int = 0) -> dict:
    key = jax.random.key(seed)
    k = jax.random.split(key, 30)
    D = D_MODEL
    NA, NB = N_A_LAYERS, N_B_LAYERS

    def nrm(i, shape, scale):
        return jax.random.normal(k[i], shape, jnp.float32) * scale

    def uni(i, shape, lo, hi):
        return jax.random.uniform(k[i], shape, jnp.float32, lo, hi)

    return {
        'x': nrm(0, (BATCH, SEQ, D), 1.0),
        'c': nrm(1, (BATCH, D), 1.0),
        'ada_w': nrm(2, (D, ADA_WIDTH), 0.3 * D ** -0.5),
        'ada_b': nrm(3, (ADA_WIDTH,), 0.01),
        'ln_g': 1.0 + nrm(4, (DEPTH, 2, D), 0.02),
        'ln_b': nrm(5, (DEPTH, 2, D), 0.02),
        'rw_mu': uni(6, (NA, 6, D), 0.0, 1.0),
        'rw_w_rkv': nrm(7, (NA, D, 3 * D), D ** -0.5),
        'rw_w0': uni(8, (NA, D), -6.0, 0.0),
        'rw_w1': nrm(9, (NA, D, DECAY_LORA), D ** -0.5),
        'rw_w2': nrm(10, (NA, DECAY_LORA, D), 0.5 * DECAY_LORA ** -0.5),
        'rw_a0': nrm(11, (NA, D), 0.1),
        'rw_a1': nrm(12, (NA, D, AAA_LORA), D ** -0.5),
        'rw_a2': nrm(13, (NA, AAA_LORA, D), AAA_LORA ** -0.5),
        'rw_g1': nrm(14, (NA, D, GATE_LORA), D ** -0.5),
        'rw_g2': nrm(15, (NA, GATE_LORA, D), GATE_LORA ** -0.5),
        'rw_k_k': 0.85 + nrm(16, (NA, D), 0.05),
        'rw_k_a': 1.0 + nrm(17, (NA, D), 0.05),
        'rw_r_k': nrm(18, (NA, RWKV_HEADS, RWKV_HEAD), 0.1),
        'rw_lnx_g': 1.0 + nrm(19, (NA, D), 0.02),
        'rw_lnx_b': nrm(20, (NA, D), 0.02),
        'rw_w_out': nrm(21, (NA, D, D), DEEPNORM_BETA * D ** -0.5),
        'kv_w': nrm(22, (D, 2 * Q_WIDTH), D ** -0.5),
        'attn_w_q': nrm(23, (NB, D, Q_WIDTH), D ** -0.5),
        'attn_w_o': nrm(24, (NB, ATTN_OUT, D), DEEPNORM_BETA * ATTN_OUT ** -0.5),
        'ffn_w_gu': nrm(25, (N_DENSE, D, 2 * D_FF), D ** -0.5),
        'ffn_w_down': nrm(26, (N_DENSE, D_FF, D), DEEPNORM_BETA * D_FF ** -0.5),
        'moe_router': nrm(27, (N_MOE, D, N_EXPERTS), D ** -0.5),
        'moe_w_gu': nrm(28, (N_MOE, N_EXPERTS, D, 2 * D_FF_EXPERT), D ** -0.5),
        'moe_w_down': nrm(29, (N_MOE, N_EXPERTS, D_FF_EXPERT, D), DEEPNORM_BETA * D_FF_EXPERT ** -0.5),
    }


def reference(x, c, ada_w, ada_b, ln_g, ln_b, rw_mu, rw_w_rkv, rw_w0, rw_w1, rw_w2, rw_a0, rw_a1, rw_a2,
              rw_g1, rw_g2, rw_k_k, rw_k_a, rw_r_k, rw_lnx_g, rw_lnx_b, rw_w_out, kv_w, attn_w_q, attn_w_o,
              ffn_w_gu, ffn_w_down, moe_router, moe_w_gu, moe_w_down):
    b = x.shape[0]
    mod = jax.nn.silu(c) @ ada_w + ada_b
    sub_mod = mod[:, :SUB_MOD].reshape(b, DEPTH, 2, 3, D_MODEL)
    kv_mod = mod[:, SUB_MOD:].reshape(b, 2, D_MODEL)

    def modulate(t, shift, scale):
        return t * (1.0 + scale[:, None, :]) + shift[:, None, :]

    def post_norm(t, y, l, j):
        gate = sub_mod[:, l, j, 2][:, None, :]
        return layer_norm(DEEPNORM_ALPHA * t + (1.0 + gate) * y, ln_g[l, j], ln_b[l, j])

    k_sh, v_sh = None, None
    for l in range(DEPTH):
        h = modulate(x, sub_mod[:, l, 0, 0], sub_mod[:, l, 0, 1])
        if l < N_A_LAYERS:
            i = l
            y = rwkv7_time_mix(h, rw_mu[i], rw_w_rkv[i], rw_w0[i], rw_w1[i], rw_w2[i], rw_a0[i], rw_a1[i],
                               rw_a2[i], rw_g1[i], rw_g2[i], rw_k_k[i], rw_k_a[i], rw_r_k[i], rw_lnx_g[i],
                               rw_lnx_b[i], rw_w_out[i])
        else:
            i = l - N_A_LAYERS
            y = dilated_attention(h, k_sh, v_sh, attn_w_q[i], attn_w_o[i])
        x = post_norm(x, y, l, 0)
        h = modulate(x, sub_mod[:, l, 1, 0], sub_mod[:, l, 1, 1])
        if l % 2 == 0:
            y = swiglu(h, ffn_w_gu[l // 2], ffn_w_down[l // 2])
        else:
            y = moe_swiglu(h, moe_router[l // 2], moe_w_gu[l // 2], moe_w_down[l // 2])
        x = post_norm(x, y, l, 1)
        if l == N_A_LAYERS - 1:
            k_sh, v_sh = shared_kv(modulate(x, kv_mod[:, 0], kv_mod[:, 1]), kv_w)
    return x
```

```cpp
#include <hip/hip_runtime.h>
#include <cstdio>
#include <cstdint>

#define LAS __attribute__((address_space(3)))
#define GAS __attribute__((address_space(1)))
typedef unsigned short bf16_t;
typedef short bf16x8 __attribute__((ext_vector_type(8)));
typedef short s16x4 __attribute__((ext_vector_type(4)));
typedef float f32x4 __attribute__((ext_vector_type(4)));
typedef float f32x2 __attribute__((ext_vector_type(2)));
typedef unsigned u32x4 __attribute__((ext_vector_type(4)));
typedef unsigned u32x2 __attribute__((ext_vector_type(2)));
typedef GAS unsigned gu32;
#define RLX_AGENT __ATOMIC_RELAXED, __HIP_MEMORY_SCOPE_AGENT

__device__ __forceinline__ unsigned cvt_pk_bf16(float lo, float hi) { unsigned r; asm volatile("v_cvt_pk_bf16_f32 %0, %1, %2" : "=v"(r) : "v"(lo), "v"(hi)); return r; }
__device__ __forceinline__ float bflo(unsigned w) { return __uint_as_float(w << 16); }
__device__ __forceinline__ float bfhi(unsigned w) { return __uint_as_float(w & 0xffff0000u); }
__device__ __forceinline__ float sigmoidf_(float x) { return 1.f / (1.f + __expf(-x)); }
__device__ __forceinline__ float tanhf_(float x) { return 1.f - 2.f / (1.f + __expf(2.f * x)); }
__device__ __forceinline__ float siluf_(float x) { return x / (1.f + __expf(-x)); }
__device__ __forceinline__ int ld_i32(const int* p) { return (int)__hip_atomic_load((const unsigned*)p, RLX_AGENT); }

constexpr int BATCH = 2, SEQ = 16384, D = 1024, T = BATCH * SEQ;
constexpr int ADA_W = 14336;
constexpr int DFF = 2816, NEXP = 8, DFE = 3584;
constexpr int QW = 1536, AOUT = 512;
constexpr int RMAX = (T * 2 / 256 + NEXP) * 256;
constexpr int NBLKMAX = RMAX / 256;
constexpr float LN_EPS = 1e-5f, LNX_EPS = 64e-5f;
constexpr float DN_ALPHA = 1.4142135623730951f;

namespace pg8 {
constexpr int BM = 256, BK = 64, HALF = 128, HTB = HALF * BK * 2, STAGE_BYTES = 8 * HTB, NXCD = 8, WGM = 8;
__host__ __device__ __forceinline__ int lds_byte(int r, int c) { const int st = (r >> 4) * 2 + (c >> 5), rr = r & 15, cc = c & 31, ob = rr * 64 + cc * 2; return st * 1024 + (ob ^ (((ob >> 9) & 1) << 5)); }
__host__ __device__ __forceinline__ void stage_rc(int b, int& R, int& C) { const int st = b / 1024, sb = b % 1024, swz = sb ^ (((sb >> 9) & 1) << 5); R = (st >> 1) * 16 + swz / 64; C = (st & 1) * 32 + (swz % 64) / 2; }
__host__ __device__ __forceinline__ int perm32(int rho) { const int n = rho >> 4, i = rho & 15; return 8 * (i >> 2) + 4 * n + (i & 3); }

struct Unit { int pm, pn, z; };
struct Gemm { const bf16_t* A; const bf16_t* Bt; int K, lda; size_t azs, bzs; const int* rowmap; const int* blk_exp; size_t bes; };

struct StaticOrder {
    int nM, nN, nZ, nwg, G, c;
    __device__ void init(int nM_, int nN_, int nZ_, int G_, int c_) { nM = nM_; nN = nN_; nZ = nZ_; nwg = nM * nN; G = G_; c = c_; }
    __device__ bool next(int i, Unit& u) const {
        const long L = (long)i * G + c; if (L >= (long)nwg * nZ) return false;
        u.z = (int)(L / nwg); int wgid = (int)(L % nwg);
        { const int q = nwg / NXCD, r = nwg % NXCD, xcd = wgid % NXCD, off = wgid / NXCD; wgid = (xcd < r ? xcd * (q + 1) : r * (q + 1) + (xcd - r) * q) + off; }
        const int nig = WGM * nN, gid = wgid / nig, fm = gid * WGM, gsz = (nM - fm) < WGM ? (nM - fm) : WGM;
        u.pm = fm + ((wgid % nig) % gsz); u.pn = (wgid % nig) / gsz; return true;
    }
};

#define EPI_LOOP_BEGIN \
    const int row0 = u.pm * BM + wr * 64 + fr, col0 = u.pn * BM + wc * 32 + 8 * fq; \
    _Pragma("unroll") for (int ai = 0; ai < 2; ++ai) _Pragma("unroll") for (int m = 0; m < 4; ++m) { const int row = row0 + ai * HALF + m * 16; \
    _Pragma("unroll") for (int bj = 0; bj < 2; ++bj) { const int col = col0 + bj * HALF; f32x4 v0 = acc[ai][bj][m][0], v1 = acc[ai][bj][m][1];
#define EPI_LOOP_END } }

__device__ __forceinline__ float act_apply(int a, float x) { return a == 1 ? tanhf_(x) : (a == 2 ? sigmoidf_(x) : x); }
template <int ACT0, int ACT1, int ACT2> struct EpiBf16Z {
    static constexpr bool PERM = true;
    bf16_t* O; int ldc; size_t ozs;
    __device__ __forceinline__ void operator()(const f32x4 (&acc)[2][2][4][2], const Unit& u, int wr, int wc, int fr, int fq) const {
        const int a = u.z == 0 ? ACT0 : (u.z == 1 ? ACT1 : ACT2); bf16_t* base = O + (size_t)u.z * ozs;
        EPI_LOOP_BEGIN
            if (a) { _Pragma("unroll") for (int e = 0; e < 4; ++e) { v0[e] = act_apply(a, v0[e]); v1[e] = act_apply(a, v1[e]); } }
            u32x4 w; w.x = cvt_pk_bf16(v0[0], v0[1]); w.y = cvt_pk_bf16(v0[2], v0[3]); w.z = cvt_pk_bf16(v1[0], v1[1]); w.w = cvt_pk_bf16(v1[2], v1[3]);
            *(u32x4*)(base + (size_t)row * ldc + col) = w;
        EPI_LOOP_END
    }
};
struct EpiLora2 {
    static constexpr bool PERM = true;
    float* WLOG; bf16_t* AS; bf16_t* G; const float* w0; const float* a0;
    __device__ __forceinline__ void operator()(const f32x4 (&acc)[2][2][4][2], const Unit& u, int wr, int wc, int fr, int fq) const {
        EPI_LOOP_BEGIN
            if (u.z == 0) {
                const f32x4 b0 = *(const f32x4*)(w0 + col), b1 = *(const f32x4*)(w0 + col + 4);
                _Pragma("unroll") for (int e = 0; e < 4; ++e) {
                    float x = -(v0[e] + b0[e]); float sp = fmaxf(x, 0.f) + __logf(1.f + __expf(-fabsf(x))); v0[e] = -__expf(-sp - 0.5f);
                    x = -(v1[e] + b1[e]); sp = fmaxf(x, 0.f) + __logf(1.f + __expf(-fabsf(x))); v1[e] = -__expf(-sp - 0.5f); }
                float* p = WLOG + (size_t)row * D + col; *(f32x4*)p = v0; *(f32x4*)(p + 4) = v1;
            } else {
                if (u.z == 1) { const f32x4 b0 = *(const f32x4*)(a0 + col), b1 = *(const f32x4*)(a0 + col + 4);
                    _Pragma("unroll") for (int e = 0; e < 4; ++e) { v0[e] = sigmoidf_(v0[e] + b0[e]); v1[e] = sigmoidf_(v1[e] + b1[e]); } }
                u32x4 w; w.x = cvt_pk_bf16(v0[0], v0[1]); w.y = cvt_pk_bf16(v0[2], v0[3]); w.z = cvt_pk_bf16(v1[0], v1[1]); w.w = cvt_pk_bf16(v1[2], v1[3]);
                *(u32x4*)((u.z == 1 ? AS : G) + (size_t)row * D + col) = w;
            }
        EPI_LOOP_END
    }
};
struct EpiF32 {
    static constexpr bool PERM = true;
    float* O; int ldc;
    __device__ __forceinline__ void operator()(const f32x4 (&acc)[2][2][4][2], const Unit& u, int wr, int wc, int fr, int fq) const {
        EPI_LOOP_BEGIN
            float* p = O + (size_t)row * ldc + col; *(f32x4*)p = v0; *(f32x4*)(p + 4) = v1;
        EPI_LOOP_END
    }
};
struct EpiSwiglu {
    static constexpr bool PERM = true;
    bf16_t* O; int ldo;
    __device__ __forceinline__ void operator()(const f32x4 (&acc)[2][2][4][2], const Unit& u, int wr, int wc, int fr, int fq) const {
        EPI_LOOP_BEGIN
            u32x2 w; w.x = cvt_pk_bf16(siluf_(v0[0]) * v0[1], siluf_(v0[2]) * v0[3]); w.y = cvt_pk_bf16(siluf_(v1[0]) * v1[1], siluf_(v1[2]) * v1[3]);
            *(u32x2*)(O + (size_t)row * ldo + (col >> 1)) = w;
        EPI_LOOP_END
    }
};
struct EpiRope {
    static constexpr bool PERM = true;
    bf16_t* O; bf16_t* O2; int ncol_rope; const float* cs; const float* sn; float scale;
    __device__ __forceinline__ void operator()(const f32x4 (&acc)[2][2][4][2], const Unit& u, int wr, int wc, int fr, int fq) const {
        EPI_LOOP_BEGIN
            bf16_t* dst;
            if (col < ncol_rope) {
                const int t = row & (SEQ - 1), i0 = (col & 63) >> 1;
                const f32x4 c4 = *(const f32x4*)(cs + (size_t)t * 32 + i0), s4 = *(const f32x4*)(sn + (size_t)t * 32 + i0);
                float a, b;
                a = v0[0]; b = v0[1]; v0[0] = (a * c4[0] - b * s4[0]) * scale; v0[1] = (b * c4[0] + a * s4[0]) * scale;
                a = v0[2]; b = v0[3]; v0[2] = (a * c4[1] - b * s4[1]) * scale; v0[3] = (b * c4[1] + a * s4[1]) * scale;
                a = v1[0]; b = v1[1]; v1[0] = (a * c4[2] - b * s4[2]) * scale; v1[1] = (b * c4[2] + a * s4[2]) * scale;
                a = v1[2]; b = v1[3]; v1[2] = (a * c4[3] - b * s4[3]) * scale; v1[3] = (b * c4[3] + a * s4[3]) * scale;
                dst = O + (size_t)row * ncol_rope + col;
            } else dst = O2 + (size_t)row * ncol_rope + (col - ncol_rope);
            u32x4 w; w.x = cvt_pk_bf16(v0[0], v0[1]); w.y = cvt_pk_bf16(v0[2], v0[3]); w.z = cvt_pk_bf16(v1[0], v1[1]); w.w = cvt_pk_bf16(v1[2], v1[3]);
            *(u32x4*)dst = w;
        EPI_LOOP_END
    }
};

template <class Epi, class Sched, bool ALIGN_EPI>
__device__ __forceinline__ void gemm_phase(LAS unsigned char* lds, const Gemm g, const Sched& S, const Epi& E) {
    const int tid = threadIdx.x, wid = __builtin_amdgcn_readfirstlane(tid >> 6), lane = tid & 63, wr = wid >> 2, wc = wid & 3, fr = lane & 15, fq = lane >> 4;
    const int K = g.K, nt = K / BK;
    int RA[2], CA[2]; unsigned voffB[2];
#pragma unroll
    for (int i = 0; i < 2; ++i) { int R, C; stage_rc(tid * 16 + i * 8192, R, C); const int Rb = Epi::PERM ? ((R & ~31) + perm32(R & 31)) : R;
        RA[i] = R; CA[i] = C; voffB[i] = (unsigned)(Rb * K + C) * 2u; }
    const size_t kstep = (size_t)(BK * 2);
    const size_t hstepB = (size_t)HALF * K * 2, tstepB = 2 * hstepB;
    const unsigned ldsw = (unsigned)wid * 1024u;
    const int aoff = lds_byte(wr * 64 + fr, fq * 8), boff = lds_byte(wc * 32 + fr, fq * 8);
#define PG8_SA(b, h) (((b) * 2 + (h)) * HTB)
#define PG8_SB(b, h) ((4 + (b) * 2 + (h)) * HTB)
#define PG8_STAGE(bufoff, gbase, voff) do { _Pragma("unroll") for (int _i = 0; _i < 2; ++_i) \
        __builtin_amdgcn_global_load_lds((const unsigned*)((const char*)(gbase) + (voff)[_i]), (LAS unsigned*)(lds + (bufoff) + ldsw + _i * 8192), 16, 0, 0); } while (0)
#define PG8_VOFFA(v, uu) do { _Pragma("unroll") for (int _h = 0; _h < 2; ++_h) _Pragma("unroll") for (int _i = 0; _i < 2; ++_i) { int _row = (uu).pm * BM + _h * HALF + RA[_i]; \
        if (g.rowmap) _row = g.rowmap[_row]; (v)[_h][_i] = (unsigned)((size_t)(uu).z * g.azs) + (unsigned)(_row * g.lda + CA[_i]) * 2u; } } while (0)
#define PG8_BBASE(uu) ((const char*)g.Bt + (size_t)(uu).z * g.bzs + (g.blk_exp ? (size_t)ld_i32(g.blk_exp + (uu).pm) * g.bes : (size_t)0) + (size_t)(uu).pn * tstepB)
#define PG8_LDA(dst, b, h) do { _Pragma("unroll") for (int m = 0; m < 4; ++m) _Pragma("unroll") for (int k = 0; k < 2; ++k) dst[m][k] = *(const LAS bf16x8*)(lds + PG8_SA(b, h) + aoff + m * 2048 + k * 1024); } while (0)
#define PG8_LDB(dst, b, h) do { _Pragma("unroll") for (int n = 0; n < 2; ++n) _Pragma("unroll") for (int k = 0; k < 2; ++k) dst[n][k] = *(const LAS bf16x8*)(lds + PG8_SB(b, h) + boff + n * 2048 + k * 1024); } while (0)
#define PG8_MMA(ai, bj, At, Bt) do { __builtin_amdgcn_s_setprio(1); _Pragma("unroll") for (int m = 0; m < 4; ++m) _Pragma("unroll") for (int n = 0; n < 2; ++n) _Pragma("unroll") for (int k = 0; k < 2; ++k) \
        acc[ai][bj][m][n] = __builtin_amdgcn_mfma_f32_16x16x32_bf16(Bt[n][k], At[m][k], acc[ai][bj][m][n], 0, 0, 0); __builtin_amdgcn_s_setprio(0); } while (0)
#define PG8_WAIT_V(n) asm volatile("s_waitcnt vmcnt(" #n ")" ::: "memory")
#define PG8_WAIT_L(n) asm volatile("s_waitcnt lgkmcnt(" #n ")" ::: "memory")
#define PG8_BAR __builtin_amdgcn_s_barrier()
#define PG8_SCHED __builtin_amdgcn_sched_barrier(0)
    Unit cur, nxt; int ui = 0;
    if (!S.next(0, cur)) return;
    f32x4 acc[2][2][4][2];
#pragma unroll
    for (int a = 0; a < 2; ++a)
#pragma unroll
        for (int b = 0; b < 2; ++b)
#pragma unroll
            for (int m = 0; m < 4; ++m)
#pragma unroll
                for (int n = 0; n < 2; ++n) acc[a][b][m][n] = (f32x4){0.f, 0.f, 0.f, 0.f};
    bf16x8 At[4][2], B0[2][2], B1[2][2];
    unsigned vc[2][2], vn[2][2];
    const char* const Ab = (const char*)g.A;
    const char* cB = PG8_BBASE(cur);
    PG8_VOFFA(vc, cur);
    PG8_STAGE(PG8_SB(0, 0), cB, voffB); PG8_STAGE(PG8_SB(0, 1), cB + hstepB, voffB); PG8_STAGE(PG8_SA(0, 0), Ab, vc[0]); PG8_STAGE(PG8_SA(0, 1), Ab, vc[1]);
    if (wr == 1) PG8_BAR;
    PG8_WAIT_V(2); PG8_BAR;
    PG8_STAGE(PG8_SB(1, 0), cB + kstep, voffB); PG8_STAGE(PG8_SA(1, 0), Ab + kstep, vc[0]); PG8_STAGE(PG8_SB(1, 1), cB + hstepB + kstep, voffB);
    PG8_WAIT_V(6); PG8_BAR;
    for (;;) {
        const bool has_next = S.next(ui + 1, nxt);
        const char* nB = cB;
        if (has_next) { nB = PG8_BBASE(nxt); PG8_VOFFA(vn, nxt); }
        else {
#pragma unroll
            for (int h = 0; h < 2; ++h)
#pragma unroll
                for (int i = 0; i < 2; ++i) vn[h][i] = vc[h][i];
        }
        for (int t = 0; t < nt; t += 2) {
            const bool last = (t == nt - 2);
            const char* a1 = Ab + (size_t)(t + 1) * kstep;
            const char* a2 = last ? Ab : Ab + (size_t)(t + 2) * kstep; const char* b2 = last ? nB : cB + (size_t)(t + 2) * kstep;
            const char* a3 = a2 + kstep; const char* b3 = b2 + kstep;
            unsigned v2[2][2];
#pragma unroll
            for (int h = 0; h < 2; ++h)
#pragma unroll
                for (int i = 0; i < 2; ++i) v2[h][i] = last ? vn[h][i] : vc[h][i];
            PG8_LDB(B0, 0, 0); PG8_LDB(B1, 0, 1); PG8_SCHED; PG8_LDA(At, 0, 0); PG8_STAGE(PG8_SA(1, 1), a1, vc[1]);
            PG8_WAIT_V(8); PG8_WAIT_L(0); PG8_BAR; PG8_MMA(0, 0, At, B0); PG8_MMA(0, 1, At, B1); PG8_BAR; PG8_SCHED;
            PG8_LDA(At, 0, 1); PG8_STAGE(PG8_SB(0, 0), b2, voffB); PG8_STAGE(PG8_SB(0, 1), b2 + hstepB, voffB); PG8_STAGE(PG8_SA(0, 0), a2, v2[0]);
            PG8_WAIT_V(8); PG8_WAIT_L(0); PG8_BAR; PG8_MMA(1, 0, At, B0); PG8_MMA(1, 1, At, B1); PG8_BAR; PG8_SCHED;
            PG8_LDB(B0, 1, 0); PG8_LDB(B1, 1, 1); PG8_SCHED; PG8_LDA(At, 1, 0); PG8_STAGE(PG8_SA(0, 1), a2, v2[1]);
            PG8_WAIT_V(8); PG8_WAIT_L(0); PG8_BAR; PG8_MMA(0, 0, At, B0); PG8_MMA(0, 1, At, B1); PG8_BAR; PG8_SCHED;
            PG8_LDA(At, 1, 1); PG8_STAGE(PG8_SB(1, 0), b3, voffB); PG8_STAGE(PG8_SB(1, 1), b3 + hstepB, voffB); PG8_STAGE(PG8_SA(1, 0), a3, v2[0]);
            PG8_WAIT_V(8); PG8_WAIT_L(0); PG8_BAR; PG8_MMA(1, 0, At, B0); PG8_MMA(1, 1, At, B1); PG8_BAR; PG8_SCHED;
        }
        if constexpr (ALIGN_EPI) { if (wr == 0) PG8_BAR; }
        E(acc, cur, wr, wc, fr, fq);
        if (!has_next) break;
#pragma unroll
        for (int a = 0; a < 2; ++a)
#pragma unroll
            for (int b = 0; b < 2; ++b)
#pragma unroll
                for (int m = 0; m < 4; ++m)
#pragma unroll
                    for (int n = 0; n < 2; ++n) acc[a][b][m][n] = (f32x4){0.f, 0.f, 0.f, 0.f};
        cur = nxt; cB = nB; ++ui;
#pragma unroll
        for (int h = 0; h < 2; ++h)
#pragma unroll
            for (int i = 0; i < 2; ++i) vc[h][i] = vn[h][i];
        if constexpr (ALIGN_EPI) { if (wr == 1) PG8_BAR; }
    }
    PG8_WAIT_V(0);
    if constexpr (!ALIGN_EPI) { if (wr == 0) PG8_BAR; }
    PG8_BAR;
#undef PG8_SA
#undef PG8_SB
#undef PG8_STAGE
#undef PG8_VOFFA
#undef PG8_BBASE
#undef PG8_LDA
#undef PG8_LDB
#undef PG8_MMA
#undef PG8_WAIT_V
#undef PG8_WAIT_L
#undef PG8_BAR
#undef PG8_SCHED
}
}

constexpr int NWAVES = 8;
constexpr int NPH = 20;
#ifndef MK_N_LAUNCHES
#define MK_N_LAUNCHES NPH
#endif
constexpr int N_LAUNCHES = MK_N_LAUNCHES;

constexpr size_t MiB = 1u << 20;
constexpr size_t WS_CTL = 0, CTL_ZERO_BYTES = 1 * MiB;
constexpr size_t WS_MOD = 1 * MiB;
constexpr size_t WS_ROPE = 2 * MiB;
constexpr size_t WS_WRKV = 6 * MiB;
constexpr size_t WS_WL1 = 12 * MiB;
constexpr size_t WS_WL2 = 14 * MiB;
constexpr size_t WS_WOUT = 16 * MiB;
constexpr size_t WS_WFGU = 18 * MiB;
constexpr size_t WS_WFDN = 29 * MiB;
constexpr size_t WS_WKV = 35 * MiB;
constexpr size_t WS_WQ = 41 * MiB;
constexpr size_t WS_WO = 44 * MiB;
constexpr size_t WS_WMGU = 46 * MiB;
constexpr size_t WS_WMDN = 158 * MiB;
constexpr size_t WS_AR = 216 * MiB;
constexpr size_t AR(size_t mib) { return WS_AR + mib * MiB; }
constexpr size_t WS_A6 = AR(0);
constexpr size_t WS_L1 = AR(384);
constexpr size_t WS_RB = AR(432), WS_KB = AR(496), WS_VB = AR(560);
constexpr size_t WS_AS = AR(192), WS_G = AR(256);
constexpr size_t WS_YS = AR(0);
constexpr size_t WS_YG = AR(128);
constexpr size_t WS_Y1 = AR(320);
constexpr size_t WS_X1 = AR(448);
constexpr size_t WS_H2 = AR(576);
constexpr size_t WS_ACT = AR(0);
constexpr size_t WS_Y2 = AR(176);
constexpr size_t WS_X2 = AR(304);
constexpr size_t WS_HKV = AR(0), WS_H3 = AR(64);
constexpr size_t WS_K2 = AR(128), WS_V2 = AR(432), WS_Q2 = AR(528);
constexpr size_t WS_OG = AR(0);
constexpr size_t WS_LSE = AR(96);
constexpr size_t WS_OM = AR(224);
constexpr size_t WS_Y3 = AR(432);
constexpr size_t WS_H4 = AR(0);
constexpr size_t WS_ROUTE = AR(66);
constexpr size_t WS_ACT2 = AR(70);
constexpr size_t WS_YB = AR(532);
constexpr size_t WS_END = AR(664);
static_assert(WS_END <= 896 * MiB, "workspace");
static_assert((size_t)RMAX * DFE * 2 <= 462 * MiB && (size_t)RMAX * D * 2 <= 132 * MiB, "moe buffers");
constexpr size_t RT_TOKE = 0;
constexpr size_t RT_TOKR = 256 * 1024;
constexpr size_t RT_TOKW = 512 * 1024;
constexpr size_t RT_ROWTOK = 768 * 1024;
constexpr size_t RT_BLKEXP = 1280 * 1024;
constexpr int CW_BAR = 4096;
constexpr int CW_CNT = 16384;
constexpr int CW_NBLK = 16448;

constexpr int RING_BYTES = 131072;
constexpr int LDSCTL_OFF = RING_BYTES, MISC_OFF = LDSCTL_OFF + 320;
constexpr int LDS_BYTES = 147456;

#define LDS_WAIT() asm volatile("s_waitcnt lgkmcnt(0)" ::: "memory")
#define VM_WAIT() asm volatile("s_waitcnt vmcnt(0)" ::: "memory")

#define XB_TMO      128
#define XB_XCNT(j)  (256  + 64 * (j))
#define XB_XSUB(j)  (1280 + 64 * (j))
#define XB_XGEN(j)  (2304 + 64 * (j))
#define XB_TOP      3328
#define XB_TOPGEN   3392
#define XCD_BAR_WORDS 3456
#define XB_SPIN_CAP (1u << 22)

__device__ __forceinline__ unsigned xb_ld(unsigned* p)              { return __hip_atomic_load(p, __ATOMIC_RELAXED, __HIP_MEMORY_SCOPE_AGENT); }
__device__ __forceinline__ unsigned xb_add(unsigned* p, unsigned v) { return __hip_atomic_fetch_add(p, v, __ATOMIC_RELAXED, __HIP_MEMORY_SCOPE_AGENT); }
__device__ __forceinline__ unsigned xb_xcc_id() { return (unsigned)__builtin_amdgcn_s_getreg((3 << 11) | 20) & 0xFu; }
#define XB_SPIN(cond, bar) do { unsigned _sp = 0; while (cond) { __builtin_amdgcn_s_sleep(1); \
    if ((++_sp & 255u) == 0u) { if (xb_ld(&(bar)[XB_TMO])) break; if (_sp > XB_SPIN_CAP) { atomicAdd(&(bar)[XB_TMO], 1u); break; } } } } while (0)

struct XcdBarrier { unsigned* bar; unsigned x; volatile LAS unsigned* st; };
__device__ __forceinline__ XcdBarrier xcd_barrier_post(unsigned* bar, volatile LAS unsigned* st) {
    XcdBarrier b; b.bar = bar; b.x = xb_xcc_id(); b.st = st;
    if (threadIdx.x == 0) (void)xb_add(&bar[XB_XCNT(b.x)], 1u);
    return b;
}
__device__ __forceinline__ void xcd_barrier_complete(unsigned* bar, unsigned x, unsigned& nloc, unsigned& nx) {
    const unsigned G = gridDim.x * gridDim.y * gridDim.z;
    unsigned sum, cnt, mine, sp = 0u;
    for (;;) {
        sum = 0u; cnt = 0u; mine = 0u;
#pragma unroll
        for (unsigned j = 0; j < 16; ++j) { const unsigned c = xb_ld(&bar[XB_XCNT(j)]); sum += c; cnt += (c > 0u) ? 1u : 0u; mine = (j == x) ? c : mine; }
        if (sum == G) break;
        __builtin_amdgcn_s_sleep(1);
        if ((++sp & 255u) == 0u) { if (xb_ld(&bar[XB_TMO])) break; if (sp > XB_SPIN_CAP) { atomicAdd(&bar[XB_TMO], 1u); break; } }
    }
    nloc = mine > 0u ? mine : 1u; nx = cnt > 0u ? cnt : 1u;
}
__device__ __forceinline__ void xcd_barrier(const XcdBarrier& b) {
    asm volatile("s_waitcnt vmcnt(0)" ::: "memory");
    __syncthreads();
    if (threadIdx.x == 0) {
        unsigned* bar = b.bar;
        __builtin_amdgcn_s_waitcnt(0);
        unsigned nloc = b.st[0], nx = b.st[1];
        if (nloc == 0u) { xcd_barrier_complete(bar, b.x, nloc, nx); b.st[0] = nloc; b.st[1] = nx; }
        const unsigned old = xb_add(&bar[XB_XSUB(b.x)], 1u);
        const unsigned gen = old / nloc;
        if (old + 1u == (gen + 1u) * nloc) {
            __builtin_amdgcn_fence(__ATOMIC_RELEASE, "agent");
            asm volatile("s_waitcnt vmcnt(0)" ::: "memory");
            const unsigned og = xb_add(&bar[XB_TOP], 1u);
            const unsigned tg = og / nx;
            if (og + 1u == (tg + 1u) * nx) xb_add(&bar[XB_TOPGEN], 1u);
            else XB_SPIN(xb_ld(&bar[XB_TOPGEN]) == tg, bar);
            __builtin_amdgcn_fence(__ATOMIC_ACQUIRE, "agent");
            xb_add(&bar[XB_XGEN(b.x)], 1u);
            asm volatile("s_waitcnt vmcnt(0)" ::: "memory");
        } else {
            XB_SPIN(xb_ld(&bar[XB_XGEN(b.x)]) == gen, bar);
            __builtin_amdgcn_fence(__ATOMIC_ACQUIRE, "agent");
            asm volatile("s_waitcnt vmcnt(0)" ::: "memory");
        }
    }
    __syncthreads();
}

struct Frame {
    LAS unsigned char* lds;
    volatile LAS unsigned* MISC;
    gu32* ctl;
    int tid, lane, wave;
    int vcu, G;
    const float* const* in;
    float* out;
    unsigned char* ws;
};
#define WSP(type, off) ((type*)(F.ws + (off)))

__device__ __forceinline__ float wave_sum(float v) {
#pragma unroll
    for (int o = 1; o < 64; o <<= 1) v += __shfl_xor(v, o);
    return v;
}

__device__ __forceinline__ int colmap(int kind, int half, int n) {
    if (kind == 1) return (n & 1) ? half + (n >> 1) : (n >> 1);
    if (kind == 2 || (kind == 3 && n < QW)) { const int hd = n >> 6, p = n & 63; return hd * 64 + ((p & 1) * 32 + (p >> 1)); }
    return n;
}
__device__ __forceinline__ void cvt_item(const float* W, int ldw, int Kv, int Nv, bf16_t* WT, int Kout, int Nout, int kind, int half, LAS float* scr, int item, int lane) {
    const int nblk = Nout / 32, kb = item / nblk, nb = item % nblk, k0 = 64 * kb, n0 = 32 * nb;
    const int nn = n0 + (lane & 31); const int sc = colmap(kind, half, nn); const bool nok = nn < Nv;
#pragma unroll 8
    for (int i = 0; i < 32; ++i) { const int kk = 2 * i + (lane >> 5); float v = 0.f; if (nok && (k0 + kk) < Kv) v = W[(size_t)(k0 + kk) * ldw + sc]; scr[kk * 33 + (lane & 31)] = v; }
    LDS_WAIT(); asm volatile("" ::: "memory");
    const int c = lane & 7;
#pragma unroll
    for (int j = 0; j < 4; ++j) { const int n = (lane >> 3) + 8 * j; const LAS float* s = scr + (8 * c) * 33 + n;
        u32x4 o; o.x = cvt_pk_bf16(s[0 * 33], s[1 * 33]); o.y = cvt_pk_bf16(s[2 * 33], s[3 * 33]); o.z = cvt_pk_bf16(s[4 * 33], s[5 * 33]); o.w = cvt_pk_bf16(s[6 * 33], s[7 * 33]);
        *(u32x4*)(WT + (size_t)(n0 + n) * Kout + k0 + 8 * c) = o; }
    LDS_WAIT(); asm volatile("" ::: "memory");
}
__device__ __forceinline__ void p0_prologue(Frame& F) {
    {
        LAS float* part = (LAS float*)F.lds;
        const float* c = F.in[1]; const float* aw = F.in[2]; const float* ab = F.in[3]; float* MOD = WSP(float, WS_MOD);
        for (int it = F.vcu; it < ADA_W / 64; it += F.G) {
            const int j = it * 64 + F.lane; float s0 = 0.f, s1 = 0.f;
#pragma unroll 8
            for (int k = F.wave * 128; k < F.wave * 128 + 128; ++k) { const float w = aw[(size_t)k * ADA_W + j]; s0 += siluf_(c[k]) * w; s1 += siluf_(c[D + k]) * w; }
            part[(F.wave * 2 + 0) * 64 + F.lane] = s0; part[(F.wave * 2 + 1) * 64 + F.lane] = s1;
            __syncthreads();
            if (F.wave < 2) { float s = ab[j];
#pragma unroll
                for (int w = 0; w < 8; ++w) s += part[(w * 2 + F.wave) * 64 + F.lane];
                MOD[F.wave * ADA_W + j] = s; }
            __syncthreads();
        }
    }
    {
        float* cs = WSP(float, WS_ROPE); float* sn = cs + SEQ * 32;
        for (int idx = F.vcu * 512 + F.tid; idx < SEQ * 32; idx += F.G * 512) {
            const int t = idx >> 5, i = idx & 31;
            const float inv = powf(10000.0f, -(float)i / 32.0f); const float ang = (float)t * inv;
            cs[idx] = cosf(ang); sn[idx] = sinf(ang);
        }
    }
    LAS float* scr = (LAS float*)(F.lds + F.wave * 16384);
    const int gw = F.vcu * NWAVES + F.wave, NGW = F.G * NWAVES;
    constexpr int I_RKV = 16 * 96, I_L1 = 16 * 8, I_L2 = 4 * 32, I_OUT = 16 * 32, I_FGU = 16 * 176, I_FDN = 44 * 32, I_KV = 16 * 96, I_Q = 16 * 48, I_O = 8 * 32, I_MGU = 16 * 224, I_MDN = 56 * 32;
    constexpr int NITEMS = I_RKV + 3 * I_L1 + 3 * I_L2 + I_OUT + I_FGU + I_FDN + I_KV + I_Q + I_O + 8 * I_MGU + 8 * I_MDN;
    for (int it = gw; it < NITEMS; it += NGW) {
        int r = it;
        if (r < 8 * I_MGU) { const int e = r / I_MGU; cvt_item(F.in[28] + (size_t)e * D * 2 * DFE, 2 * DFE, D, 2 * DFE, WSP(bf16_t, WS_WMGU) + (size_t)e * 2 * DFE * D, D, 2 * DFE, 1, DFE, scr, r % I_MGU, F.lane); continue; } r -= 8 * I_MGU;
        if (r < 8 * I_MDN) { const int e = r / I_MDN; cvt_item(F.in[29] + (size_t)e * DFE * D, D, DFE, D, WSP(bf16_t, WS_WMDN) + (size_t)e * D * DFE, DFE, D, 0, 0, scr, r % I_MDN, F.lane); continue; } r -= 8 * I_MDN;
        if (r < I_RKV) { cvt_item(F.in[7], 3 * D, D, 3 * D, WSP(bf16_t, WS_WRKV), D, 3 * D, 0, 0, scr, r, F.lane); continue; } r -= I_RKV;
        if (r < I_L1) { cvt_item(F.in[9], 64, D, 64, WSP(bf16_t, WS_WL1), D, 256, 0, 0, scr, r, F.lane); continue; } r -= I_L1;
        if (r < I_L1) { cvt_item(F.in[12], 64, D, 64, WSP(bf16_t, WS_WL1) + 256 * D, D, 256, 0, 0, scr, r, F.lane); continue; } r -= I_L1;
        if (r < I_L1) { cvt_item(F.in[14], 160, D, 160, WSP(bf16_t, WS_WL1) + 2 * 256 * D, D, 256, 0, 0, scr, r, F.lane); continue; } r -= I_L1;
        if (r < I_L2) { cvt_item(F.in[10], D, 64, D, WSP(bf16_t, WS_WL2), 256, D, 0, 0, scr, r, F.lane); continue; } r -= I_L2;
        if (r < I_L2) { cvt_item(F.in[13], D, 64, D, WSP(bf16_t, WS_WL2) + D * 256, 256, D, 0, 0, scr, r, F.lane); continue; } r -= I_L2;
        if (r < I_L2) { cvt_item(F.in[15], D, 160, D, WSP(bf16_t, WS_WL2) + 2 * D * 256, 256, D, 0, 0, scr, r, F.lane); continue; } r -= I_L2;
        if (r < I_OUT) { cvt_item(F.in[21], D, D, D, WSP(bf16_t, WS_WOUT), D, D, 0, 0, scr, r, F.lane); continue; } r -= I_OUT;
        if (r < I_FGU) { cvt_item(F.in[25], 2 * DFF, D, 2 * DFF, WSP(bf16_t, WS_WFGU), D, 2 * DFF, 1, DFF, scr, r, F.lane); continue; } r -= I_FGU;
        if (r < I_FDN) { cvt_item(F.in[26], D, DFF, D, WSP(bf16_t, WS_WFDN), DFF, D, 0, 0, scr, r, F.lane); continue; } r -= I_FDN;
        if (r < I_KV) { cvt_item(F.in[22], 2 * QW, D, 2 * QW, WSP(bf16_t, WS_WKV), D, 2 * QW, 3, 0, scr, r, F.lane); continue; } r -= I_KV;
        if (r < I_Q) { cvt_item(F.in[23], QW, D, QW, WSP(bf16_t, WS_WQ), D, QW, 2, 0, scr, r, F.lane); continue; } r -= I_Q;
        cvt_item(F.in[24], D, AOUT, D, WSP(bf16_t, WS_WO), AOUT, D, 0, 0, scr, r, F.lane);
    }
}

__device__ __forceinline__ void p1_lerp(Frame& F) {
    const int gw = F.vcu * NWAVES + F.wave, NGW = F.G * NWAVES;
    const float* x = F.in[0]; const float* mu = F.in[6]; const float* MOD = WSP(float, WS_MOD); bf16_t* A6 = WSP(bf16_t, WS_A6);
    for (int m = gw; m < T; m += NGW) {
        const int b = m >> 14, t = m & (SEQ - 1);
#pragma unroll
        for (int j = 0; j < 4; ++j) {
            const int c = 4 * F.lane + 256 * j;
            const f32x4 sh = *(const f32x4*)(MOD + b * ADA_W + 0 * D + c), sc = *(const f32x4*)(MOD + b * ADA_W + 1 * D + c);
            const f32x4 xc = *(const f32x4*)(x + (size_t)m * D + c);
            const f32x4 hc = xc * (1.f + sc) + sh;
            f32x4 hp = (f32x4){0.f, 0.f, 0.f, 0.f};
            if (t > 0) { const f32x4 xp = *(const f32x4*)(x + (size_t)(m - 1) * D + c); hp = xp * (1.f + sc) + sh; }
            const f32x4 xx = hp - hc;
#pragma unroll
            for (int p = 0; p < 6; ++p) {
                const f32x4 mv = *(const f32x4*)(mu + p * D + c); const f32x4 o = hc + xx * mv;
                u32x2 w; w.x = cvt_pk_bf16(o[0], o[1]); w.y = cvt_pk_bf16(o[2], o[3]);
                *(u32x2*)(A6 + (size_t)p * T * D + (size_t)m * D + c) = w;
            }
        }
    }
}

__device__ __forceinline__ float sum16(float v) { v += __shfl_xor(v, 1); v += __shfl_xor(v, 2); v += __shfl_xor(v, 4); v += __shfl_xor(v, 8); return v; }
__device__ __forceinline__ void p4_scan_seq(Frame& F) {
    constexpr int TC = 32;
    LAS float* Rs = (LAS float*)F.lds; LAS float* Ws = Rs + TC * 64; LAS float* Ks = Ws + TC * 64; LAS float* As = Ks + TC * 64; LAS float* Bs = As + TC * 64;
    LAS float* Vs = Bs + TC * 64; LAS float* Ys = Vs + TC * 32;
    const bf16_t* RB = WSP(bf16_t, WS_RB); const bf16_t* KB = WSP(bf16_t, WS_KB); const bf16_t* VB = WSP(bf16_t, WS_VB); const bf16_t* AS = WSP(bf16_t, WS_AS);
    const float* WLOG = F.out; float* YS = WSP(float, WS_YS);
    const float* k_k = F.in[16]; const float* k_a = F.in[17];
    for (int unit = blockIdx.x; unit < 64; unit += F.G) {
        const int b = unit >> 5, h = (unit >> 1) & 15, vh = unit & 1;
        const int kq = F.lane & 15, vl = F.wave * 4 + (F.lane >> 4);
        const int ts = F.tid >> 4, skq = F.tid & 15, scol = h * 64 + 4 * skq;
        const f32x4 kk4 = *(const f32x4*)(k_k + scol), ka4 = *(const f32x4*)(k_a + scol);
        f32x4 S = (f32x4){0.f, 0.f, 0.f, 0.f};
        for (int chunk = 0; chunk < SEQ / TC; ++chunk) {
            {
                const size_t m = (size_t)b * SEQ + chunk * TC + ts;
                const u32x2 rw = *(const u32x2*)(RB + m * D + scol), kw = *(const u32x2*)(KB + m * D + scol), aw = *(const u32x2*)(AS + m * D + scol);
                const f32x4 wl = *(const f32x4*)(WLOG + m * D + scol);
                const f32x4 r4 = (f32x4){bflo(rw.x), bfhi(rw.x), bflo(rw.y), bfhi(rw.y)}, k4 = (f32x4){bflo(kw.x), bfhi(kw.x), bflo(kw.y), bfhi(kw.y)}, a4 = (f32x4){bflo(aw.x), bfhi(aw.x), bflo(aw.y), bfhi(aw.y)};
                f32x4 kkv = k4 * kk4; float ss = kkv[0] * kkv[0] + kkv[1] * kkv[1] + kkv[2] * kkv[2] + kkv[3] * kkv[3]; ss = sum16(ss);
                const float inv = 1.f / fmaxf(sqrtf(ss), 1e-12f); kkv = kkv * inv;
                const f32x4 kp = k4 * (1.f + (a4 - 1.f) * ka4), bb = kkv * a4;
                f32x4 w4; w4[0] = __expf(wl[0]); w4[1] = __expf(wl[1]); w4[2] = __expf(wl[2]); w4[3] = __expf(wl[3]);
                *(LAS f32x4*)(Rs + ts * 64 + 4 * skq) = r4; *(LAS f32x4*)(Ws + ts * 64 + 4 * skq) = w4; *(LAS f32x4*)(Ks + ts * 64 + 4 * skq) = kp;
                *(LAS f32x4*)(As + ts * 64 + 4 * skq) = -kkv; *(LAS f32x4*)(Bs + ts * 64 + 4 * skq) = bb;
                if (skq < 8) { const u32x2 vw = *(const u32x2*)(VB + m * D + h * 64 + vh * 32 + 4 * skq);
                    *(LAS f32x4*)(Vs + ts * 32 + 4 * skq) = (f32x4){bflo(vw.x), bfhi(vw.x), bflo(vw.y), bfhi(vw.y)}; }
            }
            __syncthreads();
            for (int tt = 0; tt < TC; ++tt) {
                const f32x4 a4 = *(const LAS f32x4*)(As + tt * 64 + 4 * kq), w4 = *(const LAS f32x4*)(Ws + tt * 64 + 4 * kq), b4 = *(const LAS f32x4*)(Bs + tt * 64 + 4 * kq);
                const f32x4 k4 = *(const LAS f32x4*)(Ks + tt * 64 + 4 * kq), r4 = *(const LAS f32x4*)(Rs + tt * 64 + 4 * kq);
                const float vv = Vs[tt * 32 + vl];
                float sa = S[0] * a4[0] + S[1] * a4[1] + S[2] * a4[2] + S[3] * a4[3]; sa = sum16(sa);
                S = S * w4 + sa * b4 + vv * k4;
                float y = S[0] * r4[0] + S[1] * r4[1] + S[2] * r4[2] + S[3] * r4[3]; y = sum16(y);
                if (kq == 0) Ys[tt * 32 + vl] = y;
            }
            __syncthreads();
            { const int idx = F.tid * 2, tt = idx >> 5, v = idx & 31;
              *(f32x2*)(YS + ((size_t)b * SEQ + chunk * TC + tt) * D + h * 64 + vh * 32 + v) = (f32x2){Ys[idx], Ys[idx + 1]}; }
        }
        __syncthreads();
    }
}

__device__ __forceinline__ void ld16bf(const bf16_t* p, float (&o)[16]) {
    const u32x4 a = *(const u32x4*)p, b = *(const u32x4*)(p + 8);
    o[0] = bflo(a.x); o[1] = bfhi(a.x); o[2] = bflo(a.y); o[3] = bfhi(a.y); o[4] = bflo(a.z); o[5] = bfhi(a.z); o[6] = bflo(a.w); o[7] = bfhi(a.w);
    o[8] = bflo(b.x); o[9] = bfhi(b.x); o[10] = bflo(b.y); o[11] = bfhi(b.y); o[12] = bflo(b.z); o[13] = bfhi(b.z); o[14] = bflo(b.w); o[15] = bfhi(b.w);
}
__device__ __forceinline__ void ld16f(const float* p, float (&o)[16]) {
#pragma unroll
    for (int q = 0; q < 4; ++q) { const f32x4 v = *(const f32x4*)(p + 4 * q); o[4 * q] = v[0]; o[4 * q + 1] = v[1]; o[4 * q + 2] = v[2]; o[4 * q + 3] = v[3]; }
}
__device__ __forceinline__ void p5_gnorm(Frame& F) {
    const int gw = F.vcu * NWAVES + F.wave, NGW = F.G * NWAVES;
    const float* YS = WSP(float, WS_YS); const bf16_t* RB = WSP(bf16_t, WS_RB); const bf16_t* KB = WSP(bf16_t, WS_KB); const bf16_t* VB = WSP(bf16_t, WS_VB);
    const bf16_t* AS = WSP(bf16_t, WS_AS); const bf16_t* GG = WSP(bf16_t, WS_G); bf16_t* YG = WSP(bf16_t, WS_YG);
    const int c0 = 16 * F.lane;
    float ka[16], rk[16], lg[16], lb[16];
    ld16f(F.in[17] + c0, ka); ld16f(F.in[18] + c0, rk); ld16f(F.in[19] + c0, lg); ld16f(F.in[20] + c0, lb);
    for (int m = gw; m < T; m += NGW) {
        float y[16], r[16], k[16], v[16], a[16], g[16];
        ld16f(YS + (size_t)m * D + c0, y); ld16bf(RB + (size_t)m * D + c0, r); ld16bf(KB + (size_t)m * D + c0, k); ld16bf(VB + (size_t)m * D + c0, v);
        ld16bf(AS + (size_t)m * D + c0, a); ld16bf(GG + (size_t)m * D + c0, g);
        float s = 0.f, bn = 0.f;
#pragma unroll
        for (int i = 0; i < 16; ++i) { s += y[i]; const float kp = k[i] * (1.f + (a[i] - 1.f) * ka[i]); bn += r[i] * kp * rk[i]; }
        s += __shfl_xor(s, 1); s += __shfl_xor(s, 2); bn += __shfl_xor(bn, 1); bn += __shfl_xor(bn, 2);
        const float mean = s * (1.f / 64.f); float q = 0.f;
#pragma unroll
        for (int i = 0; i < 16; ++i) { const float d = y[i] - mean; q += d * d; }
        q += __shfl_xor(q, 1); q += __shfl_xor(q, 2);
        const float rstd = 1.f / sqrtf(q * (1.f / 64.f) + LNX_EPS);
        float o[16];
#pragma unroll
        for (int i = 0; i < 16; ++i) o[i] = (((y[i] - mean) * rstd) * lg[i] + lb[i] + bn * v[i]) * g[i];
        u32x4 w0, w1;
        w0.x = cvt_pk_bf16(o[0], o[1]); w0.y = cvt_pk_bf16(o[2], o[3]); w0.z = cvt_pk_bf16(o[4], o[5]); w0.w = cvt_pk_bf16(o[6], o[7]);
        w1.x = cvt_pk_bf16(o[8], o[9]); w1.y = cvt_pk_bf16(o[10], o[11]); w1.z = cvt_pk_bf16(o[12], o[13]); w1.w = cvt_pk_bf16(o[14], o[15]);
        *(u32x4*)(YG + (size_t)m * D + c0) = w0; *(u32x4*)(YG + (size_t)m * D + c0 + 8) = w1;
    }
}

__device__ __forceinline__ void ln_apply(f32x4 (&v)[4], const float* g, const float* b, int lane) {
    float s = 0.f;
#pragma unroll
    for (int j = 0; j < 4; ++j) s += (v[j][0] + v[j][1]) + (v[j][2] + v[j][3]);
    const float mean = wave_sum(s) * (1.f / D); float s2 = 0.f;
#pragma unroll
    for (int j = 0; j < 4; ++j) { v[j] = v[j] - mean; s2 += (v[j][0] * v[j][0] + v[j][1] * v[j][1]) + (v[j][2] * v[j][2] + v[j][3] * v[j][3]); }
    const float rstd = 1.f / sqrtf(wave_sum(s2) * (1.f / D) + LN_EPS);
#pragma unroll
    for (int j = 0; j < 4; ++j) { const int c = 4 * lane + 256 * j; v[j] = v[j] * rstd * *(const f32x4*)(g + c) + *(const f32x4*)(b + c); }
}
__device__ __forceinline__ void mod_store(const f32x4 (&v)[4], const float* shift, const float* scale, bf16_t* orow, int lane) {
#pragma unroll
    for (int j = 0; j < 4; ++j) { const int c = 4 * lane + 256 * j; const f32x4 o = v[j] * (1.f + *(const f32x4*)(scale + c)) + *(const f32x4*)(shift + c);
        u32x2 w; w.x = cvt_pk_bf16(o[0], o[1]); w.y = cvt_pk_bf16(o[2], o[3]); *(u32x2*)(orow + c) = w; }
}
__device__ __forceinline__ void p_postnorm(Frame& F, const float* xres, const float* y, float* xout, int sub, int modA, bf16_t* outA, int modB, bf16_t* outB) {
    const int gw = F.vcu * NWAVES + F.wave, NGW = F.G * NWAVES;
    const float* MOD = WSP(float, WS_MOD); const float* g = F.in[4] + sub * D; const float* bb = F.in[5] + sub * D;
    for (int m = gw; m < T; m += NGW) {
        const int b = m >> 14; const float* gate = MOD + b * ADA_W + (sub * 3 + 2) * D;
        f32x4 v[4];
#pragma unroll
        for (int j = 0; j < 4; ++j) { const int c = 4 * F.lane + 256 * j;
            v[j] = DN_ALPHA * *(const f32x4*)(xres + (size_t)m * D + c) + (1.f + *(const f32x4*)(gate + c)) * *(const f32x4*)(y + (size_t)m * D + c); }
        ln_apply(v, g, bb, F.lane);
#pragma unroll
        for (int j = 0; j < 4; ++j) *(f32x4*)(xout + (size_t)m * D + 4 * F.lane + 256 * j) = v[j];
        if (outA) mod_store(v, MOD + b * ADA_W + modA, MOD + b * ADA_W + modA + D, outA + (size_t)m * D, F.lane);
        if (outB) mod_store(v, MOD + b * ADA_W + modB, MOD + b * ADA_W + modB + D, outB + (size_t)m * D, F.lane);
    }
}

constexpr int KS_STRIDE = 72;
constexpr int VT_STRIDE = 264;
__device__ __forceinline__ void p12_attn(Frame& F) {
    LAS bf16_t* Ks = (LAS bf16_t*)F.lds;
    LAS bf16_t* Vt = Ks + 256 * KS_STRIDE;
    const bf16_t* Q2 = WSP(bf16_t, WS_Q2); const bf16_t* K2 = WSP(bf16_t, WS_K2); const bf16_t* V2 = WSP(bf16_t, WS_V2);
    bf16_t* OG = WSP(bf16_t, WS_OG); float* LSE = WSP(float, WS_LSE);
    const int lane = F.lane, w = F.wave, q16 = lane & 15, qd = lane >> 4;
    for (int unit = F.vcu; unit < BATCH * 3 * 8 * 128; unit += F.G) {
        const int pb = unit & 127, hg = (unit >> 7) & 7, gb = unit >> 10, g = gb % 3, b = gb / 3;
        const int dil = g == 0 ? 1 : (g == 1 ? 4 : 16), nb = 128 / dil, phase = pb / nb, blk = pb % nb;
        const int hcol = (g * 8 + hg) * 64;
#pragma unroll
        for (int i = 0; i < 4; ++i) {
            const int ch = F.tid + 512 * i, key = ch >> 3, c8 = (ch & 7) * 8;
            const int pos = (blk - 1) * 128 + key;
            u32x4 kv = (u32x4){0u, 0u, 0u, 0u}, vv = (u32x4){0u, 0u, 0u, 0u};
            if (pos >= 0) { const size_t row = (size_t)b * SEQ + (size_t)pos * dil + phase;
                kv = *(const u32x4*)(K2 + row * QW + hcol + c8); vv = *(const u32x4*)(V2 + row * QW + hcol + c8); }
            *(LAS u32x4*)(Ks + key * KS_STRIDE + c8) = kv;
            Vt[(c8 + 0) * VT_STRIDE + key] = (bf16_t)(vv.x & 0xffff); Vt[(c8 + 1) * VT_STRIDE + key] = (bf16_t)(vv.x >> 16);
            Vt[(c8 + 2) * VT_STRIDE + key] = (bf16_t)(vv.y & 0xffff); Vt[(c8 + 3) * VT_STRIDE + key] = (bf16_t)(vv.y >> 16);
            Vt[(c8 + 4) * VT_STRIDE + key] = (bf16_t)(vv.z & 0xffff); Vt[(c8 + 5) * VT_STRIDE + key] = (bf16_t)(vv.z >> 16);
            Vt[(c8 + 6) * VT_STRIDE + key] = (bf16_t)(vv.w & 0xffff); Vt[(c8 + 7) * VT_STRIDE + key] = (bf16_t)(vv.w >> 16);
        }
        const int qi = 16 * w + q16;
        const size_t qrow = (size_t)b * SEQ + (size_t)(blk * 128 + qi) * dil + phase;
        const bf16x8 qf0 = *(const bf16x8*)(Q2 + qrow * QW + hcol + 8 * qd), qf1 = *(const bf16x8*)(Q2 + qrow * QW + hcol + 32 + 8 * qd);
        __syncthreads();
        const int kt0 = w < 6 ? w : 6;
        f32x4 s[10];
#pragma unroll
        for (int i = 0; i < 10; ++i) {
            const LAS bf16_t* kp = Ks + (16 * (kt0 + i) + q16) * KS_STRIDE + 8 * qd;
            const bf16x8 k0 = *(const LAS bf16x8*)kp, k1 = *(const LAS bf16x8*)(kp + 32);
            f32x4 a = (f32x4){0.f, 0.f, 0.f, 0.f};
            a = __builtin_amdgcn_mfma_f32_16x16x32_bf16(k0, qf0, a, 0, 0, 0);
            a = __builtin_amdgcn_mfma_f32_16x16x32_bf16(k1, qf1, a, 0, 0, 0);
            s[i] = a;
        }
        float mx = -1e30f;
#pragma unroll
        for (int i = 0; i < 10; ++i)
#pragma unroll
            for (int r = 0; r < 4; ++r) { const int kidx = 16 * (kt0 + i) + 4 * qd + r; const bool ok = (kidx >= qi) && (kidx <= qi + 128) && (blk > 0 || kidx >= 128);
                s[i][r] = ok ? s[i][r] : -1e30f; mx = fmaxf(mx, s[i][r]); }
        mx = fmaxf(mx, __shfl_xor(mx, 16)); mx = fmaxf(mx, __shfl_xor(mx, 32));
        float l = 0.f;
#pragma unroll
        for (int i = 0; i < 10; ++i)
#pragma unroll
            for (int r = 0; r < 4; ++r) { const float p = __expf(s[i][r] - mx); s[i][r] = p; l += p; }
        l += __shfl_xor(l, 16); l += __shfl_xor(l, 32);
        f32x4 o[4];
#pragma unroll
        for (int dt = 0; dt < 4; ++dt) o[dt] = (f32x4){0.f, 0.f, 0.f, 0.f};
#pragma unroll
        for (int i = 0; i < 5; ++i) {
            union { bf16x8 v; unsigned u[4]; } pf;
            pf.u[0] = cvt_pk_bf16(s[2 * i][0], s[2 * i][1]); pf.u[1] = cvt_pk_bf16(s[2 * i][2], s[2 * i][3]);
            pf.u[2] = cvt_pk_bf16(s[2 * i + 1][0], s[2 * i + 1][1]); pf.u[3] = cvt_pk_bf16(s[2 * i + 1][2], s[2 * i + 1][3]);
#pragma unroll
            for (int dt = 0; dt < 4; ++dt) {
                const LAS bf16_t* vp = Vt + (16 * dt + q16) * VT_STRIDE + 16 * (kt0 + 2 * i) + 4 * qd;
                union { bf16x8 v; s16x4 h[2]; } vf; vf.h[0] = *(const LAS s16x4*)vp; vf.h[1] = *(const LAS s16x4*)(vp + 16);
                o[dt] = __builtin_amdgcn_mfma_f32_16x16x32_bf16(vf.v, pf.v, o[dt], 0, 0, 0);
            }
        }
        const float il = 1.f / l;
        bf16_t* op = OG + (size_t)g * T * AOUT + qrow * AOUT + hg * 64 + 4 * qd;
#pragma unroll
        for (int dt = 0; dt < 4; ++dt) { u32x2 wv; wv.x = cvt_pk_bf16(o[dt][0] * il, o[dt][1] * il); wv.y = cvt_pk_bf16(o[dt][2] * il, o[dt][3] * il); *(u32x2*)(op + 16 * dt) = wv; }
        if (qd == 0) LSE[(size_t)g * T * 8 + qrow * 8 + hg] = mx + __logf(l);
        __syncthreads();
    }
}
__device__ __forceinline__ void p13_merge(Frame& F) {
    const bf16_t* OG = WSP(bf16_t, WS_OG); const float* LSE = WSP(float, WS_LSE); bf16_t* OM = WSP(bf16_t, WS_OM);
    for (int idx = F.vcu * 512 + F.tid; idx < T * 64; idx += F.G * 512) {
        const int m = idx >> 6, hg = (idx >> 3) & 7, c8 = (idx & 7) * 8;
        const float l0 = LSE[(size_t)0 * T * 8 + m * 8 + hg], l1 = LSE[(size_t)1 * T * 8 + m * 8 + hg], l2 = LSE[(size_t)2 * T * 8 + m * 8 + hg];
        const float mx = fmaxf(l0, fmaxf(l1, l2)); float w0 = __expf(l0 - mx), w1 = __expf(l1 - mx), w2 = __expf(l2 - mx); const float inv = 1.f / (w0 + w1 + w2); w0 *= inv; w1 *= inv; w2 *= inv;
        const size_t off = (size_t)m * AOUT + hg * 64 + c8;
        const u32x4 a = *(const u32x4*)(OG + off), bq = *(const u32x4*)(OG + (size_t)T * AOUT + off), c = *(const u32x4*)(OG + (size_t)2 * T * AOUT + off);
        u32x4 o;
        o.x = cvt_pk_bf16(w0 * bflo(a.x) + w1 * bflo(bq.x) + w2 * bflo(c.x), w0 * bfhi(a.x) + w1 * bfhi(bq.x) + w2 * bfhi(c.x));
        o.y = cvt_pk_bf16(w0 * bflo(a.y) + w1 * bflo(bq.y) + w2 * bflo(c.y), w0 * bfhi(a.y) + w1 * bfhi(bq.y) + w2 * bfhi(c.y));
        o.z = cvt_pk_bf16(w0 * bflo(a.z) + w1 * bflo(bq.z) + w2 * bflo(c.z), w0 * bfhi(a.z) + w1 * bfhi(bq.z) + w2 * bfhi(c.z));
        o.w = cvt_pk_bf16(w0 * bflo(a.w) + w1 * bflo(bq.w) + w2 * bflo(c.w), w0 * bfhi(a.w) + w1 * bfhi(bq.w) + w2 * bfhi(c.w));
        *(u32x4*)(OM + off) = o;
    }
}

__device__ __forceinline__ void p15_ln_route(Frame& F) {
    LAS float* RT = (LAS float*)F.lds;
    LAS int* lcnt = (LAS int*)(F.lds + 32768);
    LAS int* lbase = lcnt + 8;
    LAS int* lte = lcnt + 16;
    LAS int* ltr = lte + 256;
    LAS float* ltw = (LAS float*)(ltr + 256);
    const float* MOD = WSP(float, WS_MOD); const float* g = F.in[4] + 2 * D; const float* bb = F.in[5] + 2 * D;
    const float* X2 = WSP(float, WS_X2); const float* Y3 = WSP(float, WS_Y3); float* X3 = F.out; bf16_t* H4 = WSP(bf16_t, WS_H4);
    int* TOKE = (int*)(F.ws + WS_ROUTE + RT_TOKE); int* TOKR = (int*)(F.ws + WS_ROUTE + RT_TOKR); float* TOKW = (float*)(F.ws + WS_ROUTE + RT_TOKW);
    int* ROWTOK = (int*)(F.ws + WS_ROUTE + RT_ROWTOK);
    for (int i = F.tid; i < D * 8; i += 512) RT[i] = F.in[27][i];
    for (int i = F.vcu * 512 + F.tid; i < RMAX; i += F.G * 512) ROWTOK[i] = T;
    if (F.vcu == 0) for (int i = F.tid; i < D / 2; i += 512) ((unsigned*)(H4 + (size_t)T * D))[i] = 0u;
    __syncthreads();
    for (int chunk = F.vcu; chunk < T / 128; chunk += F.G) {
        if (F.tid < 8) lcnt[F.tid] = 0;
        __syncthreads();
        for (int i = 0; i < 16; ++i) {
            const int lr = F.wave * 16 + i, m = chunk * 128 + lr, b = m >> 14;
            const float* gate = MOD + b * ADA_W + (2 * 3 + 2) * D;
            f32x4 v[4];
#pragma unroll
            for (int j = 0; j < 4; ++j) { const int c = 4 * F.lane + 256 * j;
                v[j] = DN_ALPHA * *(const f32x4*)(X2 + (size_t)m * D + c) + (1.f + *(const f32x4*)(gate + c)) * *(const f32x4*)(Y3 + (size_t)m * D + c); }
            ln_apply(v, g, bb, F.lane);
#pragma unroll
            for (int j = 0; j < 4; ++j) *(f32x4*)(X3 + (size_t)m * D + 4 * F.lane + 256 * j) = v[j];
            const float* shift = MOD + b * ADA_W + (3 * 3 + 0) * D; const float* scale = MOD + b * ADA_W + (3 * 3 + 1) * D;
            float lg[8];
#pragma unroll
            for (int e = 0; e < 8; ++e) lg[e] = 0.f;
#pragma unroll
            for (int j = 0; j < 4; ++j) { const int c = 4 * F.lane + 256 * j; const f32x4 hh = v[j] * (1.f + *(const f32x4*)(scale + c)) + *(const f32x4*)(shift + c);
                u32x2 wv; wv.x = cvt_pk_bf16(hh[0], hh[1]); wv.y = cvt_pk_bf16(hh[2], hh[3]); *(u32x2*)(H4 + (size_t)m * D + c) = wv;
#pragma unroll
                for (int q = 0; q < 4; ++q) { const f32x4 r0 = *(const LAS f32x4*)(RT + (c + q) * 8), r1 = *(const LAS f32x4*)(RT + (c + q) * 8 + 4);
                    lg[0] += hh[q] * r0[0]; lg[1] += hh[q] * r0[1]; lg[2] += hh[q] * r0[2]; lg[3] += hh[q] * r0[3];
                    lg[4] += hh[q] * r1[0]; lg[5] += hh[q] * r1[1]; lg[6] += hh[q] * r1[2]; lg[7] += hh[q] * r1[3]; } }
#pragma unroll
            for (int e = 0; e < 8; ++e) lg[e] = wave_sum(lg[e]);
            int e1 = 0; float m1 = lg[0];
#pragma unroll
            for (int e = 1; e < 8; ++e) if (lg[e] > m1) { m1 = lg[e]; e1 = e; }
            int e2 = -1; float m2 = -3.0e38f;
#pragma unroll
            for (int e = 0; e < 8; ++e) if (e != e1 && lg[e] > m2) { m2 = lg[e]; e2 = e; }
            if (F.lane == 0) {
                const float w1 = 1.f / (1.f + __expf(m2 - m1));
                lte[lr * 2] = e1; lte[lr * 2 + 1] = e2; ltw[lr * 2] = w1; ltw[lr * 2 + 1] = 1.f - w1;
                ltr[lr * 2] = atomicAdd((int*)&lcnt[e1], 1); ltr[lr * 2 + 1] = atomicAdd((int*)&lcnt[e2], 1);
            }
        }
        __syncthreads();
        if (F.tid < 8) lbase[F.tid] = (int)__hip_atomic_fetch_add((unsigned*)(F.ctl + CW_CNT + F.tid), (unsigned)lcnt[F.tid], RLX_AGENT);
        __syncthreads();
        if (F.tid < 256) { const int m = chunk * 128 + (F.tid >> 1), s = F.tid & 1; const int e = lte[F.tid];
            TOKE[m * 2 + s] = e; TOKR[m * 2 + s] = lbase[e] + ltr[F.tid]; TOKW[m * 2 + s] = ltw[F.tid]; }
        __syncthreads();
    }
}
__device__ __forceinline__ void p16_place(Frame& F) {
    int* TOKE = (int*)(F.ws + WS_ROUTE + RT_TOKE); int* TOKR = (int*)(F.ws + WS_ROUTE + RT_TOKR);
    int* ROWTOK = (int*)(F.ws + WS_ROUTE + RT_ROWTOK); int* BLKEXP = (int*)(F.ws + WS_ROUTE + RT_BLKEXP);
    int pstart[8], pend[8]; int acc = 0;
#pragma unroll
    for (int e = 0; e < 8; ++e) { const int c = (int)__hip_atomic_load((unsigned*)(F.ctl + CW_CNT + e), RLX_AGENT); pstart[e] = acc; acc += (c + 255) / 256 * 256; pend[e] = acc; }
    for (int idx = F.vcu * 512 + F.tid; idx < T * 2; idx += F.G * 512) {
        const int e = TOKE[idx]; int ps = 0;
#pragma unroll
        for (int j = 0; j < 8; ++j) ps = (e == j) ? pstart[j] : ps;
        const int dest = ps + TOKR[idx]; ROWTOK[dest] = idx >> 1; TOKR[idx] = dest;
    }
    if (F.vcu == 0) {
        for (int blk = F.tid; blk < NBLKMAX; blk += 512) { int e = 0;
#pragma unroll
            for (int j = 0; j < 8; ++j) e += (pend[j] <= blk * 256) ? 1 : 0;
            BLKEXP[blk] = e < 8 ? e : 7; }
        if (F.tid == 0) __hip_atomic_store((unsigned*)(F.ctl + CW_NBLK), (unsigned)(acc / 256), RLX_AGENT);
    }
}
__device__ __forceinline__ void p19_final(Frame& F) {
    const int gw = F.vcu * NWAVES + F.wave, NGW = F.G * NWAVES;
    const float* MOD = WSP(float, WS_MOD); const float* g = F.in[4] + 3 * D; const float* bb = F.in[5] + 3 * D;
    const bf16_t* YB = WSP(bf16_t, WS_YB); const int* TOKR = (const int*)(F.ws + WS_ROUTE + RT_TOKR); const float* TOKW = (const float*)(F.ws + WS_ROUTE + RT_TOKW);
    float* X = F.out;
    for (int m = gw; m < T; m += NGW) {
        const int b = m >> 14; const float* gate = MOD + b * ADA_W + (3 * 3 + 2) * D;
        const int d0 = TOKR[m * 2], d1 = TOKR[m * 2 + 1]; const float w0 = TOKW[m * 2], w1 = TOKW[m * 2 + 1];
        f32x4 v[4];
#pragma unroll
        for (int j = 0; j < 4; ++j) { const int c = 4 * F.lane + 256 * j;
            const u32x2 a = *(const u32x2*)(YB + (size_t)d0 * D + c), q = *(const u32x2*)(YB + (size_t)d1 * D + c);
            const f32x4 y = (f32x4){w0 * bflo(a.x) + w1 * bflo(q.x), w0 * bfhi(a.x) + w1 * bfhi(q.x), w0 * bflo(a.y) + w1 * bflo(q.y), w0 * bfhi(a.y) + w1 * bfhi(q.y)};
            v[j] = DN_ALPHA * *(const f32x4*)(X + (size_t)m * D + c) + (1.f + *(const f32x4*)(gate + c)) * y; }
        ln_apply(v, g, bb, F.lane);
#pragma unroll
        for (int j = 0; j < 4; ++j) *(f32x4*)(X + (size_t)m * D + 4 * F.lane + 256 * j) = v[j];
    }
}

struct Args { const float* in[30]; float* out; unsigned char* ws; int ph_lo, ph_hi, li, pad; };
__global__ void __launch_bounds__(NWAVES * 64, 2) fwd(Args args) {
    extern __shared__ __attribute__((aligned(16))) unsigned char lds[];
    Frame F;
    F.lds = (LAS unsigned char*)lds;
    F.MISC = (volatile LAS unsigned*)(F.lds + MISC_OFF);
    F.tid = threadIdx.x; F.lane = F.tid & 63; F.wave = __builtin_amdgcn_readfirstlane(F.tid >> 6);
    F.G = gridDim.x; { const int bx = blockIdx.x; F.vcu = (F.G % 8 == 0) ? (bx % 8) * (F.G / 8) + bx / 8 : bx; }
    F.ws = args.ws; F.ctl = (gu32*)(args.ws + WS_CTL); F.out = args.out;
    F.in = args.in;
    for (int u = F.tid; u < (LDS_BYTES - LDSCTL_OFF) / 4; u += NWAVES * 64) ((LAS unsigned*)(F.lds + LDSCTL_OFF))[u] = 0u;
    __syncthreads();
    XcdBarrier bar; bar.bar = (unsigned*)(F.ctl + CW_BAR); bar.x = 0; bar.st = nullptr;
    if (N_LAUNCHES != NPH) bar = xcd_barrier_post((unsigned*)(F.ctl + CW_BAR) + args.li * XCD_BAR_WORDS, F.MISC + 8);
#define GRID_BAR() do { if (N_LAUNCHES != NPH) xcd_barrier(bar); } while (0)
    const int lo = args.ph_lo, hi = args.ph_hi;
#define IN(k) (lo <= (k) && (k) < hi)
#define BOTH(k) (IN(k) && IN((k) + 1))
    using namespace pg8;
    const int cid = (int)blockIdx.x;

    if (IN(0)) { p0_prologue(F); if (BOTH(0)) GRID_BAR(); }
    if (IN(1)) { p1_lerp(F); if (BOTH(1)) GRID_BAR(); }
    if (IN(2)) {
        Gemm g{WSP(bf16_t, WS_A6) + (size_t)3 * T * D, WSP(bf16_t, WS_WL1), D, D, (size_t)T * D * 2, (size_t)256 * D * 2, nullptr, nullptr, 0};
        StaticOrder S; S.init(T / 256, 1, 3, F.G, cid);
        EpiBf16Z<1, 0, 2> E{WSP(bf16_t, WS_L1), 256, (size_t)T * 256};
        gemm_phase<EpiBf16Z<1, 0, 2>, StaticOrder, true>(F.lds, g, S, E);
        if (BOTH(2)) GRID_BAR();
    }
    if (IN(3)) {
        { Gemm g{WSP(bf16_t, WS_A6), WSP(bf16_t, WS_WRKV), D, D, (size_t)T * D * 2, (size_t)D * D * 2, nullptr, nullptr, 0};
          StaticOrder S; S.init(T / 256, D / 256, 3, F.G, cid);
          EpiBf16Z<0, 0, 0> E{WSP(bf16_t, WS_RB), D, (size_t)T * D};
          gemm_phase<EpiBf16Z<0, 0, 0>, StaticOrder, true>(F.lds, g, S, E); }
        { Gemm g{WSP(bf16_t, WS_L1), WSP(bf16_t, WS_WL2), 256, 256, (size_t)T * 256 * 2, (size_t)D * 256 * 2, nullptr, nullptr, 0};
          StaticOrder S; S.init(T / 256, D / 256, 3, F.G, cid);
          EpiLora2 E{F.out, WSP(bf16_t, WS_AS), WSP(bf16_t, WS_G), F.in[8], F.in[11]};
          gemm_phase<EpiLora2, StaticOrder, true>(F.lds, g, S, E); }
        if (BOTH(3)) GRID_BAR();
    }
    if (IN(4)) { p4_scan_seq(F); if (BOTH(4)) GRID_BAR(); }
    if (IN(5)) { p5_gnorm(F); if (BOTH(5)) GRID_BAR(); }
    if (IN(6)) {
        Gemm g{WSP(bf16_t, WS_YG), WSP(bf16_t, WS_WOUT), D, D, 0, 0, nullptr, nullptr, 0};
        StaticOrder S; S.init(T / 256, D / 256, 1, F.G, cid);
        EpiF32 E{WSP(float, WS_Y1), D};
        gemm_phase<EpiF32, StaticOrder, true>(F.lds, g, S, E);
        if (BOTH(6)) GRID_BAR();
    }
    if (IN(7)) { p_postnorm(F, F.in[0], WSP(float, WS_Y1), WSP(float, WS_X1), 0, (1 * 3 + 0) * D, WSP(bf16_t, WS_H2), 0, nullptr); if (BOTH(7)) GRID_BAR(); }
    if (IN(8)) {
        Gemm g{WSP(bf16_t, WS_H2), WSP(bf16_t, WS_WFGU), D, D, 0, 0, nullptr, nullptr, 0};
        StaticOrder S; S.init(T / 256, 2 * DFF / 256, 1, F.G, cid);
        EpiSwiglu E{WSP(bf16_t, WS_ACT), DFF};
        gemm_phase<EpiSwiglu, StaticOrder, true>(F.lds, g, S, E);
        if (BOTH(8)) GRID_BAR();
    }
    if (IN(9)) {
        Gemm g{WSP(bf16_t, WS_ACT), WSP(bf16_t, WS_WFDN), DFF, DFF, 0, 0, nullptr, nullptr, 0};
        StaticOrder S; S.init(T / 256, D / 256, 1, F.G, cid);
        EpiF32 E{WSP(float, WS_Y2), D};
        gemm_phase<EpiF32, StaticOrder, true>(F.lds, g, S, E);
        if (BOTH(9)) GRID_BAR();
    }
    if (IN(10)) { p_postnorm(F, WSP(float, WS_X1), WSP(float, WS_Y2), WSP(float, WS_X2), 1, 12 * D, WSP(bf16_t, WS_HKV), (2 * 3 + 0) * D, WSP(bf16_t, WS_H3)); if (BOTH(10)) GRID_BAR(); }
    if (IN(11)) {
        const float* cs = WSP(float, WS_ROPE); const float* sn = cs + SEQ * 32;
        { Gemm g{WSP(bf16_t, WS_HKV), WSP(bf16_t, WS_WKV), D, D, 0, 0, nullptr, nullptr, 0};
          StaticOrder S; S.init(T / 256, 2 * QW / 256, 1, F.G, cid);
          EpiRope E{WSP(bf16_t, WS_K2), WSP(bf16_t, WS_V2), QW, cs, sn, 1.f};
          gemm_phase<EpiRope, StaticOrder, true>(F.lds, g, S, E); }
        { Gemm g{WSP(bf16_t, WS_H3), WSP(bf16_t, WS_WQ), D, D, 0, 0, nullptr, nullptr, 0};
          StaticOrder S; S.init(T / 256, QW / 256, 1, F.G, cid);
          EpiRope E{WSP(bf16_t, WS_Q2), WSP(bf16_t, WS_Q2), QW, cs, sn, 0.125f};
          gemm_phase<EpiRope, StaticOrder, true>(F.lds, g, S, E); }
        if (BOTH(11)) GRID_BAR();
    }
    if (IN(12)) { p12_attn(F); if (BOTH(12)) GRID_BAR(); }
    if (IN(13)) { p13_merge(F); if (BOTH(13)) GRID_BAR(); }
    if (IN(14)) {
        Gemm g{WSP(bf16_t, WS_OM), WSP(bf16_t, WS_WO), AOUT, AOUT, 0, 0, nullptr, nullptr, 0};
        StaticOrder S; S.init(T / 256, D / 256, 1, F.G, cid);
        EpiF32 E{WSP(float, WS_Y3), D};
        gemm_phase<EpiF32, StaticOrder, true>(F.lds, g, S, E);
        if (BOTH(14)) GRID_BAR();
    }
    if (IN(15)) { p15_ln_route(F); if (BOTH(15)) GRID_BAR(); }
    if (IN(16)) { p16_place(F); if (BOTH(16)) GRID_BAR(); }
    if (IN(17)) {
        const int nblk = (int)__hip_atomic_load((unsigned*)(F.ctl + CW_NBLK), RLX_AGENT);
        Gemm g{WSP(bf16_t, WS_H4), WSP(bf16_t, WS_WMGU), D, D, 0, 0, (const int*)(F.ws + WS_ROUTE + RT_ROWTOK), (const int*)(F.ws + WS_ROUTE + RT_BLKEXP), (size_t)2 * DFE * D * 2};
        StaticOrder S; S.init(nblk, 2 * DFE / 256, 1, F.G, cid);
        EpiSwiglu E{WSP(bf16_t, WS_ACT2), DFE};
        gemm_phase<EpiSwiglu, StaticOrder, true>(F.lds, g, S, E);
        if (BOTH(17)) GRID_BAR();
    }
    if (IN(18)) {
        const int nblk = (int)__hip_atomic_load((unsigned*)(F.ctl + CW_NBLK), RLX_AGENT);
        Gemm g{WSP(bf16_t, WS_ACT2), WSP(bf16_t, WS_WMDN), DFE, DFE, 0, 0, nullptr, (const int*)(F.ws + WS_ROUTE + RT_BLKEXP), (size_t)D * DFE * 2};
        StaticOrder S; S.init(nblk, D / 256, 1, F.G, cid);
        EpiBf16Z<0, 0, 0> E{WSP(bf16_t, WS_YB), D, 0};
        gemm_phase<EpiBf16Z<0, 0, 0>, StaticOrder, true>(F.lds, g, S, E);
        if (BOTH(18)) GRID_BAR();
    }
    if (IN(19)) { p19_final(F); }
#undef IN
#undef BOTH
}

extern "C" void kernel_launch(void* const* d_in, const int* in_sizes, int n_in, void* d_out, int out_size, void* d_ws, size_t ws_size, hipStream_t stream) {
    static int grid = 0;
    if (grid == 0) {
        if (n_in != 30 || in_sizes[0] != T * D || out_size != T * D || ws_size < WS_END) { fprintf(stderr, "kernel_launch: unexpected shapes / workspace (%d inputs, ws %zu)\n", n_in, ws_size); grid = -1; return; }
        int dev = 0, cus = 0, per_cu = 0;
        if (hipGetDevice(&dev) != hipSuccess || hipDeviceGetAttribute(&cus, hipDeviceAttributeMultiprocessorCount, dev) != hipSuccess) { grid = -1; return; }
        if (hipFuncSetAttribute((const void*)fwd, hipFuncAttributeMaxDynamicSharedMemorySize, LDS_BYTES) != hipSuccess) { fprintf(stderr, "kernel_launch: hipFuncSetAttribute failed\n"); grid = -1; return; }
        if (hipOccupancyMaxActiveBlocksPerMultiprocessor(&per_cu, (const void*)fwd, NWAVES * 64, LDS_BYTES) != hipSuccess || per_cu < 1)
            fprintf(stderr, "kernel_launch: occupancy query reports %d workgroups per CU\n", per_cu);
        (void)hipGetLastError();
        grid = cus;
    }
    if (grid < 0) return;
    if (hipMemsetAsync((char*)d_ws + WS_CTL, 0, CTL_ZERO_BYTES, stream) != hipSuccess) return;
    Args a{};
    for (int i = 0; i < 30; ++i) a.in[i] = (const float*)d_in[i];
    a.out = (float*)d_out; a.ws = (unsigned char*)d_ws;
    for (int li = 0; li < N_LAUNCHES; ++li) {
        a.ph_lo = (N_LAUNCHES == NPH) ? li : 0; a.ph_hi = (N_LAUNCHES == NPH) ? li + 1 : NPH; a.li = (N_LAUNCHES == NPH) ? 0 : li;
        hipLaunchKernelGGL(fwd, dim3(grid), dim3(NWAVES * 64), LDS_BYTES, stream, a);
        if (hipPeekAtLastError() != hipSuccess) { fprintf(stderr, "kernel_launch: launch %d failed\n", li); break; }
    }
}
```

```cpp
#include <hip/hip_runtime.h>
#include <cstdio>
#include <cstdint>

#define LAS __attribute__((address_space(3)))
#define GAS __attribute__((address_space(1)))
typedef unsigned short bf16_t;
typedef short bf16x8 __attribute__((ext_vector_type(8)));
typedef short s16x4 __attribute__((ext_vector_type(4)));
typedef float f32x4 __attribute__((ext_vector_type(4)));
typedef float f32x2 __attribute__((ext_vector_type(2)));
typedef unsigned u32x4 __attribute__((ext_vector_type(4)));
typedef unsigned u32x2 __attribute__((ext_vector_type(2)));
typedef GAS unsigned gu32;
#define RLX_AGENT __ATOMIC_RELAXED, __HIP_MEMORY_SCOPE_AGENT

__device__ __forceinline__ unsigned cvt_pk_bf16(float lo, float hi) { unsigned r; asm volatile("v_cvt_pk_bf16_f32 %0, %1, %2" : "=v"(r) : "v"(lo), "v"(hi)); return r; }
__device__ __forceinline__ float bflo(unsigned w) { return __uint_as_float(w << 16); }
__device__ __forceinline__ float bfhi(unsigned w) { return __uint_as_float(w & 0xffff0000u); }
__device__ __forceinline__ float sigmoidf_(float x) { return 1.f / (1.f + __expf(-x)); }
__device__ __forceinline__ float tanhf_(float x) { return 1.f - 2.f / (1.f + __expf(2.f * x)); }
__device__ __forceinline__ float siluf_(float x) { return x / (1.f + __expf(-x)); }
__device__ __forceinline__ int ld_i32(const int* p) { return (int)__hip_atomic_load((const unsigned*)p, RLX_AGENT); }

constexpr int BATCH = 2, SEQ = 16384, D = 1024, T = BATCH * SEQ;
constexpr int ADA_W = 14336;
constexpr int DFF = 2816, NEXP = 8, DFE = 3584;
constexpr int QW = 1536, AOUT = 512;
constexpr int RMAX = (T * 2 / 256 + NEXP) * 256;
constexpr int NBLKMAX = RMAX / 256;
constexpr float LN_EPS = 1e-5f, LNX_EPS = 64e-5f;
constexpr float DN_ALPHA = 1.4142135623730951f;

namespace pg8 {
constexpr int BM = 256, BK = 64, HALF = 128, HTB = HALF * BK * 2, STAGE_BYTES = 8 * HTB, NXCD = 8, WGM = 8;
__host__ __device__ __forceinline__ int lds_byte(int r, int c) { const int st = (r >> 4) * 2 + (c >> 5), rr = r & 15, cc = c & 31, ob = rr * 64 + cc * 2; return st * 1024 + (ob ^ (((ob >> 9) & 1) << 5)); }
__host__ __device__ __forceinline__ void stage_rc(int b, int& R, int& C) { const int st = b / 1024, sb = b % 1024, swz = sb ^ (((sb >> 9) & 1) << 5); R = (st >> 1) * 16 + swz / 64; C = (st & 1) * 32 + (swz % 64) / 2; }
__host__ __device__ __forceinline__ int perm32(int rho) { const int n = rho >> 4, i = rho & 15; return 8 * (i >> 2) + 4 * n + (i & 3); }

struct Unit { int pm, pn, z; };
struct Gemm { const bf16_t* A; const bf16_t* Bt; int K, lda; size_t azs, bzs; const int* rowmap; const int* blk_exp; size_t bes; };

struct StaticOrder {
    int nM, nN, nZ, nwg, G, c;
    __device__ void init(int nM_, int nN_, int nZ_, int G_, int c_) { nM = nM_; nN = nN_; nZ = nZ_; nwg = nM * nN; G = G_; c = c_; }
    __device__ bool next(int i, Unit& u) const {
        const long L = (long)i * G + c; if (L >= (long)nwg * nZ) return false;
        u.z = (int)(L / nwg); int wgid = (int)(L % nwg);
        { const int q = nwg / NXCD, r = nwg % NXCD, xcd = wgid % NXCD, off = wgid / NXCD; wgid = (xcd < r ? xcd * (q + 1) : r * (q + 1) + (xcd - r) * q) + off; }
        const int nig = WGM * nN, gid = wgid / nig, fm = gid * WGM, gsz = (nM - fm) < WGM ? (nM - fm) : WGM;
        u.pm = fm + ((wgid % nig) % gsz); u.pn = (wgid % nig) / gsz; return true;
    }
};

#define EPI_LOOP_BEGIN \
    const int row0 = u.pm * BM + wr * 64 + fr, col0 = u.pn * BM + wc * 32 + 8 * fq; \
    _Pragma("unroll") for (int ai = 0; ai < 2; ++ai) _Pragma("unroll") for (int m = 0; m < 4; ++m) { const int row = row0 + ai * HALF + m * 16; \
    _Pragma("unroll") for (int bj = 0; bj < 2; ++bj) { const int col = col0 + bj * HALF; f32x4 v0 = acc[ai][bj][m][0], v1 = acc[ai][bj][m][1];
#define EPI_LOOP_END } }

__device__ __forceinline__ float act_apply(int a, float x) { return a == 1 ? tanhf_(x) : (a == 2 ? sigmoidf_(x) : x); }
template <int ACT0, int ACT1, int ACT2> struct EpiBf16Z {
    static constexpr bool PERM = true;
    bf16_t* O; int ldc; size_t ozs;
    __device__ __forceinline__ void operator()(const f32x4 (&acc)[2][2][4][2], const Unit& u, int wr, int wc, int fr, int fq) const {
        const int a = u.z == 0 ? ACT0 : (u.z == 1 ? ACT1 : ACT2); bf16_t* base = O + (size_t)u.z * ozs;
        EPI_LOOP_BEGIN
            if (a) { _Pragma("unroll") for (int e = 0; e < 4; ++e) { v0[e] = act_apply(a, v0[e]); v1[e] = act_apply(a, v1[e]); } }
            u32x4 w; w.x = cvt_pk_bf16(v0[0], v0[1]); w.y = cvt_pk_bf16(v0[2], v0[3]); w.z = cvt_pk_bf16(v1[0], v1[1]); w.w = cvt_pk_bf16(v1[2], v1[3]);
            *(u32x4*)(base + (size_t)row * ldc + col) = w;
        EPI_LOOP_END
    }
};
struct EpiLora2 {
    static constexpr bool PERM = true;
    float* WLOG; bf16_t* AS; bf16_t* G; const float* w0; const float* a0;
    __device__ __forceinline__ void operator()(const f32x4 (&acc)[2][2][4][2], const Unit& u, int wr, int wc, int fr, int fq) const {
        EPI_LOOP_BEGIN
            if (u.z == 0) {
                const f32x4 b0 = *(const f32x4*)(w0 + col), b1 = *(const f32x4*)(w0 + col + 4);
                _Pragma("unroll") for (int e = 0; e < 4; ++e) {
                    float x = -(v0[e] + b0[e]); float sp = fmaxf(x, 0.f) + __logf(1.f + __expf(-fabsf(x))); v0[e] = -__expf(-sp - 0.5f);
                    x = -(v1[e] + b1[e]); sp = fmaxf(x, 0.f) + __logf(1.f + __expf(-fabsf(x))); v1[e] = -__expf(-sp - 0.5f); }
                float* p = WLOG + (size_t)row * D + col; *(f32x4*)p = v0; *(f32x4*)(p + 4) = v1;
            } else {
                if (u.z == 1) { const f32x4 b0 = *(const f32x4*)(a0 + col), b1 = *(const f32x4*)(a0 + col + 4);
                    _Pragma("unroll") for (int e = 0; e < 4; ++e) { v0[e] = sigmoidf_(v0[e] + b0[e]); v1[e] = sigmoidf_(v1[e] + b1[e]); } }
                u32x4 w; w.x = cvt_pk_bf16(v0[0], v0[1]); w.y = cvt_pk_bf16(v0[2], v0[3]); w.z = cvt_pk_bf16(v1[0], v1[1]); w.w = cvt_pk_bf16(v1[2], v1[3]);
                *(u32x4*)((u.z == 1 ? AS : G) + (size_t)row * D + col) = w;
            }
        EPI_LOOP_END
    }
};
struct EpiF32 {
    static constexpr bool PERM = true;
    float* O; int ldc;
    __device__ __forceinline__ void operator()(const f32x4 (&acc)[2][2][4][2], const Unit& u, int wr, int wc, int fr, int fq) const {
        EPI_LOOP_BEGIN
            float* p = O + (size_t)row * ldc + col; *(f32x4*)p = v0; *(f32x4*)(p + 4) = v1;
        EPI_LOOP_END
    }
};
struct EpiSwiglu {
    static constexpr bool PERM = true;
    bf16_t* O; int ldo;
    __device__ __forceinline__ void operator()(const f32x4 (&acc)[2][2][4][2], const Unit& u, int wr, int wc, int fr, int fq) const {
        EPI_LOOP_BEGIN
            u32x2 w; w.x = cvt_pk_bf16(siluf_(v0[0]) * v0[1], siluf_(v0[2]) * v0[3]); w.y = cvt_pk_bf16(siluf_(v1[0]) * v1[1], siluf_(v1[2]) * v1[3]);
            *(u32x2*)(O + (size_t)row * ldo + (col >> 1)) = w;
        EPI_LOOP_END
    }
};
struct EpiRope {
    static constexpr bool PERM = true;
    bf16_t* O; bf16_t* O2; int ncol_rope; const float* cs; const float* sn; float scale;
    __device__ __forceinline__ void operator()(const f32x4 (&acc)[2][2][4][2], const Unit& u, int wr, int wc, int fr, int fq) const {
        EPI_LOOP_BEGIN
            bf16_t* dst;
            if (col < ncol_rope) {
                const int t = row & (SEQ - 1), i0 = (col & 63) >> 1;
                const f32x4 c4 = *(const f32x4*)(cs + (size_t)t * 32 + i0), s4 = *(const f32x4*)(sn + (size_t)t * 32 + i0);
                float a, b;
                a = v0[0]; b = v0[1]; v0[0] = (a * c4[0] - b * s4[0]) * scale; v0[1] = (b * c4[0] + a * s4[0]) * scale;
                a = v0[2]; b = v0[3]; v0[2] = (a * c4[1] - b * s4[1]) * scale; v0[3] = (b * c4[1] + a * s4[1]) * scale;
                a = v1[0]; b = v1[1]; v1[0] = (a * c4[2] - b * s4[2]) * scale; v1[1] = (b * c4[2] + a * s4[2]) * scale;
                a = v1[2]; b = v1[3]; v1[2] = (a * c4[3] - b * s4[3]) * scale; v1[3] = (b * c4[3] + a * s4[3]) * scale;
                dst = O + (size_t)row * ncol_rope + col;
            } else dst = O2 + (size_t)row * ncol_rope + (col - ncol_rope);
            u32x4 w; w.x = cvt_pk_bf16(v0[0], v0[1]); w.y = cvt_pk_bf16(v0[2], v0[3]); w.z = cvt_pk_bf16(v1[0], v1[1]); w.w = cvt_pk_bf16(v1[2], v1[3]);
            *(u32x4*)dst = w;
        EPI_LOOP_END
    }
};

template <class Epi, class Sched, bool ALIGN_EPI>
__device__ __forceinline__ void gemm_phase(LAS unsigned char* lds, const Gemm g, const Sched& S, const Epi& E) {
    const int tid = threadIdx.x, wid = __builtin_amdgcn_readfirstlane(tid >> 6), lane = tid & 63, wr = wid >> 2, wc = wid & 3, fr = lane & 15, fq = lane >> 4;
    const int K = g.K, nt = K / BK;
    int RA[2], CA[2]; unsigned voffB[2];
#pragma unroll
    for (int i = 0; i < 2; ++i) { int R, C; stage_rc(tid * 16 + i * 8192, R, C); const int Rb = Epi::PERM ? ((R & ~31) + perm32(R & 31)) : R;
        RA[i] = R; CA[i] = C; voffB[i] = (unsigned)(Rb * K + C) * 2u; }
    const size_t kstep = (size_t)(BK * 2);
    const size_t hstepB = (size_t)HALF * K * 2, tstepB = 2 * hstepB;
    const unsigned ldsw = (unsigned)wid * 1024u;
    const int aoff = lds_byte(wr * 64 + fr, fq * 8), boff = lds_byte(wc * 32 + fr, fq * 8);
#define PG8_SA(b, h) (((b) * 2 + (h)) * HTB)
#define PG8_SB(b, h) ((4 + (b) * 2 + (h)) * HTB)
#define PG8_STAGE(bufoff, gbase, voff) do { _Pragma("unroll") for (int _i = 0; _i < 2; ++_i) \
        __builtin_amdgcn_global_load_lds((const unsigned*)((const char*)(gbase) + (voff)[_i]), (LAS unsigned*)(lds + (bufoff) + ldsw + _i * 8192), 16, 0, 0); } while (0)
#define PG8_VOFFA(v, uu) do { _Pragma("unroll") for (int _h = 0; _h < 2; ++_h) _Pragma("unroll") for (int _i = 0; _i < 2; ++_i) { int _row = (uu).pm * BM + _h * HALF + RA[_i]; \
        if (g.rowmap) _row = g.rowmap[_row]; (v)[_h][_i] = (unsigned)((size_t)(uu).z * g.azs) + (unsigned)(_row * g.lda + CA[_i]) * 2u; } } while (0)
#define PG8_BBASE(uu) ((const char*)g.Bt + (size_t)(uu).z * g.bzs + (g.blk_exp ? (size_t)ld_i32(g.blk_exp + (uu).pm) * g.bes : (size_t)0) + (size_t)(uu).pn * tstepB)
#define PG8_LDA(dst, b, h) do { _Pragma("unroll") for (int m = 0; m < 4; ++m) _Pragma("unroll") for (int k = 0; k < 2; ++k) dst[m][k] = *(const LAS bf16x8*)(lds + PG8_SA(b, h) + aoff + m * 2048 + k * 1024); } while (0)
#define PG8_LDB(dst, b, h) do { _Pragma("unroll") for (int n = 0; n < 2; ++n) _Pragma("unroll") for (int k = 0; k < 2; ++k) dst[n][k] = *(const LAS bf16x8*)(lds + PG8_SB(b, h) + boff + n * 2048 + k * 1024); } while (0)
#define PG8_MMA(ai, bj, At, Bt) do { __builtin_amdgcn_s_setprio(1); _Pragma("unroll") for (int m = 0; m < 4; ++m) _Pragma("unroll") for (int n = 0; n < 2; ++n) _Pragma("unroll") for (int k = 0; k < 2; ++k) \
        acc[ai][bj][m][n] = __builtin_amdgcn_mfma_f32_16x16x32_bf16(Bt[n][k], At[m][k], acc[ai][bj][m][n], 0, 0, 0); __builtin_amdgcn_s_setprio(0); } while (0)
#define PG8_WAIT_V(n) asm volatile("s_waitcnt vmcnt(" #n ")" ::: "memory")
#define PG8_WAIT_L(n) asm volatile("s_waitcnt lgkmcnt(" #n ")" ::: "memory")
#define PG8_BAR __builtin_amdgcn_s_barrier()
#define PG8_SCHED __builtin_amdgcn_sched_barrier(0)
    Unit cur, nxt; int ui = 0;
    if (!S.next(0, cur)) return;
    f32x4 acc[2][2][4][2];
#pragma unroll
    for (int a = 0; a < 2; ++a)
#pragma unroll
        for (int b = 0; b < 2; ++b)
#pragma unroll
            for (int m = 0; m < 4; ++m)
#pragma unroll
                for (int n = 0; n < 2; ++n) acc[a][b][m][n] = (f32x4){0.f, 0.f, 0.f, 0.f};
    bf16x8 At[4][2], B0[2][2], B1[2][2];
    unsigned vc[2][2], vn[2][2];
    const char* const Ab = (const char*)g.A;
    const char* cB = PG8_BBASE(cur);
    PG8_VOFFA(vc, cur);
    PG8_STAGE(PG8_SB(0, 0), cB, voffB); PG8_STAGE(PG8_SB(0, 1), cB + hstepB, voffB); PG8_STAGE(PG8_SA(0, 0), Ab, vc[0]); PG8_STAGE(PG8_SA(0, 1), Ab, vc[1]);
    if (wr == 1) PG8_BAR;
    PG8_WAIT_V(2); PG8_BAR;
    PG8_STAGE(PG8_SB(1, 0), cB + kstep, voffB); PG8_STAGE(PG8_SA(1, 0), Ab + kstep, vc[0]); PG8_STAGE(PG8_SB(1, 1), cB + hstepB + kstep, voffB);
    PG8_WAIT_V(6); PG8_BAR;
    for (;;) {
        const bool has_next = S.next(ui + 1, nxt);
        const char* nB = cB;
        if (has_next) { nB = PG8_BBASE(nxt); PG8_VOFFA(vn, nxt); }
        else {
#pragma unroll
            for (int h = 0; h < 2; ++h)
#pragma unroll
                for (int i = 0; i < 2; ++i) vn[h][i] = vc[h][i];
        }
        for (int t = 0; t < nt; t += 2) {
            const bool last = (t == nt - 2);
            const char* a1 = Ab + (size_t)(t + 1) * kstep;
            const char* a2 = last ? Ab : Ab + (size_t)(t + 2) * kstep; const char* b2 = last ? nB : cB + (size_t)(t + 2) * kstep;
            const char* a3 = a2 + kstep; const char* b3 = b2 + kstep;
            unsigned v2[2][2];
#pragma unroll
            for (int h = 0; h < 2; ++h)
#pragma unroll
                for (int i = 0; i < 2; ++i) v2[h][i] = last ? vn[h][i] : vc[h][i];
            PG8_LDB(B0, 0, 0); PG8_LDB(B1, 0, 1); PG8_SCHED; PG8_LDA(At, 0, 0); PG8_STAGE(PG8_SA(1, 1), a1, vc[1]);
            PG8_WAIT_V(8); PG8_WAIT_L(0); PG8_BAR; PG8_MMA(0, 0, At, B0); PG8_MMA(0, 1, At, B1); PG8_BAR; PG8_SCHED;
            PG8_LDA(At, 0, 1); PG8_STAGE(PG8_SB(0, 0), b2, voffB); PG8_STAGE(PG8_SB(0, 1), b2 + hstepB, voffB); PG8_STAGE(PG8_SA(0, 0), a2, v2[0]);
            PG8_WAIT_V(8); PG8_WAIT_L(0); PG8_BAR; PG8_MMA(1, 0, At, B0); PG8_MMA(1, 1, At, B1); PG8_BAR; PG8_SCHED;
            PG8_LDB(B0, 1, 0); PG8_LDB(B1, 1, 1); PG8_SCHED; PG8_LDA(At, 1, 0); PG8_STAGE(PG8_SA(0, 1), a2, v2[1]);
            PG8_WAIT_V(8); PG8_WAIT_L(0); PG8_BAR; PG8_MMA(0, 0, At, B0); PG8_MMA(0, 1, At, B1); PG8_BAR; PG8_SCHED;
            PG8_LDA(At, 1, 1); PG8_STAGE(PG8_SB(1, 0), b3, voffB); PG8_STAGE(PG8_SB(1, 1), b3 + hstepB, voffB); PG8_STAGE(PG8_SA(1, 0), a3, v2[0]);
            PG8_WAIT_V(8); PG8_WAIT_L(0); PG8_BAR; PG8_MMA(1, 0, At, B0); PG8_MMA(1, 1, At, B1); PG8_BAR; PG8_SCHED;
        }
        if constexpr (ALIGN_EPI) { if (wr == 0) PG8_BAR; }
        E(acc, cur, wr, wc, fr, fq);
        if (!has_next) break;
#pragma unroll
        for (int a = 0; a < 2; ++a)
#pragma unroll
            for (int b = 0; b < 2; ++b)
#pragma unroll
                for (int m = 0; m < 4; ++m)
#pragma unroll
                    for (int n = 0; n < 2; ++n) acc[a][b][m][n] = (f32x4){0.f, 0.f, 0.f, 0.f};
        cur = nxt; cB = nB; ++ui;
#pragma unroll
        for (int h = 0; h < 2; ++h)
#pragma unroll
            for (int i = 0; i < 2; ++i) vc[h][i] = vn[h][i];
        if constexpr (ALIGN_EPI) { if (wr == 1) PG8_BAR; }
    }
    PG8_WAIT_V(0);
    if constexpr (!ALIGN_EPI) { if (wr == 0) PG8_BAR; }
    PG8_BAR;
#undef PG8_SA
#undef PG8_SB
#undef PG8_STAGE
#undef PG8_VOFFA
#undef PG8_BBASE
#undef PG8_LDA
#undef PG8_LDB
#undef PG8_MMA
#undef PG8_WAIT_V
#undef PG8_WAIT_L
#undef PG8_BAR
#undef PG8_SCHED
}
}

constexpr int NWAVES = 8;
constexpr int NPH = 20;
#ifndef MK_N_LAUNCHES
#define MK_N_LAUNCHES 1
#endif
constexpr int N_LAUNCHES = MK_N_LAUNCHES;

constexpr size_t MiB = 1u << 20;
constexpr size_t WS_CTL = 0, CTL_ZERO_BYTES = 1 * MiB;
constexpr size_t WS_MOD = 1 * MiB;
constexpr size_t WS_ROPE = 2 * MiB;
constexpr size_t WS_WRKV = 6 * MiB;
constexpr size_t WS_WL1 = 12 * MiB;
constexpr size_t WS_WL2 = 14 * MiB;
constexpr size_t WS_WOUT = 16 * MiB;
constexpr size_t WS_WFGU = 18 * MiB;
constexpr size_t WS_WFDN = 29 * MiB;
constexpr size_t WS_WKV = 35 * MiB;
constexpr size_t WS_WQ = 41 * MiB;
constexpr size_t WS_WO = 44 * MiB;
constexpr size_t WS_WMGU = 46 * MiB;
constexpr size_t WS_WMDN = 158 * MiB;
constexpr size_t WS_AR = 216 * MiB;
constexpr size_t AR(size_t mib) { return WS_AR + mib * MiB; }
constexpr size_t WS_A6 = AR(0);
constexpr size_t WS_L1 = AR(384);
constexpr size_t WS_RB = AR(432), WS_KB = AR(496), WS_VB = AR(560);
constexpr size_t WS_AS = AR(192), WS_G = AR(256);
constexpr size_t WS_YS = AR(0);
constexpr size_t WS_YG = AR(128);
constexpr size_t WS_Y1 = AR(320);
constexpr size_t WS_X1 = AR(448);
constexpr size_t WS_H2 = AR(576);
constexpr size_t WS_ACT = AR(0);
constexpr size_t WS_Y2 = AR(176);
constexpr size_t WS_X2 = AR(304);
constexpr size_t WS_HKV = AR(0), WS_H3 = AR(64);
constexpr size_t WS_K2 = AR(128), WS_V2 = AR(432), WS_Q2 = AR(528);
constexpr size_t WS_OG = AR(0);
constexpr size_t WS_LSE = AR(96);
constexpr size_t WS_OM = AR(224);
constexpr size_t WS_Y3 = AR(432);
constexpr size_t WS_H4 = AR(0);
constexpr size_t WS_ROUTE = AR(66);
constexpr size_t WS_ACT2 = AR(70);
constexpr size_t WS_YB = AR(532);
constexpr size_t WS_END = AR(664);
static_assert(WS_END <= 896 * MiB, "workspace");
static_assert((size_t)RMAX * DFE * 2 <= 462 * MiB && (size_t)RMAX * D * 2 <= 132 * MiB, "moe buffers");
constexpr size_t RT_TOKE = 0;
constexpr size_t RT_TOKR = 256 * 1024;
constexpr size_t RT_TOKW = 512 * 1024;
constexpr size_t RT_ROWTOK = 768 * 1024;
constexpr size_t RT_BLKEXP = 1280 * 1024;
constexpr int CW_BAR = 4096;
constexpr int CW_CNT = 16384;
constexpr int CW_NBLK = 16448;

constexpr int RING_BYTES = 131072;
constexpr int LDSCTL_OFF = RING_BYTES, MISC_OFF = LDSCTL_OFF + 320;
constexpr int LDS_BYTES = 147456;

#define LDS_WAIT() asm volatile("s_waitcnt lgkmcnt(0)" ::: "memory")
#define VM_WAIT() asm volatile("s_waitcnt vmcnt(0)" ::: "memory")

#define XB_TMO      128
#define XB_XCNT(j)  (256  + 64 * (j))
#define XB_XSUB(j)  (1280 + 64 * (j))
#define XB_XGEN(j)  (2304 + 64 * (j))
#define XB_TOP      3328
#define XB_TOPGEN   3392
#define XCD_BAR_WORDS 3456
#define XB_SPIN_CAP (1u << 22)

__device__ __forceinline__ unsigned xb_ld(unsigned* p)              { return __hip_atomic_load(p, __ATOMIC_RELAXED, __HIP_MEMORY_SCOPE_AGENT); }
__device__ __forceinline__ unsigned xb_add(unsigned* p, unsigned v) { return __hip_atomic_fetch_add(p, v, __ATOMIC_RELAXED, __HIP_MEMORY_SCOPE_AGENT); }
__device__ __forceinline__ unsigned xb_xcc_id() { return (unsigned)__builtin_amdgcn_s_getreg((3 << 11) | 20) & 0xFu; }
#define XB_SPIN(cond, bar) do { unsigned _sp = 0; while (cond) { __builtin_amdgcn_s_sleep(1); \
    if ((++_sp & 255u) == 0u) { if (xb_ld(&(bar)[XB_TMO])) break; if (_sp > XB_SPIN_CAP) { atomicAdd(&(bar)[XB_TMO], 1u); break; } } } } while (0)

struct XcdBarrier { unsigned* bar; unsigned x; volatile LAS unsigned* st; };
__device__ __forceinline__ XcdBarrier xcd_barrier_post(unsigned* bar, volatile LAS unsigned* st) {
    XcdBarrier b; b.bar = bar; b.x = xb_xcc_id(); b.st = st;
    if (threadIdx.x == 0) (void)xb_add(&bar[XB_XCNT(b.x)], 1u);
    return b;
}
__device__ __forceinline__ void xcd_barrier_complete(unsigned* bar, unsigned x, unsigned& nloc, unsigned& nx) {
    const unsigned G = gridDim.x * gridDim.y * gridDim.z;
    unsigned sum, cnt, mine, sp = 0u;
    for (;;) {
        sum = 0u; cnt = 0u; mine = 0u;
#pragma unroll
        for (unsigned j = 0; j < 16; ++j) { const unsigned c = xb_ld(&bar[XB_XCNT(j)]); sum += c; cnt += (c > 0u) ? 1u : 0u; mine = (j == x) ? c : mine; }
        if (sum == G) break;
        __builtin_amdgcn_s_sleep(1);
        if ((++sp & 255u) == 0u) { if (xb_ld(&bar[XB_TMO])) break; if (sp > XB_SPIN_CAP) { atomicAdd(&bar[XB_TMO], 1u); break; } }
    }
    nloc = mine > 0u ? mine : 1u; nx = cnt > 0u ? cnt : 1u;
}
__device__ __forceinline__ void xcd_barrier(const XcdBarrier& b) {
    asm volatile("s_waitcnt vmcnt(0)" ::: "memory");
    __syncthreads();
    if (threadIdx.x == 0) {
        unsigned* bar = b.bar;
        __builtin_amdgcn_s_waitcnt(0);
        unsigned nloc = b.st[0], nx = b.st[1];
        if (nloc == 0u) { xcd_barrier_complete(bar, b.x, nloc, nx); b.st[0] = nloc; b.st[1] = nx; }
        const unsigned old = xb_add(&bar[XB_XSUB(b.x)], 1u);
        const unsigned gen = old / nloc;
        if (old + 1u == (gen + 1u) * nloc) {
            __builtin_amdgcn_fence(__ATOMIC_RELEASE, "agent");
            asm volatile("s_waitcnt vmcnt(0)" ::: "memory");
            const unsigned og = xb_add(&bar[XB_TOP], 1u);
            const unsigned tg = og / nx;
            if (og + 1u == (tg + 1u) * nx) xb_add(&bar[XB_TOPGEN], 1u);
            else XB_SPIN(xb_ld(&bar[XB_TOPGEN]) == tg, bar);
            __builtin_amdgcn_fence(__ATOMIC_ACQUIRE, "agent");
            xb_add(&bar[XB_XGEN(b.x)], 1u);
            asm volatile("s_waitcnt vmcnt(0)" ::: "memory");
        } else {
            XB_SPIN(xb_ld(&bar[XB_XGEN(b.x)]) == gen, bar);
            __builtin_amdgcn_fence(__ATOMIC_ACQUIRE, "agent");
            asm volatile("s_waitcnt vmcnt(0)" ::: "memory");
        }
    }
    __syncthreads();
}

struct Frame {
    LAS unsigned char* lds;
    volatile LAS unsigned* MISC;
    gu32* ctl;
    int tid, lane, wave;
    int vcu, G;
    const float* const* in;
    float* out;
    unsigned char* ws;
};
#define WSP(type, off) ((type*)(F.ws + (off)))

__device__ __forceinline__ float wave_sum(float v) {
#pragma unroll
    for (int o = 1; o < 64; o <<= 1) v += __shfl_xor(v, o);
    return v;
}

__device__ __forceinline__ int colmap(int kind, int half, int n) {
    if (kind == 1) return (n & 1) ? half + (n >> 1) : (n >> 1);
    if (kind == 2 || (kind == 3 && n < QW)) { const int hd = n >> 6, p = n & 63; return hd * 64 + ((p & 1) * 32 + (p >> 1)); }
    return n;
}
__device__ __forceinline__ void cvt_item(const float* W, int ldw, int Kv, int Nv, bf16_t* WT, int Kout, int Nout, int kind, int half, LAS float* scr, int item, int lane) {
    const int nblk = Nout / 32, kb = item / nblk, nb = item % nblk, k0 = 64 * kb, n0 = 32 * nb;
    const int nn = n0 + (lane & 31); const int sc = colmap(kind, half, nn); const bool nok = nn < Nv;
#pragma unroll 8
    for (int i = 0; i < 32; ++i) { const int kk = 2 * i + (lane >> 5); float v = 0.f; if (nok && (k0 + kk) < Kv) v = W[(size_t)(k0 + kk) * ldw + sc]; scr[kk * 33 + (lane & 31)] = v; }
    LDS_WAIT(); asm volatile("" ::: "memory");
    const int c = lane & 7;
#pragma unroll
    for (int j = 0; j < 4; ++j) { const int n = (lane >> 3) + 8 * j; const LAS float* s = scr + (8 * c) * 33 + n;
        u32x4 o; o.x = cvt_pk_bf16(s[0 * 33], s[1 * 33]); o.y = cvt_pk_bf16(s[2 * 33], s[3 * 33]); o.z = cvt_pk_bf16(s[4 * 33], s[5 * 33]); o.w = cvt_pk_bf16(s[6 * 33], s[7 * 33]);
        *(u32x4*)(WT + (size_t)(n0 + n) * Kout + k0 + 8 * c) = o; }
    LDS_WAIT(); asm volatile("" ::: "memory");
}
__device__ __forceinline__ void p0_prologue(Frame& F) {
    {
        LAS float* part = (LAS float*)F.lds;
        const float* c = F.in[1]; const float* aw = F.in[2]; const float* ab = F.in[3]; float* MOD = WSP(float, WS_MOD);
        for (int it = F.vcu; it < ADA_W / 64; it += F.G) {
            const int j = it * 64 + F.lane; float s0 = 0.f, s1 = 0.f;
#pragma unroll 8
            for (int k = F.wave * 128; k < F.wave * 128 + 128; ++k) { const float w = aw[(size_t)k * ADA_W + j]; s0 += siluf_(c[k]) * w; s1 += siluf_(c[D + k]) * w; }
            part[(F.wave * 2 + 0) * 64 + F.lane] = s0; part[(F.wave * 2 + 1) * 64 + F.lane] = s1;
            __syncthreads();
            if (F.wave < 2) { float s = ab[j];
#pragma unroll
                for (int w = 0; w < 8; ++w) s += part[(w * 2 + F.wave) * 64 + F.lane];
                MOD[F.wave * ADA_W + j] = s; }
            __syncthreads();
        }
    }
    {
        float* cs = WSP(float, WS_ROPE); float* sn = cs + SEQ * 32;
        for (int idx = F.vcu * 512 + F.tid; idx < SEQ * 32; idx += F.G * 512) {
            const int t = idx >> 5, i = idx & 31;
            const float inv = powf(10000.0f, -(float)i / 32.0f); const float ang = (float)t * inv;
            cs[idx] = cosf(ang); sn[idx] = sinf(ang);
        }
    }
    LAS float* scr = (LAS float*)(F.lds + F.wave * 16384);
    const int gw = F.vcu * NWAVES + F.wave, NGW = F.G * NWAVES;
    constexpr int I_RKV = 16 * 96, I_L1 = 16 * 8, I_L2 = 4 * 32, I_OUT = 16 * 32, I_FGU = 16 * 176, I_FDN = 44 * 32, I_KV = 16 * 96, I_Q = 16 * 48, I_O = 8 * 32, I_MGU = 16 * 224, I_MDN = 56 * 32;
    constexpr int NITEMS = I_RKV + 3 * I_L1 + 3 * I_L2 + I_OUT + I_FGU + I_FDN + I_KV + I_Q + I_O + 8 * I_MGU + 8 * I_MDN;
    for (int it = gw; it < NITEMS; it += NGW) {
        int r = it;
        if (r < 8 * I_MGU) { const int e = r / I_MGU; cvt_item(F.in[28] + (size_t)e * D * 2 * DFE, 2 * DFE, D, 2 * DFE, WSP(bf16_t, WS_WMGU) + (size_t)e * 2 * DFE * D, D, 2 * DFE, 1, DFE, scr, r % I_MGU, F.lane); continue; } r -= 8 * I_MGU;
        if (r < 8 * I_MDN) { const int e = r / I_MDN; cvt_item(F.in[29] + (size_t)e * DFE * D, D, DFE, D, WSP(bf16_t, WS_WMDN) + (size_t)e * D * DFE, DFE, D, 0, 0, scr, r % I_MDN, F.lane); continue; } r -= 8 * I_MDN;
        if (r < I_RKV) { cvt_item(F.in[7], 3 * D, D, 3 * D, WSP(bf16_t, WS_WRKV), D, 3 * D, 0, 0, scr, r, F.lane); continue; } r -= I_RKV;
        if (r < I_L1) { cvt_item(F.in[9], 64, D, 64, WSP(bf16_t, WS_WL1), D, 256, 0, 0, scr, r, F.lane); continue; } r -= I_L1;
        if (r < I_L1) { cvt_item(F.in[12], 64, D, 64, WSP(bf16_t, WS_WL1) + 256 * D, D, 256, 0, 0, scr, r, F.lane); continue; } r -= I_L1;
        if (r < I_L1) { cvt_item(F.in[14], 160, D, 160, WSP(bf16_t, WS_WL1) + 2 * 256 * D, D, 256, 0, 0, scr, r, F.lane); continue; } r -= I_L1;
        if (r < I_L2) { cvt_item(F.in[10], D, 64, D, WSP(bf16_t, WS_WL2), 256, D, 0, 0, scr, r, F.lane); continue; } r -= I_L2;
        if (r < I_L2) { cvt_item(F.in[13], D, 64, D, WSP(bf16_t, WS_WL2) + D * 256, 256, D, 0, 0, scr, r, F.lane); continue; } r -= I_L2;
        if (r < I_L2) { cvt_item(F.in[15], D, 160, D, WSP(bf16_t, WS_WL2) + 2 * D * 256, 256, D, 0, 0, scr, r, F.lane); continue; } r -= I_L2;
        if (r < I_OUT) { cvt_item(F.in[21], D, D, D, WSP(bf16_t, WS_WOUT), D, D, 0, 0, scr, r, F.lane); continue; } r -= I_OUT;
        if (r < I_FGU) { cvt_item(F.in[25], 2 * DFF, D, 2 * DFF, WSP(bf16_t, WS_WFGU), D, 2 * DFF, 1, DFF, scr, r, F.lane); continue; } r -= I_FGU;
        if (r < I_FDN) { cvt_item(F.in[26], D, DFF, D, WSP(bf16_t, WS_WFDN), DFF, D, 0, 0, scr, r, F.lane); continue; } r -= I_FDN;
        if (r < I_KV) { cvt_item(F.in[22], 2 * QW, D, 2 * QW, WSP(bf16_t, WS_WKV), D, 2 * QW, 3, 0, scr, r, F.lane); continue; } r -= I_KV;
        if (r < I_Q) { cvt_item(F.in[23], QW, D, QW, WSP(bf16_t, WS_WQ), D, QW, 2, 0, scr, r, F.lane); continue; } r -= I_Q;
        cvt_item(F.in[24], D, AOUT, D, WSP(bf16_t, WS_WO), AOUT, D, 0, 0, scr, r, F.lane);
    }
}

__device__ __forceinline__ void p1_lerp(Frame& F) {
    const int gw = F.vcu * NWAVES + F.wave, NGW = F.G * NWAVES;
    const float* x = F.in[0]; const float* mu = F.in[6]; const float* MOD = WSP(float, WS_MOD); bf16_t* A6 = WSP(bf16_t, WS_A6);
    for (int m = gw; m < T; m += NGW) {
        const int b = m >> 14, t = m & (SEQ - 1);
#pragma unroll
        for (int j = 0; j < 4; ++j) {
            const int c = 4 * F.lane + 256 * j;
            const f32x4 sh = *(const f32x4*)(MOD + b * ADA_W + 0 * D + c), sc = *(const f32x4*)(MOD + b * ADA_W + 1 * D + c);
            const f32x4 xc = *(const f32x4*)(x + (size_t)m * D + c);
            const f32x4 hc = xc * (1.f + sc) + sh;
            f32x4 hp = (f32x4){0.f, 0.f, 0.f, 0.f};
            if (t > 0) { const f32x4 xp = *(const f32x4*)(x + (size_t)(m - 1) * D + c); hp = xp * (1.f + sc) + sh; }
            const f32x4 xx = hp - hc;
#pragma unroll
            for (int p = 0; p < 6; ++p) {
                const f32x4 mv = *(const f32x4*)(mu + p * D + c); const f32x4 o = hc + xx * mv;
                u32x2 w; w.x = cvt_pk_bf16(o[0], o[1]); w.y = cvt_pk_bf16(o[2], o[3]);
                *(u32x2*)(A6 + (size_t)p * T * D + (size_t)m * D + c) = w;
            }
        }
    }
}

__device__ __forceinline__ float sum16(float v) { v += __shfl_xor(v, 1); v += __shfl_xor(v, 2); v += __shfl_xor(v, 4); v += __shfl_xor(v, 8); return v; }
__device__ __forceinline__ void p4_scan_seq(Frame& F) {
    constexpr int TC = 32;
    LAS float* Rs = (LAS float*)F.lds; LAS float* Ws = Rs + TC * 64; LAS float* Ks = Ws + TC * 64; LAS float* As = Ks + TC * 64; LAS float* Bs = As + TC * 64;
    LAS float* Vs = Bs + TC * 64; LAS float* Ys = Vs + TC * 32;
    const bf16_t* RB = WSP(bf16_t, WS_RB); const bf16_t* KB = WSP(bf16_t, WS_KB); const bf16_t* VB = WSP(bf16_t, WS_VB); const bf16_t* AS = WSP(bf16_t, WS_AS);
    const float* WLOG = F.out; float* YS = WSP(float, WS_YS);
    const float* k_k = F.in[16]; const float* k_a = F.in[17];
    for (int unit = blockIdx.x; unit < 64; unit += F.G) {
        const int b = unit >> 5, h = (unit >> 1) & 15, vh = unit & 1;
        const int kq = F.lane & 15, vl = F.wave * 4 + (F.lane >> 4);
        const int ts = F.tid >> 4, skq = F.tid & 15, scol = h * 64 + 4 * skq;
        const f32x4 kk4 = *(const f32x4*)(k_k + scol), ka4 = *(const f32x4*)(k_a + scol);
        f32x4 S = (f32x4){0.f, 0.f, 0.f, 0.f};
        for (int chunk = 0; chunk < SEQ / TC; ++chunk) {
            {
                const size_t m = (size_t)b * SEQ + chunk * TC + ts;
                const u32x2 rw = *(const u32x2*)(RB + m * D + scol), kw = *(const u32x2*)(KB + m * D + scol), aw = *(const u32x2*)(AS + m * D + scol);
                const f32x4 wl = *(const f32x4*)(WLOG + m * D + scol);
                const f32x4 r4 = (f32x4){bflo(rw.x), bfhi(rw.x), bflo(rw.y), bfhi(rw.y)}, k4 = (f32x4){bflo(kw.x), bfhi(kw.x), bflo(kw.y), bfhi(kw.y)}, a4 = (f32x4){bflo(aw.x), bfhi(aw.x), bflo(aw.y), bfhi(aw.y)};
                f32x4 kkv = k4 * kk4; float ss = kkv[0] * kkv[0] + kkv[1] * kkv[1] + kkv[2] * kkv[2] + kkv[3] * kkv[3]; ss = sum16(ss);
                const float inv = 1.f / fmaxf(sqrtf(ss), 1e-12f); kkv = kkv * inv;
                const f32x4 kp = k4 * (1.f + (a4 - 1.f) * ka4), bb = kkv * a4;
                f32x4 w4; w4[0] = __expf(wl[0]); w4[1] = __expf(wl[1]); w4[2] = __expf(wl[2]); w4[3] = __expf(wl[3]);
                *(LAS f32x4*)(Rs + ts * 64 + 4 * skq) = r4; *(LAS f32x4*)(Ws + ts * 64 + 4 * skq) = w4; *(LAS f32x4*)(Ks + ts * 64 + 4 * skq) = kp;
                *(LAS f32x4*)(As + ts * 64 + 4 * skq) = -kkv; *(LAS f32x4*)(Bs + ts * 64 + 4 * skq) = bb;
                if (skq < 8) { const u32x2 vw = *(const u32x2*)(VB + m * D + h * 64 + vh * 32 + 4 * skq);
                    *(LAS f32x4*)(Vs + ts * 32 + 4 * skq) = (f32x4){bflo(vw.x), bfhi(vw.x), bflo(vw.y), bfhi(vw.y)}; }
            }
            __syncthreads();
            for (int tt = 0; tt < TC; ++tt) {
                const f32x4 a4 = *(const LAS f32x4*)(As + tt * 64 + 4 * kq), w4 = *(const LAS f32x4*)(Ws + tt * 64 + 4 * kq), b4 = *(const LAS f32x4*)(Bs + tt * 64 + 4 * kq);
                const f32x4 k4 = *(const LAS f32x4*)(Ks + tt * 64 + 4 * kq), r4 = *(const LAS f32x4*)(Rs + tt * 64 + 4 * kq);
                const float vv = Vs[tt * 32 + vl];
                float sa = S[0] * a4[0] + S[1] * a4[1] + S[2] * a4[2] + S[3] * a4[3]; sa = sum16(sa);
                S = S * w4 + sa * b4 + vv * k4;
                float y = S[0] * r4[0] + S[1] * r4[1] + S[2] * r4[2] + S[3] * r4[3]; y = sum16(y);
                if (kq == 0) Ys[tt * 32 + vl] = y;
            }
            __syncthreads();
            { const int idx = F.tid * 2, tt = idx >> 5, v = idx & 31;
              *(f32x2*)(YS + ((size_t)b * SEQ + chunk * TC + tt) * D + h * 64 + vh * 32 + v) = (f32x2){Ys[idx], Ys[idx + 1]}; }
        }
        __syncthreads();
    }
}

__device__ __forceinline__ void ld16bf(const bf16_t* p, float (&o)[16]) {
    const u32x4 a = *(const u32x4*)p, b = *(const u32x4*)(p + 8);
    o[0] = bflo(a.x); o[1] = bfhi(a.x); o[2] = bflo(a.y); o[3] = bfhi(a.y); o[4] = bflo(a.z); o[5] = bfhi(a.z); o[6] = bflo(a.w); o[7] = bfhi(a.w);
    o[8] = bflo(b.x); o[9] = bfhi(b.x); o[10] = bflo(b.y); o[11] = bfhi(b.y); o[12] = bflo(b.z); o[13] = bfhi(b.z); o[14] = bflo(b.w); o[15] = bfhi(b.w);
}
__device__ __forceinline__ void ld16f(const float* p, float (&o)[16]) {
#pragma unroll
    for (int q = 0; q < 4; ++q) { const f32x4 v = *(const f32x4*)(p + 4 * q); o[4 * q] = v[0]; o[4 * q + 1] = v[1]; o[4 * q + 2] = v[2]; o[4 * q + 3] = v[3]; }
}
__device__ __forceinline__ void p5_gnorm(Frame& F) {
    const int gw = F.vcu * NWAVES + F.wave, NGW = F.G * NWAVES;
    const float* YS = WSP(float, WS_YS); const bf16_t* RB = WSP(bf16_t, WS_RB); const bf16_t* KB = WSP(bf16_t, WS_KB); const bf16_t* VB = WSP(bf16_t, WS_VB);
    const bf16_t* AS = WSP(bf16_t, WS_AS); const bf16_t* GG = WSP(bf16_t, WS_G); bf16_t* YG = WSP(bf16_t, WS_YG);
    const int c0 = 16 * F.lane;
    float ka[16], rk[16], lg[16], lb[16];
    ld16f(F.in[17] + c0, ka); ld16f(F.in[18] + c0, rk); ld16f(F.in[19] + c0, lg); ld16f(F.in[20] + c0, lb);
    for (int m = gw; m < T; m += NGW) {
        float y[16], r[16], k[16], v[16], a[16], g[16];
        ld16f(YS + (size_t)m * D + c0, y); ld16bf(RB + (size_t)m * D + c0, r); ld16bf(KB + (size_t)m * D + c0, k); ld16bf(VB + (size_t)m * D + c0, v);
        ld16bf(AS + (size_t)m * D + c0, a); ld16bf(GG + (size_t)m * D + c0, g);
        float s = 0.f, bn = 0.f;
#pragma unroll
        for (int i = 0; i < 16; ++i) { s += y[i]; const float kp = k[i] * (1.f + (a[i] - 1.f) * ka[i]); bn += r[i] * kp * rk[i]; }
        s += __shfl_xor(s, 1); s += __shfl_xor(s, 2); bn += __shfl_xor(bn, 1); bn += __shfl_xor(bn, 2);
        const float mean = s * (1.f / 64.f); float q = 0.f;
#pragma unroll
        for (int i = 0; i < 16; ++i) { const float d = y[i] - mean; q += d * d; }
        q += __shfl_xor(q, 1); q += __shfl_xor(q, 2);
        const float rstd = 1.f / sqrtf(q * (1.f / 64.f) + LNX_EPS);
        float o[16];
#pragma unroll
        for (int i = 0; i < 16; ++i) o[i] = (((y[i] - mean) * rstd) * lg[i] + lb[i] + bn * v[i]) * g[i];
        u32x4 w0, w1;
        w0.x = cvt_pk_bf16(o[0], o[1]); w0.y = cvt_pk_bf16(o[2], o[3]); w0.z = cvt_pk_bf16(o[4], o[5]); w0.w = cvt_pk_bf16(o[6], o[7]);
        w1.x = cvt_pk_bf16(o[8], o[9]); w1.y = cvt_pk_bf16(o[10], o[11]); w1.z = cvt_pk_bf16(o[12], o[13]); w1.w = cvt_pk_bf16(o[14], o[15]);
        *(u32x4*)(YG + (size_t)m * D + c0) = w0; *(u32x4*)(YG + (size_t)m * D + c0 + 8) = w1;
    }
}

__device__ __forceinline__ void ln_apply(f32x4 (&v)[4], const float* g, const float* b, int lane) {
    float s = 0.f;
#pragma unroll
    for (int j = 0; j < 4; ++j) s += (v[j][0] + v[j][1]) + (v[j][2] + v[j][3]);
    const float mean = wave_sum(s) * (1.f / D); float s2 = 0.f;
#pragma unroll
    for (int j = 0; j < 4; ++j) { v[j] = v[j] - mean; s2 += (v[j][0] * v[j][0] + v[j][1] * v[j][1]) + (v[j][2] * v[j][2] + v[j][3] * v[j][3]); }
    const float rstd = 1.f / sqrtf(wave_sum(s2) * (1.f / D) + LN_EPS);
#pragma unroll
    for (int j = 0; j < 4; ++j) { const int c = 4 * lane + 256 * j; v[j] = v[j] * rstd * *(const f32x4*)(g + c) + *(const f32x4*)(b + c); }
}
__device__ __forceinline__ void mod_store(const f32x4 (&v)[4], const float* shift, const float* scale, bf16_t* orow, int lane) {
#pragma unroll
    for (int j = 0; j < 4; ++j) { const int c = 4 * lane + 256 * j; const f32x4 o = v[j] * (1.f + *(const f32x4*)(scale + c)) + *(const f32x4*)(shift + c);
        u32x2 w; w.x = cvt_pk_bf16(o[0], o[1]); w.y = cvt_pk_bf16(o[2], o[3]); *(u32x2*)(orow + c) = w; }
}
__device__ __forceinline__ void p_postnorm(Frame& F, const float* xres, const float* y, float* xout, int sub, int modA, bf16_t* outA, int modB, bf16_t* outB) {
    const int gw = F.vcu * NWAVES + F.wave, NGW = F.G * NWAVES;
    const float* MOD = WSP(float, WS_MOD); const float* g = F.in[4] + sub * D; const float* bb = F.in[5] + sub * D;
    for (int m = gw; m < T; m += NGW) {
        const int b = m >> 14; const float* gate = MOD + b * ADA_W + (sub * 3 + 2) * D;
        f32x4 v[4];
#pragma unroll
        for (int j = 0; j < 4; ++j) { const int c = 4 * F.lane + 256 * j;
            v[j] = DN_ALPHA * *(const f32x4*)(xres + (size_t)m * D + c) + (1.f + *(const f32x4*)(gate + c)) * *(const f32x4*)(y + (size_t)m * D + c); }
        ln_apply(v, g, bb, F.lane);
#pragma unroll
        for (int j = 0; j < 4; ++j) *(f32x4*)(xout + (size_t)m * D + 4 * F.lane + 256 * j) = v[j];
        if (outA) mod_store(v, MOD + b * ADA_W + modA, MOD + b * ADA_W + modA + D, outA + (size_t)m * D, F.lane);
        if (outB) mod_store(v, MOD + b * ADA_W + modB, MOD + b * ADA_W + modB + D, outB + (size_t)m * D, F.lane);
    }
}

constexpr int KS_STRIDE = 72;
constexpr int VT_STRIDE = 264;
__device__ __forceinline__ void p12_attn(Frame& F) {
    LAS bf16_t* Ks = (LAS bf16_t*)F.lds;
    LAS bf16_t* Vt = Ks + 256 * KS_STRIDE;
    const bf16_t* Q2 = WSP(bf16_t, WS_Q2); const bf16_t* K2 = WSP(bf16_t, WS_K2); const bf16_t* V2 = WSP(bf16_t, WS_V2);
    bf16_t* OG = WSP(bf16_t, WS_OG); float* LSE = WSP(float, WS_LSE);
    const int lane = F.lane, w = F.wave, q16 = lane & 15, qd = lane >> 4;
    for (int unit = F.vcu; unit < BATCH * 3 * 8 * 128; unit += F.G) {
        const int pb = unit & 127, hg = (unit >> 7) & 7, gb = unit >> 10, g = gb % 3, b = gb / 3;
        const int dil = g == 0 ? 1 : (g == 1 ? 4 : 16), nb = 128 / dil, phase = pb / nb, blk = pb % nb;
        const int hcol = (g * 8 + hg) * 64;
#pragma unroll
        for (int i = 0; i < 4; ++i) {
            const int ch = F.tid + 512 * i, key = ch >> 3, c8 = (ch & 7) * 8;
            const int pos = (blk - 1) * 128 + key;
            u32x4 kv = (u32x4){0u, 0u, 0u, 0u}, vv = (u32x4){0u, 0u, 0u, 0u};
            if (pos >= 0) { const size_t row = (size_t)b * SEQ + (size_t)pos * dil + phase;
                kv = *(const u32x4*)(K2 + row * QW + hcol + c8); vv = *(const u32x4*)(V2 + row * QW + hcol + c8); }
            *(LAS u32x4*)(Ks + key * KS_STRIDE + c8) = kv;
            Vt[(c8 + 0) * VT_STRIDE + key] = (bf16_t)(vv.x & 0xffff); Vt[(c8 + 1) * VT_STRIDE + key] = (bf16_t)(vv.x >> 16);
            Vt[(c8 + 2) * VT_STRIDE + key] = (bf16_t)(vv.y & 0xffff); Vt[(c8 + 3) * VT_STRIDE + key] = (bf16_t)(vv.y >> 16);
            Vt[(c8 + 4) * VT_STRIDE + key] = (bf16_t)(vv.z & 0xffff); Vt[(c8 + 5) * VT_STRIDE + key] = (bf16_t)(vv.z >> 16);
            Vt[(c8 + 6) * VT_STRIDE + key] = (bf16_t)(vv.w & 0xffff); Vt[(c8 + 7) * VT_STRIDE + key] = (bf16_t)(vv.w >> 16);
        }
        const int qi = 16 * w + q16;
        const size_t qrow = (size_t)b * SEQ + (size_t)(blk * 128 + qi) * dil + phase;
        const bf16x8 qf0 = *(const bf16x8*)(Q2 + qrow * QW + hcol + 8 * qd), qf1 = *(const bf16x8*)(Q2 + qrow * QW + hcol + 32 + 8 * qd);
        __syncthreads();
        const int kt0 = w < 6 ? w : 6;
        f32x4 s[10];
#pragma unroll
        for (int i = 0; i < 10; ++i) {
            const LAS bf16_t* kp = Ks + (16 * (kt0 + i) + q16) * KS_STRIDE + 8 * qd;
            const bf16x8 k0 = *(const LAS bf16x8*)kp, k1 = *(const LAS bf16x8*)(kp + 32);
            f32x4 a = (f32x4){0.f, 0.f, 0.f, 0.f};
            a = __builtin_amdgcn_mfma_f32_16x16x32_bf16(k0, qf0, a, 0, 0, 0);
            a = __builtin_amdgcn_mfma_f32_16x16x32_bf16(k1, qf1, a, 0, 0, 0);
            s[i] = a;
        }
        float mx = -1e30f;
#pragma unroll
        for (int i = 0; i < 10; ++i)
#pragma unroll
            for (int r = 0; r < 4; ++r) { const int kidx = 16 * (kt0 + i) + 4 * qd + r; const bool ok = (kidx >= qi) && (kidx <= qi + 128) && (blk > 0 || kidx >= 128);
                s[i][r] = ok ? s[i][r] : -1e30f; mx = fmaxf(mx, s[i][r]); }
        mx = fmaxf(mx, __shfl_xor(mx, 16)); mx = fmaxf(mx, __shfl_xor(mx, 32));
        float l = 0.f;
#pragma unroll
        for (int i = 0; i < 10; ++i)
#pragma unroll
            for (int r = 0; r < 4; ++r) { const float p = __expf(s[i][r] - mx); s[i][r] = p; l += p; }
        l += __shfl_xor(l, 16); l += __shfl_xor(l, 32);
        f32x4 o[4];
#pragma unroll
        for (int dt = 0; dt < 4; ++dt) o[dt] = (f32x4){0.f, 0.f, 0.f, 0.f};
#pragma unroll
        for (int i = 0; i < 5; ++i) {
            union { bf16x8 v; unsigned u[4]; } pf;
            pf.u[0] = cvt_pk_bf16(s[2 * i][0], s[2 * i][1]); pf.u[1] = cvt_pk_bf16(s[2 * i][2], s[2 * i][3]);
            pf.u[2] = cvt_pk_bf16(s[2 * i + 1][0], s[2 * i + 1][1]); pf.u[3] = cvt_pk_bf16(s[2 * i + 1][2], s[2 * i + 1][3]);
#pragma unroll
            for (int dt = 0; dt < 4; ++dt) {
                const LAS bf16_t* vp = Vt + (16 * dt + q16) * VT_STRIDE + 16 * (kt0 + 2 * i) + 4 * qd;
                union { bf16x8 v; s16x4 h[2]; } vf; vf.h[0] = *(const LAS s16x4*)vp; vf.h[1] = *(const LAS s16x4*)(vp + 16);
                o[dt] = __builtin_amdgcn_mfma_f32_16x16x32_bf16(vf.v, pf.v, o[dt], 0, 0, 0);
            }
        }
        const float il = 1.f / l;
        bf16_t* op = OG + (size_t)g * T * AOUT + qrow * AOUT + hg * 64 + 4 * qd;
#pragma unroll
        for (int dt = 0; dt < 4; ++dt) { u32x2 wv; wv.x = cvt_pk_bf16(o[dt][0] * il, o[dt][1] * il); wv.y = cvt_pk_bf16(o[dt][2] * il, o[dt][3] * il); *(u32x2*)(op + 16 * dt) = wv; }
        if (qd == 0) LSE[(size_t)g * T * 8 + qrow * 8 + hg] = mx + __logf(l);
        __syncthreads();
    }
}
__device__ __forceinline__ void p13_merge(Frame& F) {
    const bf16_t* OG = WSP(bf16_t, WS_OG); const float* LSE = WSP(float, WS_LSE); bf16_t* OM = WSP(bf16_t, WS_OM);
    for (int idx = F.vcu * 512 + F.tid; idx < T * 64; idx += F.G * 512) {
        const int m = idx >> 6, hg = (idx >> 3) & 7, c8 = (idx & 7) * 8;
        const float l0 = LSE[(size_t)0 * T * 8 + m * 8 + hg], l1 = LSE[(size_t)1 * T * 8 + m * 8 + hg], l2 = LSE[(size_t)2 * T * 8 + m * 8 + hg];
        const float mx = fmaxf(l0, fmaxf(l1, l2)); float w0 = __expf(l0 - mx), w1 = __expf(l1 - mx), w2 = __expf(l2 - mx); const float inv = 1.f / (w0 + w1 + w2); w0 *= inv; w1 *= inv; w2 *= inv;
        const size_t off = (size_t)m * AOUT + hg * 64 + c8;
        const u32x4 a = *(const u32x4*)(OG + off), bq = *(const u32x4*)(OG + (size_t)T * AOUT + off), c = *(const u32x4*)(OG + (size_t)2 * T * AOUT + off);
        u32x4 o;
        o.x = cvt_pk_bf16(w0 * bflo(a.x) + w1 * bflo(bq.x) + w2 * bflo(c.x), w0 * bfhi(a.x) + w1 * bfhi(bq.x) + w2 * bfhi(c.x));
        o.y = cvt_pk_bf16(w0 * bflo(a.y) + w1 * bflo(bq.y) + w2 * bflo(c.y), w0 * bfhi(a.y) + w1 * bfhi(bq.y) + w2 * bfhi(c.y));
        o.z = cvt_pk_bf16(w0 * bflo(a.z) + w1 * bflo(bq.z) + w2 * bflo(c.z), w0 * bfhi(a.z) + w1 * bfhi(bq.z) + w2 * bfhi(c.z));
        o.w = cvt_pk_bf16(w0 * bflo(a.w) + w1 * bflo(bq.w) + w2 * bflo(c.w), w0 * bfhi(a.w) + w1 * bfhi(bq.w) + w2 * bfhi(c.w));
        *(u32x4*)(OM + off) = o;
    }
}

__device__ __forceinline__ void p15_ln_route(Frame& F) {
    LAS float* RT = (LAS float*)F.lds;
    LAS int* lcnt = (LAS int*)(F.lds + 32768);
    LAS int* lbase = lcnt + 8;
    LAS int* lte = lcnt + 16;
    LAS int* ltr = lte + 256;
    LAS float* ltw = (LAS float*)(ltr + 256);
    const float* MOD = WSP(float, WS_MOD); const float* g = F.in[4] + 2 * D; const float* bb = F.in[5] + 2 * D;
    const float* X2 = WSP(float, WS_X2); const float* Y3 = WSP(float, WS_Y3); float* X3 = F.out; bf16_t* H4 = WSP(bf16_t, WS_H4);
    int* TOKE = (int*)(F.ws + WS_ROUTE + RT_TOKE); int* TOKR = (int*)(F.ws + WS_ROUTE + RT_TOKR); float* TOKW = (float*)(F.ws + WS_ROUTE + RT_TOKW);
    int* ROWTOK = (int*)(F.ws + WS_ROUTE + RT_ROWTOK);
    for (int i = F.tid; i < D * 8; i += 512) RT[i] = F.in[27][i];
    for (int i = F.vcu * 512 + F.tid; i < RMAX; i += F.G * 512) ROWTOK[i] = T;
    if (F.vcu == 0) for (int i = F.tid; i < D / 2; i += 512) ((unsigned*)(H4 + (size_t)T * D))[i] = 0u;
    __syncthreads();
    for (int chunk = F.vcu; chunk < T / 128; chunk += F.G) {
        if (F.tid < 8) lcnt[F.tid] = 0;
        __syncthreads();
        for (int i = 0; i < 16; ++i) {
            const int lr = F.wave * 16 + i, m = chunk * 128 + lr, b = m >> 14;
            const float* gate = MOD + b * ADA_W + (2 * 3 + 2) * D;
            f32x4 v[4];
#pragma unroll
            for (int j = 0; j < 4; ++j) { const int c = 4 * F.lane + 256 * j;
                v[j] = DN_ALPHA * *(const f32x4*)(X2 + (size_t)m * D + c) + (1.f + *(const f32x4*)(gate + c)) * *(const f32x4*)(Y3 + (size_t)m * D + c); }
            ln_apply(v, g, bb, F.lane);
#pragma unroll
            for (int j = 0; j < 4; ++j) *(f32x4*)(X3 + (size_t)m * D + 4 * F.lane + 256 * j) = v[j];
            const float* shift = MOD + b * ADA_W + (3 * 3 + 0) * D; const float* scale = MOD + b * ADA_W + (3 * 3 + 1) * D;
            float lg[8];
#pragma unroll
            for (int e = 0; e < 8; ++e) lg[e] = 0.f;
#pragma unroll
            for (int j = 0; j < 4; ++j) { const int c = 4 * F.lane + 256 * j; const f32x4 hh = v[j] * (1.f + *(const f32x4*)(scale + c)) + *(const f32x4*)(shift + c);
                u32x2 wv; wv.x = cvt_pk_bf16(hh[0], hh[1]); wv.y = cvt_pk_bf16(hh[2], hh[3]); *(u32x2*)(H4 + (size_t)m * D + c) = wv;
#pragma unroll
                for (int q = 0; q < 4; ++q) { const f32x4 r0 = *(const LAS f32x4*)(RT + (c + q) * 8), r1 = *(const LAS f32x4*)(RT + (c + q) * 8 + 4);
                    lg[0] += hh[q] * r0[0]; lg[1] += hh[q] * r0[1]; lg[2] += hh[q] * r0[2]; lg[3] += hh[q] * r0[3];
                    lg[4] += hh[q] * r1[0]; lg[5] += hh[q] * r1[1]; lg[6] += hh[q] * r1[2]; lg[7] += hh[q] * r1[3]; } }
#pragma unroll
            for (int e = 0; e < 8; ++e) lg[e] = wave_sum(lg[e]);
            int e1 = 0; float m1 = lg[0];
#pragma unroll
            for (int e = 1; e < 8; ++e) if (lg[e] > m1) { m1 = lg[e]; e1 = e; }
            int e2 = -1; float m2 = -3.0e38f;
#pragma unroll
            for (int e = 0; e < 8; ++e) if (e != e1 && lg[e] > m2) { m2 = lg[e]; e2 = e; }
            if (F.lane == 0) {
                const float w1 = 1.f / (1.f + __expf(m2 - m1));
                lte[lr * 2] = e1; lte[lr * 2 + 1] = e2; ltw[lr * 2] = w1; ltw[lr * 2 + 1] = 1.f - w1;
                ltr[lr * 2] = atomicAdd((int*)&lcnt[e1], 1); ltr[lr * 2 + 1] = atomicAdd((int*)&lcnt[e2], 1);
            }
        }
        __syncthreads();
        if (F.tid < 8) lbase[F.tid] = (int)__hip_atomic_fetch_add((unsigned*)(F.ctl + CW_CNT + F.tid), (unsigned)lcnt[F.tid], RLX_AGENT);
        __syncthreads();
        if (F.tid < 256) { const int m = chunk * 128 + (F.tid >> 1), s = F.tid & 1; const int e = lte[F.tid];
            TOKE[m * 2 + s] = e; TOKR[m * 2 + s] = lbase[e] + ltr[F.tid]; TOKW[m * 2 + s] = ltw[F.tid]; }
        __syncthreads();
    }
}
__device__ __forceinline__ void p16_place(Frame& F) {
    int* TOKE = (int*)(F.ws + WS_ROUTE + RT_TOKE); int* TOKR = (int*)(F.ws + WS_ROUTE + RT_TOKR);
    int* ROWTOK = (int*)(F.ws + WS_ROUTE + RT_ROWTOK); int* BLKEXP = (int*)(F.ws + WS_ROUTE + RT_BLKEXP);
    int pstart[8], pend[8]; int acc = 0;
#pragma unroll
    for (int e = 0; e < 8; ++e) { const int c = (int)__hip_atomic_load((unsigned*)(F.ctl + CW_CNT + e), RLX_AGENT); pstart[e] = acc; acc += (c + 255) / 256 * 256; pend[e] = acc; }
    for (int idx = F.vcu * 512 + F.tid; idx < T * 2; idx += F.G * 512) {
        const int e = TOKE[idx]; int ps = 0;
#pragma unroll
        for (int j = 0; j < 8; ++j) ps = (e == j) ? pstart[j] : ps;
        const int dest = ps + TOKR[idx]; ROWTOK[dest] = idx >> 1; TOKR[idx] = dest;
    }
    if (F.vcu == 0) {
        for (int blk = F.tid; blk < NBLKMAX; blk += 512) { int e = 0;
#pragma unroll
            for (int j = 0; j < 8; ++j) e += (pend[j] <= blk * 256) ? 1 : 0;
            BLKEXP[blk] = e < 8 ? e : 7; }
        if (F.tid == 0) __hip_atomic_store((unsigned*)(F.ctl + CW_NBLK), (unsigned)(acc / 256), RLX_AGENT);
    }
}
__device__ __forceinline__ void p19_final(Frame& F) {
    const int gw = F.vcu * NWAVES + F.wave, NGW = F.G * NWAVES;
    const float* MOD = WSP(float, WS_MOD); const float* g = F.in[4] + 3 * D; const float* bb = F.in[5] + 3 * D;
    const bf16_t* YB = WSP(bf16_t, WS_YB); const int* TOKR = (const int*)(F.ws + WS_ROUTE + RT_TOKR); const float* TOKW = (const float*)(F.ws + WS_ROUTE + RT_TOKW);
    float* X = F.out;
    for (int m = gw; m < T; m += NGW) {
        const int b = m >> 14; const float* gate = MOD + b * ADA_W + (3 * 3 + 2) * D;
        const int d0 = TOKR[m * 2], d1 = TOKR[m * 2 + 1]; const float w0 = TOKW[m * 2], w1 = TOKW[m * 2 + 1];
        f32x4 v[4];
#pragma unroll
        for (int j = 0; j < 4; ++j) { const int c = 4 * F.lane + 256 * j;
            const u32x2 a = *(const u32x2*)(YB + (size_t)d0 * D + c), q = *(const u32x2*)(YB + (size_t)d1 * D + c);
            const f32x4 y = (f32x4){w0 * bflo(a.x) + w1 * bflo(q.x), w0 * bfhi(a.x) + w1 * bfhi(q.x), w0 * bflo(a.y) + w1 * bflo(q.y), w0 * bfhi(a.y) + w1 * bfhi(q.y)};
            v[j] = DN_ALPHA * *(const f32x4*)(X + (size_t)m * D + c) + (1.f + *(const f32x4*)(gate + c)) * y; }
        ln_apply(v, g, bb, F.lane);
#pragma unroll
        for (int j = 0; j < 4; ++j) *(f32x4*)(X + (size_t)m * D + 4 * F.lane + 256 * j) = v[j];
    }
}

struct Args { const float* in[30]; float* out; unsigned char* ws; int ph_lo, ph_hi, li, pad; };
__global__ void __launch_bounds__(NWAVES * 64, 2) fwd(Args args) {
    extern __shared__ __attribute__((aligned(16))) unsigned char lds[];
    Frame F;
    F.lds = (LAS unsigned char*)lds;
    F.MISC = (volatile LAS unsigned*)(F.lds + MISC_OFF);
    F.tid = threadIdx.x; F.lane = F.tid & 63; F.wave = __builtin_amdgcn_readfirstlane(F.tid >> 6);
    F.G = gridDim.x; { const int bx = blockIdx.x; F.vcu = (F.G % 8 == 0) ? (bx % 8) * (F.G / 8) + bx / 8 : bx; }
    F.ws = args.ws; F.ctl = (gu32*)(args.ws + WS_CTL); F.out = args.out;
    F.in = args.in;
    for (int u = F.tid; u < (LDS_BYTES - LDSCTL_OFF) / 4; u += NWAVES * 64) ((LAS unsigned*)(F.lds + LDSCTL_OFF))[u] = 0u;
    __syncthreads();
    XcdBarrier bar; bar.bar = (unsigned*)(F.ctl + CW_BAR); bar.x = 0; bar.st = nullptr;
    if (N_LAUNCHES != NPH) bar = xcd_barrier_post((unsigned*)(F.ctl + CW_BAR) + args.li * XCD_BAR_WORDS, F.MISC + 8);
#define GRID_BAR() do { if (N_LAUNCHES != NPH) xcd_barrier(bar); } while (0)
    const int lo = args.ph_lo, hi = args.ph_hi;
#define IN(k) (lo <= (k) && (k) < hi)
#define BOTH(k) (IN(k) && IN((k) + 1))
    using namespace pg8;
    const int cid = (int)blockIdx.x;

    if (IN(0)) { p0_prologue(F); if (BOTH(0)) GRID_BAR(); }
    if (IN(1)) { p1_lerp(F); if (BOTH(1)) GRID_BAR(); }
    if (IN(2)) {
        Gemm g{WSP(bf16_t, WS_A6) + (size_t)3 * T * D, WSP(bf16_t, WS_WL1), D, D, (size_t)T * D * 2, (size_t)256 * D * 2, nullptr, nullptr, 0};
        StaticOrder S; S.init(T / 256, 1, 3, F.G, cid);
        EpiBf16Z<1, 0, 2> E{WSP(bf16_t, WS_L1), 256, (size_t)T * 256};
        gemm_phase<EpiBf16Z<1, 0, 2>, StaticOrder, true>(F.lds, g, S, E);
        if (BOTH(2)) GRID_BAR();
    }
    if (IN(3)) {
        { Gemm g{WSP(bf16_t, WS_A6), WSP(bf16_t, WS_WRKV), D, D, (size_t)T * D * 2, (size_t)D * D * 2, nullptr, nullptr, 0};
          StaticOrder S; S.init(T / 256, D / 256, 3, F.G, cid);
          EpiBf16Z<0, 0, 0> E{WSP(bf16_t, WS_RB), D, (size_t)T * D};
          gemm_phase<EpiBf16Z<0, 0, 0>, StaticOrder, true>(F.lds, g, S, E); }
        { Gemm g{WSP(bf16_t, WS_L1), WSP(bf16_t, WS_WL2), 256, 256, (size_t)T * 256 * 2, (size_t)D * 256 * 2, nullptr, nullptr, 0};
          StaticOrder S; S.init(T / 256, D / 256, 3, F.G, cid);
          EpiLora2 E{F.out, WSP(bf16_t, WS_AS), WSP(bf16_t, WS_G), F.in[8], F.in[11]};
          gemm_phase<EpiLora2, StaticOrder, true>(F.lds, g, S, E); }
        if (BOTH(3)) GRID_BAR();
    }
    if (IN(4)) { p4_scan_seq(F); if (BOTH(4)) GRID_BAR(); }
    if (IN(5)) { p5_gnorm(F); if (BOTH(5)) GRID_BAR(); }
    if (IN(6)) {
        Gemm g{WSP(bf16_t, WS_YG), WSP(bf16_t, WS_WOUT), D, D, 0, 0, nullptr, nullptr, 0};
        StaticOrder S; S.init(T / 256, D / 256, 1, F.G, cid);
        EpiF32 E{WSP(float, WS_Y1), D};
        gemm_phase<EpiF32, StaticOrder, true>(F.lds, g, S, E);
        if (BOTH(6)) GRID_BAR();
    }
    if (IN(7)) { p_postnorm(F, F.in[0], WSP(float, WS_Y1), WSP(float, WS_X1), 0, (1 * 3 + 0) * D, WSP(bf16_t, WS_H2), 0, nullptr); if (BOTH(7)) GRID_BAR(); }
    if (IN(8)) {
        Gemm g{WSP(bf16_t, WS_H2), WSP(bf16_t, WS_WFGU), D, D, 0, 0, nullptr, nullptr, 0};
        StaticOrder S; S.init(T / 256, 2 * DFF / 256, 1, F.G, cid);
        EpiSwiglu E{WSP(bf16_t, WS_ACT), DFF};
        gemm_phase<EpiSwiglu, StaticOrder, true>(F.lds, g, S, E);
        if (BOTH(8)) GRID_BAR();
    }
    if (IN(9)) {
        Gemm g{WSP(bf16_t, WS_ACT), WSP(bf16_t, WS_WFDN), DFF, DFF, 0, 0, nullptr, nullptr, 0};
        StaticOrder S; S.init(T / 256, D / 256, 1, F.G, cid);
        EpiF32 E{WSP(float, WS_Y2), D};
        gemm_phase<EpiF32, StaticOrder, true>(F.lds, g, S, E);
        if (BOTH(9)) GRID_BAR();
    }
    if (IN(10)) { p_postnorm(F, WSP(float, WS_X1), WSP(float, WS_Y2), WSP(float, WS_X2), 1, 12 * D, WSP(bf16_t, WS_HKV), (2 * 3 + 0) * D, WSP(bf16_t, WS_H3)); if (BOTH(10)) GRID_BAR(); }
    if (IN(11)) {
        const float* cs = WSP(float, WS_ROPE); const float* sn = cs + SEQ * 32;
        { Gemm g{WSP(bf16_t, WS_HKV), WSP(bf16_t, WS_WKV), D, D, 0, 0, nullptr, nullptr, 0};
          StaticOrder S; S.init(T / 256, 2 * QW / 256, 1, F.G, cid);
          EpiRope E{WSP(bf16_t, WS_K2), WSP(bf16_t, WS_V2), QW, cs, sn, 1.f};
          gemm_phase<EpiRope, StaticOrder, true>(F.lds, g, S, E); }
        { Gemm g{WSP(bf16_t, WS_H3), WSP(bf16_t, WS_WQ), D, D, 0, 0, nullptr, nullptr, 0};
          StaticOrder S; S.init(T / 256, QW / 256, 1, F.G, cid);
          EpiRope E{WSP(bf16_t, WS_Q2), WSP(bf16_t, WS_Q2), QW, cs, sn, 0.125f};
          gemm_phase<EpiRope, StaticOrder, true>(F.lds, g, S, E); }
        if (BOTH(11)) GRID_BAR();
    }
    if (IN(12)) { p12_attn(F); if (BOTH(12)) GRID_BAR(); }
    if (IN(13)) { p13_merge(F); if (BOTH(13)) GRID_BAR(); }
    if (IN(14)) {
        Gemm g{WSP(bf16_t, WS_OM), WSP(bf16_t, WS_WO), AOUT, AOUT, 0, 0, nullptr, nullptr, 0};
        StaticOrder S; S.init(T / 256, D / 256, 1, F.G, cid);
        EpiF32 E{WSP(float, WS_Y3), D};
        gemm_phase<EpiF32, StaticOrder, true>(F.lds, g, S, E);
        if (BOTH(14)) GRID_BAR();
    }
    if (IN(15)) { p15_ln_route(F); if (BOTH(15)) GRID_BAR(); }
    if (IN(16)) { p16_place(F); if (BOTH(16)) GRID_BAR(); }
    if (IN(17)) {
        const int nblk = (int)__hip_atomic_load((unsigned*)(F.ctl + CW_NBLK), RLX_AGENT);
        Gemm g{WSP(bf16_t, WS_H4), WSP(bf16_t, WS_WMGU), D, D, 0, 0, (const int*)(F.ws + WS_ROUTE + RT_ROWTOK), (const int*)(F.ws + WS_ROUTE + RT_BLKEXP), (size_t)2 * DFE * D * 2};
        StaticOrder S; S.init(nblk, 2 * DFE / 256, 1, F.G, cid);
        EpiSwiglu E{WSP(bf16_t, WS_ACT2), DFE};
        gemm_phase<EpiSwiglu, StaticOrder, true>(F.lds, g, S, E);
        if (BOTH(17)) GRID_BAR();
    }
    if (IN(18)) {
        const int nblk = (int)__hip_atomic_load((unsigned*)(F.ctl + CW_NBLK), RLX_AGENT);
        Gemm g{WSP(bf16_t, WS_ACT2), WSP(bf16_t, WS_WMDN), DFE, DFE, 0, 0, nullptr, (const int*)(F.ws + WS_ROUTE + RT_BLKEXP), (size_t)D * DFE * 2};
        StaticOrder S; S.init(nblk, D / 256, 1, F.G, cid);
        EpiBf16Z<0, 0, 0> E{WSP(bf16_t, WS_YB), D, 0};
        gemm_phase<EpiBf16Z<0, 0, 0>, StaticOrder, true>(F.lds, g, S, E);
        if (BOTH(18)) GRID_BAR();
    }
    if (IN(19)) { p19_final(F); }
#undef IN
#undef BOTH
}

extern "C" void kernel_launch(void* const* d_in, const int* in_sizes, int n_in, void* d_out, int out_size, void* d_ws, size_t ws_size, hipStream_t stream) {
    static int grid = 0;
    if (grid == 0) {
        if (n_in != 30 || in_sizes[0] != T * D || out_size != T * D || ws_size < WS_END) { fprintf(stderr, "kernel_launch: unexpected shapes / workspace (%d inputs, ws %zu)\n", n_in, ws_size); grid = -1; return; }
        int dev = 0, cus = 0, per_cu = 0;
        if (hipGetDevice(&dev) != hipSuccess || hipDeviceGetAttribute(&cus, hipDeviceAttributeMultiprocessorCount, dev) != hipSuccess) { grid = -1; return; }
        if (hipFuncSetAttribute((const void*)fwd, hipFuncAttributeMaxDynamicSharedMemorySize, LDS_BYTES) != hipSuccess) { fprintf(stderr, "kernel_launch: hipFuncSetAttribute failed\n"); grid = -1; return; }
        if (hipOccupancyMaxActiveBlocksPerMultiprocessor(&per_cu, (const void*)fwd, NWAVES * 64, LDS_BYTES) != hipSuccess || per_cu < 1)
            fprintf(stderr, "kernel_launch: occupancy query reports %d workgroups per CU\n", per_cu);
        (void)hipGetLastError();
        grid = cus;
    }
    if (grid < 0) return;
    if (hipMemsetAsync((char*)d_ws + WS_CTL, 0, CTL_ZERO_BYTES, stream) != hipSuccess) return;
    Args a{};
    for (int i = 0; i < 30; ++i) a.in[i] = (const float*)d_in[i];
    a.out = (float*)d_out; a.ws = (unsigned char*)d_ws;
    for (int li = 0; li < N_LAUNCHES; ++li) {
        a.ph_lo = (N_LAUNCHES == NPH) ? li : 0; a.ph_hi = (N_LAUNCHES == NPH) ? li + 1 : NPH; a.li = (N_LAUNCHES == NPH) ? 0 : li;
        hipLaunchKernelGGL(fwd, dim3(grid), dim3(NWAVES * 64), LDS_BYTES, stream, a);
        if (hipPeekAtLastError() != hipSuccess) { fprintf(stderr, "kernel_launch: launch %d failed\n", li); break; }
    }
}
```

```cpp
#include <hip/hip_runtime.h>
#include <cstdio>
#include <cstdint>

#define LAS __attribute__((address_space(3)))
#define GAS __attribute__((address_space(1)))
typedef unsigned short bf16_t;
typedef short bf16x8 __attribute__((ext_vector_type(8)));
typedef short s16x4 __attribute__((ext_vector_type(4)));
typedef float f32x4 __attribute__((ext_vector_type(4)));
typedef float f32x2 __attribute__((ext_vector_type(2)));
typedef unsigned u32x4 __attribute__((ext_vector_type(4)));
typedef unsigned u32x2 __attribute__((ext_vector_type(2)));
typedef GAS unsigned gu32;
#define RLX_AGENT __ATOMIC_RELAXED, __HIP_MEMORY_SCOPE_AGENT

__device__ __forceinline__ unsigned cvt_pk_bf16(float lo, float hi) { unsigned r; asm volatile("v_cvt_pk_bf16_f32 %0, %1, %2" : "=v"(r) : "v"(lo), "v"(hi)); return r; }
__device__ __forceinline__ float bflo(unsigned w) { return __uint_as_float(w << 16); }
__device__ __forceinline__ float bfhi(unsigned w) { return __uint_as_float(w & 0xffff0000u); }
__device__ __forceinline__ float sigmoidf_(float x) { return 1.f / (1.f + __expf(-x)); }
__device__ __forceinline__ float tanhf_(float x) { return 1.f - 2.f / (1.f + __expf(2.f * x)); }
__device__ __forceinline__ float siluf_(float x) { return x / (1.f + __expf(-x)); }
__device__ __forceinline__ int ld_i32(const int* p) { return (int)__hip_atomic_load((const unsigned*)p, RLX_AGENT); }

constexpr int BATCH = 2, SEQ = 16384, D = 1024, T = BATCH * SEQ;
constexpr int ADA_W = 14336;
constexpr int DFF = 2816, NEXP = 8, DFE = 3584;
constexpr int QW = 1536, AOUT = 512;
constexpr int RMAX = (T * 2 / 256 + NEXP) * 256;
constexpr int NBLKMAX = RMAX / 256;
constexpr float LN_EPS = 1e-5f, LNX_EPS = 64e-5f;
constexpr float DN_ALPHA = 1.4142135623730951f;

namespace pg8 {
constexpr int BM = 256, BK = 64, HALF = 128, HTB = HALF * BK * 2, STAGE_BYTES = 8 * HTB, NXCD = 8, WGM = 8;
__host__ __device__ __forceinline__ int lds_byte(int r, int c) { const int st = (r >> 4) * 2 + (c >> 5), rr = r & 15, cc = c & 31, ob = rr * 64 + cc * 2; return st * 1024 + (ob ^ (((ob >> 9) & 1) << 5)); }
__host__ __device__ __forceinline__ void stage_rc(int b, int& R, int& C) { const int st = b / 1024, sb = b % 1024, swz = sb ^ (((sb >> 9) & 1) << 5); R = (st >> 1) * 16 + swz / 64; C = (st & 1) * 32 + (swz % 64) / 2; }
__host__ __device__ __forceinline__ int perm32(int rho) { const int n = rho >> 4, i = rho & 15; return 8 * (i >> 2) + 4 * n + (i & 3); }

struct Unit { int pm, pn, z; };
struct Gemm { const bf16_t* A; const bf16_t* Bt; int K, lda; size_t azs, bzs; const int* rowmap; const int* blk_exp; size_t bes; };

struct StaticOrder {
    int nM, nN, nZ, nwg, G, c;
    __device__ void init(int nM_, int nN_, int nZ_, int G_, int c_) { nM = nM_; nN = nN_; nZ = nZ_; nwg = nM * nN; G = G_; c = c_; }
    __device__ bool next(int i, Unit& u) const {
        const long L = (long)i * G + c; if (L >= (long)nwg * nZ) return false;
        u.z = (int)(L / nwg); int wgid = (int)(L % nwg);
        { const int q = nwg / NXCD, r = nwg % NXCD, xcd = wgid % NXCD, off = wgid / NXCD; wgid = (xcd < r ? xcd * (q + 1) : r * (q + 1) + (xcd - r) * q) + off; }
        const int nig = WGM * nN, gid = wgid / nig, fm = gid * WGM, gsz = (nM - fm) < WGM ? (nM - fm) : WGM;
        u.pm = fm + ((wgid % nig) % gsz); u.pn = (wgid % nig) / gsz; return true;
    }
};

#define EPI_LOOP_BEGIN \
    const int row0 = u.pm * BM + wr * 64 + fr, col0 = u.pn * BM + wc * 32 + 8 * fq; \
    _Pragma("unroll") for (int ai = 0; ai < 2; ++ai) _Pragma("unroll") for (int m = 0; m < 4; ++m) { const int row = row0 + ai * HALF + m * 16; \
    _Pragma("unroll") for (int bj = 0; bj < 2; ++bj) { const int col = col0 + bj * HALF; f32x4 v0 = acc[ai][bj][m][0], v1 = acc[ai][bj][m][1];
#define EPI_LOOP_END } }

__device__ __forceinline__ float act_apply(int a, float x) { return a == 1 ? tanhf_(x) : (a == 2 ? sigmoidf_(x) : x); }
template <int ACT0, int ACT1, int ACT2> struct EpiBf16Z {
    static constexpr bool PERM = true;
    bf16_t* O; int ldc; size_t ozs;
    __device__ __forceinline__ void operator()(const f32x4 (&acc)[2][2][4][2], const Unit& u, int wr, int wc, int fr, int fq) const {
        const int a = u.z == 0 ? ACT0 : (u.z == 1 ? ACT1 : ACT2); bf16_t* base = O + (size_t)u.z * ozs;
        EPI_LOOP_BEGIN
            if (a) { _Pragma("unroll") for (int e = 0; e < 4; ++e) { v0[e] = act_apply(a, v0[e]); v1[e] = act_apply(a, v1[e]); } }
            u32x4 w; w.x = cvt_pk_bf16(v0[0], v0[1]); w.y = cvt_pk_bf16(v0[2], v0[3]); w.z = cvt_pk_bf16(v1[0], v1[1]); w.w = cvt_pk_bf16(v1[2], v1[3]);
            *(u32x4*)(base + (size_t)row * ldc + col) = w;
        EPI_LOOP_END
    }
};
struct EpiLora2 {
    static constexpr bool PERM = true;
    float* WLOG; bf16_t* AS; bf16_t* G; const float* w0; const float* a0;
    __device__ __forceinline__ void operator()(const f32x4 (&acc)[2][2][4][2], const Unit& u, int wr, int wc, int fr, int fq) const {
        EPI_LOOP_BEGIN
            if (u.z == 0) {
                const f32x4 b0 = *(const f32x4*)(w0 + col), b1 = *(const f32x4*)(w0 + col + 4);
                _Pragma("unroll") for (int e = 0; e < 4; ++e) {
                    float x = -(v0[e] + b0[e]); float sp = fmaxf(x, 0.f) + __logf(1.f + __expf(-fabsf(x))); v0[e] = -__expf(-sp - 0.5f);
                    x = -(v1[e] + b1[e]); sp = fmaxf(x, 0.f) + __logf(1.f + __expf(-fabsf(x))); v1[e] = -__expf(-sp - 0.5f); }
                float* p = WLOG + (size_t)row * D + col; *(f32x4*)p = v0; *(f32x4*)(p + 4) = v1;
            } else {
                if (u.z == 1) { const f32x4 b0 = *(const f32x4*)(a0 + col), b1 = *(const f32x4*)(a0 + col + 4);
                    _Pragma("unroll") for (int e = 0; e < 4; ++e) { v0[e] = sigmoidf_(v0[e] + b0[e]); v1[e] = sigmoidf_(v1[e] + b1[e]); } }
                u32x4 w; w.x = cvt_pk_bf16(v0[0], v0[1]); w.y = cvt_pk_bf16(v0[2], v0[3]); w.z = cvt_pk_bf16(v1[0], v1[1]); w.w = cvt_pk_bf16(v1[2], v1[3]);
                *(u32x4*)((u.z == 1 ? AS : G) + (size_t)row * D + col) = w;
            }
        EPI_LOOP_END
    }
};
struct EpiF32 {
    static constexpr bool PERM = true;
    float* O; int ldc;
    __device__ __forceinline__ void operator()(const f32x4 (&acc)[2][2][4][2], const Unit& u, int wr, int wc, int fr, int fq) const {
        EPI_LOOP_BEGIN
            float* p = O + (size_t)row * ldc + col; *(f32x4*)p = v0; *(f32x4*)(p + 4) = v1;
        EPI_LOOP_END
    }
};
struct EpiSwiglu {
    static constexpr bool PERM = true;
    bf16_t* O; int ldo;
    __device__ __forceinline__ void operator()(const f32x4 (&acc)[2][2][4][2], const Unit& u, int wr, int wc, int fr, int fq) const {
        EPI_LOOP_BEGIN
            u32x2 w; w.x = cvt_pk_bf16(siluf_(v0[0]) * v0[1], siluf_(v0[2]) * v0[3]); w.y = cvt_pk_bf16(siluf_(v1[0]) * v1[1], siluf_(v1[2]) * v1[3]);
            *(u32x2*)(O + (size_t)row * ldo + (col >> 1)) = w;
        EPI_LOOP_END
    }
};
struct EpiRope {
    static constexpr bool PERM = true;
    bf16_t* O; bf16_t* O2; int ncol_rope; const float* cs; const float* sn; float scale;
    __device__ __forceinline__ void operator()(const f32x4 (&acc)[2][2][4][2], const Unit& u, int wr, int wc, int fr, int fq) const {
        EPI_LOOP_BEGIN
            bf16_t* dst;
            if (col < ncol_rope) {
                const int t = row & (SEQ - 1), i0 = (col & 63) >> 1;
                const f32x4 c4 = *(const f32x4*)(cs + (size_t)t * 32 + i0), s4 = *(const f32x4*)(sn + (size_t)t * 32 + i0);
                float a, b;
                a = v0[0]; b = v0[1]; v0[0] = (a * c4[0] - b * s4[0]) * scale; v0[1] = (b * c4[0] + a * s4[0]) * scale;
                a = v0[2]; b = v0[3]; v0[2] = (a * c4[1] - b * s4[1]) * scale; v0[3] = (b * c4[1] + a * s4[1]) * scale;
                a = v1[0]; b = v1[1]; v1[0] = (a * c4[2] - b * s4[2]) * scale; v1[1] = (b * c4[2] + a * s4[2]) * scale;
                a = v1[2]; b = v1[3]; v1[2] = (a * c4[3] - b * s4[3]) * scale; v1[3] = (b * c4[3] + a * s4[3]) * scale;
                dst = O + (size_t)row * ncol_rope + col;
            } else dst = O2 + (size_t)row * ncol_rope + (col - ncol_rope);
            u32x4 w; w.x = cvt_pk_bf16(v0[0], v0[1]); w.y = cvt_pk_bf16(v0[2], v0[3]); w.z = cvt_pk_bf16(v1[0], v1[1]); w.w = cvt_pk_bf16(v1[2], v1[3]);
            *(u32x4*)dst = w;
        EPI_LOOP_END
    }
};

template <class Epi, class Sched, bool ALIGN_EPI>
__device__ __forceinline__ void gemm_phase(LAS unsigned char* lds, const Gemm g, const Sched& S, const Epi& E) {
    const int tid = threadIdx.x, wid = __builtin_amdgcn_readfirstlane(tid >> 6), lane = tid & 63, wr = wid >> 2, wc = wid & 3, fr = lane & 15, fq = lane >> 4;
    const int K = g.K, nt = K / BK;
    int RA[2], CA[2]; unsigned voffB[2];
#pragma unroll
    for (int i = 0; i < 2; ++i) { int R, C; stage_rc(tid * 16 + i * 8192, R, C); const int Rb = Epi::PERM ? ((R & ~31) + perm32(R & 31)) : R;
        RA[i] = R; CA[i] = C; voffB[i] = (unsigned)(Rb * K + C) * 2u; }
    const size_t kstep = (size_t)(BK * 2);
    const size_t hstepB = (size_t)HALF * K * 2, tstepB = 2 * hstepB;
    const unsigned ldsw = (unsigned)wid * 1024u;
    const int aoff = lds_byte(wr * 64 + fr, fq * 8), boff = lds_byte(wc * 32 + fr, fq * 8);
#define PG8_SA(b, h) (((b) * 2 + (h)) * HTB)
#define PG8_SB(b, h) ((4 + (b) * 2 + (h)) * HTB)
#define PG8_STAGE(bufoff, gbase, voff) do { _Pragma("unroll") for (int _i = 0; _i < 2; ++_i) \
        __builtin_amdgcn_global_load_lds((const unsigned*)((const char*)(gbase) + (voff)[_i]), (LAS unsigned*)(lds + (bufoff) + ldsw + _i * 8192), 16, 0, 0); } while (0)
#define PG8_VOFFA(v, uu) do { _Pragma("unroll") for (int _h = 0; _h < 2; ++_h) _Pragma("unroll") for (int _i = 0; _i < 2; ++_i) { int _row = (uu).pm * BM + _h * HALF + RA[_i]; \
        if (g.rowmap) _row = g.rowmap[_row]; (v)[_h][_i] = (unsigned)((size_t)(uu).z * g.azs) + (unsigned)(_row * g.lda + CA[_i]) * 2u; } } while (0)
#define PG8_BBASE(uu) ((const char*)g.Bt + (size_t)(uu).z * g.bzs + (g.blk_exp ? (size_t)ld_i32(g.blk_exp + (uu).pm) * g.bes : (size_t)0) + (size_t)(uu).pn * tstepB)
#define PG8_LDA(dst, b, h) do { _Pragma("unroll") for (int m = 0; m < 4; ++m) _Pragma("unroll") for (int k = 0; k < 2; ++k) dst[m][k] = *(const LAS bf16x8*)(lds + PG8_SA(b, h) + aoff + m * 2048 + k * 1024); } while (0)
#define PG8_LDB(dst, b, h) do { _Pragma("unroll") for (int n = 0; n < 2; ++n) _Pragma("unroll") for (int k = 0; k < 2; ++k) dst[n][k] = *(const LAS bf16x8*)(lds + PG8_SB(b, h) + boff + n * 2048 + k * 1024); } while (0)
#define PG8_MMA(ai, bj, At, Bt) do { __builtin_amdgcn_s_setprio(1); _Pragma("unroll") for (int m = 0; m < 4; ++m) _Pragma("unroll") for (int n = 0; n < 2; ++n) _Pragma("unroll") for (int k = 0; k < 2; ++k) \
        acc[ai][bj][m][n] = __builtin_amdgcn_mfma_f32_16x16x32_bf16(Bt[n][k], At[m][k], acc[ai][bj][m][n], 0, 0, 0); __builtin_amdgcn_s_setprio(0); } while (0)
#define PG8_WAIT_V(n) asm volatile("s_waitcnt vmcnt(" #n ")" ::: "memory")
#define PG8_WAIT_L(n) asm volatile("s_waitcnt lgkmcnt(" #n ")" ::: "memory")
#define PG8_BAR __builtin_amdgcn_s_barrier()
#define PG8_SCHED __builtin_amdgcn_sched_barrier(0)
    Unit cur, nxt; int ui = 0;
    if (!S.next(0, cur)) return;
    f32x4 acc[2][2][4][2];
#pragma unroll
    for (int a = 0; a < 2; ++a)
#pragma unroll
        for (int b = 0; b < 2; ++b)
#pragma unroll
            for (int m = 0; m < 4; ++m)
#pragma unroll
                for (int n = 0; n < 2; ++n) acc[a][b][m][n] = (f32x4){0.f, 0.f, 0.f, 0.f};
    bf16x8 At[4][2], B0[2][2], B1[2][2];
    unsigned vc[2][2], vn[2][2];
    const char* const Ab = (const char*)g.A;
    const char* cB = PG8_BBASE(cur);
    PG8_VOFFA(vc, cur);
    PG8_STAGE(PG8_SB(0, 0), cB, voffB); PG8_STAGE(PG8_SB(0, 1), cB + hstepB, voffB); PG8_STAGE(PG8_SA(0, 0), Ab, vc[0]); PG8_STAGE(PG8_SA(0, 1), Ab, vc[1]);
    if (wr == 1) PG8_BAR;
    PG8_WAIT_V(2); PG8_BAR;
    PG8_STAGE(PG8_SB(1, 0), cB + kstep, voffB); PG8_STAGE(PG8_SA(1, 0), Ab + kstep, vc[0]); PG8_STAGE(PG8_SB(1, 1), cB + hstepB + kstep, voffB);
    PG8_WAIT_V(6); PG8_BAR;
    for (;;) {
        const bool has_next = S.next(ui + 1, nxt);
        const char* nB = cB;
        if (has_next) { nB = PG8_BBASE(nxt); PG8_VOFFA(vn, nxt); }
        else {
#pragma unroll
            for (int h = 0; h < 2; ++h)
#pragma unroll
                for (int i = 0; i < 2; ++i) vn[h][i] = vc[h][i];
        }
        for (int t = 0; t < nt; t += 2) {
            const bool last = (t == nt - 2);
            const char* a1 = Ab + (size_t)(t + 1) * kstep;
            const char* a2 = last ? Ab : Ab + (size_t)(t + 2) * kstep; const char* b2 = last ? nB : cB + (size_t)(t + 2) * kstep;
            const char* a3 = a2 + kstep; const char* b3 = b2 + kstep;
            unsigned v2[2][2];
#pragma unroll
            for (int h = 0; h < 2; ++h)
#pragma unroll
                for (int i = 0; i < 2; ++i) v2[h][i] = last ? vn[h][i] : vc[h][i];
            PG8_LDB(B0, 0, 0); PG8_LDB(B1, 0, 1); PG8_SCHED; PG8_LDA(At, 0, 0); PG8_STAGE(PG8_SA(1, 1), a1, vc[1]);
            PG8_WAIT_V(8); PG8_WAIT_L(0); PG8_BAR; PG8_MMA(0, 0, At, B0); PG8_MMA(0, 1, At, B1); PG8_BAR; PG8_SCHED;
            PG8_LDA(At, 0, 1); PG8_STAGE(PG8_SB(0, 0), b2, voffB); PG8_STAGE(PG8_SB(0, 1), b2 + hstepB, voffB); PG8_STAGE(PG8_SA(0, 0), a2, v2[0]);
            PG8_WAIT_V(8); PG8_WAIT_L(0); PG8_BAR; PG8_MMA(1, 0, At, B0); PG8_MMA(1, 1, At, B1); PG8_BAR; PG8_SCHED;
            PG8_LDB(B0, 1, 0); PG8_LDB(B1, 1, 1); PG8_SCHED; PG8_LDA(At, 1, 0); PG8_STAGE(PG8_SA(0, 1), a2, v2[1]);
            PG8_WAIT_V(8); PG8_WAIT_L(0); PG8_BAR; PG8_MMA(0, 0, At, B0); PG8_MMA(0, 1, At, B1); PG8_BAR; PG8_SCHED;
            PG8_LDA(At, 1, 1); PG8_STAGE(PG8_SB(1, 0), b3, voffB); PG8_STAGE(PG8_SB(1, 1), b3 + hstepB, voffB); PG8_STAGE(PG8_SA(1, 0), a3, v2[0]);
            PG8_WAIT_V(8); PG8_WAIT_L(0); PG8_BAR; PG8_MMA(1, 0, At, B0); PG8_MMA(1, 1, At, B1); PG8_BAR; PG8_SCHED;
        }
        if constexpr (ALIGN_EPI) { if (wr == 0) PG8_BAR; }
        E(acc, cur, wr, wc, fr, fq);
        if (!has_next) break;
#pragma unroll
        for (int a = 0; a < 2; ++a)
#pragma unroll
            for (int b = 0; b < 2; ++b)
#pragma unroll
                for (int m = 0; m < 4; ++m)
#pragma unroll
                    for (int n = 0; n < 2; ++n) acc[a][b][m][n] = (f32x4){0.f, 0.f, 0.f, 0.f};
        cur = nxt; cB = nB; ++ui;
#pragma unroll
        for (int h = 0; h < 2; ++h)
#pragma unroll
            for (int i = 0; i < 2; ++i) vc[h][i] = vn[h][i];
        if constexpr (ALIGN_EPI) { if (wr == 1) PG8_BAR; }
    }
    PG8_WAIT_V(0);
    if constexpr (!ALIGN_EPI) { if (wr == 0) PG8_BAR; }
    PG8_BAR;
#undef PG8_SA
#undef PG8_SB
#undef PG8_STAGE
#undef PG8_VOFFA
#undef PG8_BBASE
#undef PG8_LDA
#undef PG8_LDB
#undef PG8_MMA
#undef PG8_WAIT_V
#undef PG8_WAIT_L
#undef PG8_BAR
#undef PG8_SCHED
}
}

constexpr int NWAVES = 8;
constexpr int NPH = 20;
#ifndef MK_N_LAUNCHES
#define MK_N_LAUNCHES 1
#endif
constexpr int N_LAUNCHES = MK_N_LAUNCHES;

constexpr size_t MiB = 1u << 20;
constexpr size_t WS_CTL = 0, CTL_ZERO_BYTES = 1 * MiB;
constexpr size_t WS_MOD = 1 * MiB;
constexpr size_t WS_ROPE = 2 * MiB;
constexpr size_t WS_WRKV = 6 * MiB;
constexpr size_t WS_WL1 = 12 * MiB;
constexpr size_t WS_WL2 = 14 * MiB;
constexpr size_t WS_WOUT = 16 * MiB;
constexpr size_t WS_WFGU = 18 * MiB;
constexpr size_t WS_WFDN = 29 * MiB;
constexpr size_t WS_WKV = 35 * MiB;
constexpr size_t WS_WQ = 41 * MiB;
constexpr size_t WS_WO = 44 * MiB;
constexpr size_t WS_WMGU = 46 * MiB;
constexpr size_t WS_WMDN = 158 * MiB;
constexpr size_t WS_AR = 216 * MiB;
constexpr size_t AR(size_t mib) { return WS_AR + mib * MiB; }
constexpr size_t WS_A6 = AR(0);
constexpr size_t WS_L1 = AR(384);
constexpr size_t WS_RB = AR(432), WS_KB = AR(496), WS_VB = AR(560);
constexpr size_t WS_AS = AR(192), WS_G = AR(256);
constexpr size_t WS_YS = AR(0);
constexpr size_t WS_YG = AR(128);
constexpr size_t WS_Z = AR(320);
constexpr size_t WS_SE = AR(384);
constexpr size_t WS_Y1 = AR(320);
constexpr size_t WS_X1 = AR(448);
constexpr size_t WS_H2 = AR(576);
constexpr size_t WS_ACT = AR(0);
constexpr size_t WS_Y2 = AR(176);
constexpr size_t WS_X2 = AR(304);
constexpr size_t WS_HKV = AR(0), WS_H3 = AR(64);
constexpr size_t WS_K2 = AR(128), WS_V2 = AR(432), WS_Q2 = AR(528);
constexpr size_t WS_OG = AR(0);
constexpr size_t WS_LSE = AR(96);
constexpr size_t WS_OM = AR(224);
constexpr size_t WS_Y3 = AR(432);
constexpr size_t WS_H4 = AR(0);
constexpr size_t WS_ROUTE = AR(66);
constexpr size_t WS_ACT2 = AR(70);
constexpr size_t WS_YB = AR(532);
constexpr size_t WS_END = AR(664);
static_assert(WS_END <= 896 * MiB, "workspace");
static_assert((size_t)RMAX * DFE * 2 <= 462 * MiB && (size_t)RMAX * D * 2 <= 132 * MiB, "moe buffers");
constexpr size_t RT_TOKE = 0;
constexpr size_t RT_TOKR = 256 * 1024;
constexpr size_t RT_TOKW = 512 * 1024;
constexpr size_t RT_ROWTOK = 768 * 1024;
constexpr size_t RT_BLKEXP = 1280 * 1024;
constexpr int CW_BAR = 4096;
constexpr int CW_CNT = 16384;
constexpr int CW_NBLK = 16448;

constexpr int RING_BYTES = 131072;
constexpr int LDSCTL_OFF = RING_BYTES, MISC_OFF = LDSCTL_OFF + 320;
constexpr int LDS_BYTES = 147456;

#define LDS_WAIT() asm volatile("s_waitcnt lgkmcnt(0)" ::: "memory")
#define VM_WAIT() asm volatile("s_waitcnt vmcnt(0)" ::: "memory")

#define XB_TMO      128
#define XB_XCNT(j)  (256  + 64 * (j))
#define XB_XSUB(j)  (1280 + 64 * (j))
#define XB_XGEN(j)  (2304 + 64 * (j))
#define XB_TOP      3328
#define XB_TOPGEN   3392
#define XCD_BAR_WORDS 3456
#define XB_SPIN_CAP (1u << 22)

__device__ __forceinline__ unsigned xb_ld(unsigned* p)              { return __hip_atomic_load(p, __ATOMIC_RELAXED, __HIP_MEMORY_SCOPE_AGENT); }
__device__ __forceinline__ unsigned xb_add(unsigned* p, unsigned v) { return __hip_atomic_fetch_add(p, v, __ATOMIC_RELAXED, __HIP_MEMORY_SCOPE_AGENT); }
__device__ __forceinline__ unsigned xb_xcc_id() { return (unsigned)__builtin_amdgcn_s_getreg((3 << 11) | 20) & 0xFu; }
#define XB_SPIN(cond, bar) do { unsigned _sp = 0; while (cond) { __builtin_amdgcn_s_sleep(1); \
    if ((++_sp & 255u) == 0u) { if (xb_ld(&(bar)[XB_TMO])) break; if (_sp > XB_SPIN_CAP) { atomicAdd(&(bar)[XB_TMO], 1u); break; } } } } while (0)

struct XcdBarrier { unsigned* bar; unsigned x; volatile LAS unsigned* st; };
__device__ __forceinline__ XcdBarrier xcd_barrier_post(unsigned* bar, volatile LAS unsigned* st) {
    XcdBarrier b; b.bar = bar; b.x = xb_xcc_id(); b.st = st;
    if (threadIdx.x == 0) (void)xb_add(&bar[XB_XCNT(b.x)], 1u);
    return b;
}
__device__ __forceinline__ void xcd_barrier_complete(unsigned* bar, unsigned x, unsigned& nloc, unsigned& nx) {
    const unsigned G = gridDim.x * gridDim.y * gridDim.z;
    unsigned sum, cnt, mine, sp = 0u;
    for (;;) {
        sum = 0u; cnt = 0u; mine = 0u;
#pragma unroll
        for (unsigned j = 0; j < 16; ++j) { const unsigned c = xb_ld(&bar[XB_XCNT(j)]); sum += c; cnt += (c > 0u) ? 1u : 0u; mine = (j == x) ? c : mine; }
        if (sum == G) break;
        __builtin_amdgcn_s_sleep(1);
        if ((++sp & 255u) == 0u) { if (xb_ld(&bar[XB_TMO])) break; if (sp > XB_SPIN_CAP) { atomicAdd(&bar[XB_TMO], 1u); break; } }
    }
    nloc = mine > 0u ? mine : 1u; nx = cnt > 0u ? cnt : 1u;
}
__device__ __forceinline__ void xcd_barrier(const XcdBarrier& b) {
    asm volatile("s_waitcnt vmcnt(0)" ::: "memory");
    __syncthreads();
    if (threadIdx.x == 0) {
        unsigned* bar = b.bar;
        __builtin_amdgcn_s_waitcnt(0);
        unsigned nloc = b.st[0], nx = b.st[1];
        if (nloc == 0u) { xcd_barrier_complete(bar, b.x, nloc, nx); b.st[0] = nloc; b.st[1] = nx; }
        const unsigned old = xb_add(&bar[XB_XSUB(b.x)], 1u);
        const unsigned gen = old / nloc;
        if (old + 1u == (gen + 1u) * nloc) {
            __builtin_amdgcn_fence(__ATOMIC_RELEASE, "agent");
            asm volatile("s_waitcnt vmcnt(0)" ::: "memory");
            const unsigned og = xb_add(&bar[XB_TOP], 1u);
            const unsigned tg = og / nx;
            if (og + 1u == (tg + 1u) * nx) xb_add(&bar[XB_TOPGEN], 1u);
            else XB_SPIN(xb_ld(&bar[XB_TOPGEN]) == tg, bar);
            __builtin_amdgcn_fence(__ATOMIC_ACQUIRE, "agent");
            xb_add(&bar[XB_XGEN(b.x)], 1u);
            asm volatile("s_waitcnt vmcnt(0)" ::: "memory");
        } else {
            XB_SPIN(xb_ld(&bar[XB_XGEN(b.x)]) == gen, bar);
            __builtin_amdgcn_fence(__ATOMIC_ACQUIRE, "agent");
            asm volatile("s_waitcnt vmcnt(0)" ::: "memory");
        }
    }
    __syncthreads();
}

struct Frame {
    LAS unsigned char* lds;
    volatile LAS unsigned* MISC;
    gu32* ctl;
    int tid, lane, wave;
    int vcu, G;
    const float* const* in;
    float* out;
    unsigned char* ws;
};
#define WSP(type, off) ((type*)(F.ws + (off)))

__device__ __forceinline__ float wave_sum(float v) {
#pragma unroll
    for (int o = 1; o < 64; o <<= 1) v += __shfl_xor(v, o);
    return v;
}

__device__ __forceinline__ int colmap(int kind, int half, int n) {
    if (kind == 1) return (n & 1) ? half + (n >> 1) : (n >> 1);
    if (kind == 2 || (kind == 3 && n < QW)) { const int hd = n >> 6, p = n & 63; return hd * 64 + ((p & 1) * 32 + (p >> 1)); }
    return n;
}
__device__ __forceinline__ void cvt_item(const float* W, int ldw, int Kv, int Nv, bf16_t* WT, int Kout, int Nout, int kind, int half, LAS float* scr, int item, int lane) {
    const int nblk = Nout / 32, kb = item / nblk, nb = item % nblk, k0 = 64 * kb, n0 = 32 * nb;
    const int nn = n0 + (lane & 31); const int sc = colmap(kind, half, nn); const bool nok = nn < Nv;
#pragma unroll 8
    for (int i = 0; i < 32; ++i) { const int kk = 2 * i + (lane >> 5); float v = 0.f; if (nok && (k0 + kk) < Kv) v = W[(size_t)(k0 + kk) * ldw + sc]; scr[kk * 33 + (lane & 31)] = v; }
    LDS_WAIT(); asm volatile("" ::: "memory");
    const int c = lane & 7;
#pragma unroll
    for (int j = 0; j < 4; ++j) { const int n = (lane >> 3) + 8 * j; const LAS float* s = scr + (8 * c) * 33 + n;
        u32x4 o; o.x = cvt_pk_bf16(s[0 * 33], s[1 * 33]); o.y = cvt_pk_bf16(s[2 * 33], s[3 * 33]); o.z = cvt_pk_bf16(s[4 * 33], s[5 * 33]); o.w = cvt_pk_bf16(s[6 * 33], s[7 * 33]);
        *(u32x4*)(WT + (size_t)(n0 + n) * Kout + k0 + 8 * c) = o; }
    LDS_WAIT(); asm volatile("" ::: "memory");
}
__device__ __forceinline__ int invmap(int kind, int half, int sc) {
    if (kind == 1) return sc < half ? 2 * sc : 2 * (sc - half) + 1;
    if (kind == 2 || (kind == 3 && sc < QW)) { const int hd = sc >> 6, d = sc & 63; return hd * 64 + (d < 32 ? 2 * d : 2 * (d - 32) + 1); }
    return sc;
}
constexpr int CV_STRIDE = 68;
__device__ __forceinline__ void cvt_item64(const float* W, int ldw, bf16_t* WT, int Kout, int nblk, int kind, int half, LAS bf16_t* scr, int item, int lane) {
    const int kb = item / nblk, nb = item % nblk, k0 = 64 * kb, n0 = 64 * nb;
    const int c4 = lane & 15, kr = lane >> 4;
    f32x4 v[8][2];
#pragma unroll
    for (int i = 0; i < 8; ++i)
#pragma unroll
        for (int e = 0; e < 2; ++e) v[i][e] = __builtin_nontemporal_load((const f32x4*)(W + (size_t)(k0 + 8 * i + 2 * kr + e) * ldw + n0 + 4 * c4));
#pragma unroll
    for (int i = 0; i < 8; ++i)
#pragma unroll
        for (int e = 0; e < 4; ++e) *(LAS unsigned*)(scr + (4 * c4 + e) * CV_STRIDE + 8 * i + 2 * kr) = cvt_pk_bf16(v[i][0][e], v[i][1][e]);
    LDS_WAIT(); asm volatile("" ::: "memory");
    const int c = lane & 7;
#pragma unroll
    for (int j = 0; j < 8; ++j) { const int n = (lane >> 3) + 8 * j; const LAS bf16_t* sp = scr + n * CV_STRIDE + 8 * c;
        const u32x2 a = *(const LAS u32x2*)sp, b = *(const LAS u32x2*)(sp + 4);
        *(u32x4*)(WT + (size_t)invmap(kind, half, n0 + n) * Kout + k0 + 8 * c) = (u32x4){a.x, a.y, b.x, b.y}; }
    LDS_WAIT(); asm volatile("" ::: "memory");
}
__device__ __forceinline__ void p0_prologue(Frame& F) {
    {
        LAS float* part = (LAS float*)F.lds;
        const float* c = F.in[1]; const float* aw = F.in[2]; const float* ab = F.in[3]; float* MOD = WSP(float, WS_MOD);
        for (int it = F.vcu; it < ADA_W / 64; it += F.G) {
            const int j = it * 64 + F.lane; float s0 = 0.f, s1 = 0.f;
#pragma unroll 8
            for (int k = F.wave * 128; k < F.wave * 128 + 128; ++k) { const float w = aw[(size_t)k * ADA_W + j]; s0 += siluf_(c[k]) * w; s1 += siluf_(c[D + k]) * w; }
            part[(F.wave * 2 + 0) * 64 + F.lane] = s0; part[(F.wave * 2 + 1) * 64 + F.lane] = s1;
            __syncthreads();
            if (F.wave < 2) { float s = ab[j];
#pragma unroll
                for (int w = 0; w < 8; ++w) s += part[(w * 2 + F.wave) * 64 + F.lane];
                MOD[F.wave * ADA_W + j] = s; }
            __syncthreads();
        }
    }
    {
        float* cs = WSP(float, WS_ROPE); float* sn = cs + SEQ * 32;
        for (int idx = F.vcu * 512 + F.tid; idx < SEQ * 32; idx += F.G * 512) {
            const int t = idx >> 5, i = idx & 31;
            const float inv = powf(10000.0f, -(float)i / 32.0f); const float ang = (float)t * inv;
            cs[idx] = cosf(ang); sn[idx] = sinf(ang);
        }
    }
    LAS float* scr = (LAS float*)(F.lds + F.wave * 16384);
    LAS bf16_t* scrh = (LAS bf16_t*)(F.lds + F.wave * 16384);
    const int gw = F.vcu * NWAVES + F.wave, NGW = F.G * NWAVES;
    {
        constexpr int J_MGU = 16 * 112, J_MDN = 56 * 16, J_RKV = 16 * 48, J_OUT = 16 * 16, J_FGU = 16 * 88, J_FDN = 44 * 16, J_KV = 16 * 48, J_Q = 16 * 24, J_O = 8 * 16;
        constexpr int NJ = 8 * J_MGU + 8 * J_MDN + J_RKV + J_OUT + J_FGU + J_FDN + J_KV + J_Q + J_O;
        for (int it = gw; it < NJ; it += NGW) {
            int r = it;
            if (r < 8 * J_MGU) { const int e = r / J_MGU; cvt_item64(F.in[28] + (size_t)e * D * 2 * DFE, 2 * DFE, WSP(bf16_t, WS_WMGU) + (size_t)e * 2 * DFE * D, D, 112, 1, DFE, scrh, r % J_MGU, F.lane); continue; } r -= 8 * J_MGU;
            if (r < 8 * J_MDN) { const int e = r / J_MDN; cvt_item64(F.in[29] + (size_t)e * DFE * D, D, WSP(bf16_t, WS_WMDN) + (size_t)e * D * DFE, DFE, 16, 0, 0, scrh, r % J_MDN, F.lane); continue; } r -= 8 * J_MDN;
            if (r < J_RKV) { cvt_item64(F.in[7], 3 * D, WSP(bf16_t, WS_WRKV), D, 48, 0, 0, scrh, r, F.lane); continue; } r -= J_RKV;
            if (r < J_OUT) { cvt_item64(F.in[21], D, WSP(bf16_t, WS_WOUT), D, 16, 0, 0, scrh, r, F.lane); continue; } r -= J_OUT;
            if (r < J_FGU) { cvt_item64(F.in[25], 2 * DFF, WSP(bf16_t, WS_WFGU), D, 88, 1, DFF, scrh, r, F.lane); continue; } r -= J_FGU;
            if (r < J_FDN) { cvt_item64(F.in[26], D, WSP(bf16_t, WS_WFDN), DFF, 16, 0, 0, scrh, r, F.lane); continue; } r -= J_FDN;
            if (r < J_KV) { cvt_item64(F.in[22], 2 * QW, WSP(bf16_t, WS_WKV), D, 48, 3, 0, scrh, r, F.lane); continue; } r -= J_KV;
            if (r < J_Q) { cvt_item64(F.in[23], QW, WSP(bf16_t, WS_WQ), D, 24, 2, 0, scrh, r, F.lane); continue; } r -= J_Q;
            cvt_item64(F.in[24], D, WSP(bf16_t, WS_WO), AOUT, 16, 0, 0, scrh, r, F.lane);
        }
    }
    {
        constexpr int I_L1 = 16 * 8, I_L2 = 4 * 32;
        for (int it = gw; it < 3 * I_L1 + 3 * I_L2; it += NGW) {
            int r = it;
            if (r < I_L1) { cvt_item(F.in[9], 64, D, 64, WSP(bf16_t, WS_WL1), D, 256, 0, 0, scr, r, F.lane); continue; } r -= I_L1;
            if (r < I_L1) { cvt_item(F.in[12], 64, D, 64, WSP(bf16_t, WS_WL1) + 256 * D, D, 256, 0, 0, scr, r, F.lane); continue; } r -= I_L1;
            if (r < I_L1) { cvt_item(F.in[14], 160, D, 160, WSP(bf16_t, WS_WL1) + 2 * 256 * D, D, 256, 0, 0, scr, r, F.lane); continue; } r -= I_L1;
            if (r < I_L2) { cvt_item(F.in[10], D, 64, D, WSP(bf16_t, WS_WL2), 256, D, 0, 0, scr, r, F.lane); continue; } r -= I_L2;
            if (r < I_L2) { cvt_item(F.in[13], D, 64, D, WSP(bf16_t, WS_WL2) + D * 256, 256, D, 0, 0, scr, r, F.lane); continue; } r -= I_L2;
            cvt_item(F.in[15], D, 160, D, WSP(bf16_t, WS_WL2) + 2 * D * 256, 256, D, 0, 0, scr, r, F.lane);
        }
    }
}

__device__ __forceinline__ void p1_lerp(Frame& F) {
    const int gw = F.vcu * NWAVES + F.wave, NGW = F.G * NWAVES;
    const float* x = F.in[0]; const float* mu = F.in[6]; const float* MOD = WSP(float, WS_MOD); bf16_t* A6 = WSP(bf16_t, WS_A6);
    for (int m = gw; m < T; m += NGW) {
        const int b = m >> 14, t = m & (SEQ - 1);
#pragma unroll
        for (int j = 0; j < 4; ++j) {
            const int c = 4 * F.lane + 256 * j;
            const f32x4 sh = *(const f32x4*)(MOD + b * ADA_W + 0 * D + c), sc = *(const f32x4*)(MOD + b * ADA_W + 1 * D + c);
            const f32x4 xc = *(const f32x4*)(x + (size_t)m * D + c);
            const f32x4 hc = xc * (1.f + sc) + sh;
            f32x4 hp = (f32x4){0.f, 0.f, 0.f, 0.f};
            if (t > 0) { const f32x4 xp = *(const f32x4*)(x + (size_t)(m - 1) * D + c); hp = xp * (1.f + sc) + sh; }
            const f32x4 xx = hp - hc;
#pragma unroll
            for (int p = 0; p < 6; ++p) {
                const f32x4 mv = *(const f32x4*)(mu + p * D + c); const f32x4 o = hc + xx * mv;
                u32x2 w; w.x = cvt_pk_bf16(o[0], o[1]); w.y = cvt_pk_bf16(o[2], o[3]);
                *(u32x2*)(A6 + (size_t)p * T * D + (size_t)m * D + c) = w;
            }
        }
    }
}

template <int CTRL> __device__ __forceinline__ float dpp_mov(float v) { return __int_as_float(__builtin_amdgcn_update_dpp(0, __float_as_int(v), CTRL, 0xF, 0xF, false)); }
__device__ __forceinline__ float sum16(float v) {
    v += dpp_mov<0xB1>(v); v += dpp_mov<0x4E>(v); v += dpp_mov<0x141>(v); v += dpp_mov<0x140>(v); return v;
}
constexpr int NSEG = 8, SEGLEN = SEQ / NSEG, TC = 32;
constexpr int SC_BUF = 6 * TC * 64 * 4;
struct ScanRegs { u32x2 rw, kw, aw, vw; f32x4 wl; };
__device__ __forceinline__ void scan_load(ScanRegs& R, const bf16_t* RB, const bf16_t* KB, const bf16_t* VB, const bf16_t* AS, const float* WLOG, size_t m, int scol) {
    R.rw = *(const u32x2*)(RB + m * D + scol); R.kw = *(const u32x2*)(KB + m * D + scol); R.aw = *(const u32x2*)(AS + m * D + scol); R.vw = *(const u32x2*)(VB + m * D + scol);
    R.wl = *(const f32x4*)(WLOG + m * D + scol);
}
__device__ __forceinline__ void scan_stage(const ScanRegs& R, LAS float* buf, int ts, int skq, const f32x4 kk4, const f32x4 ka4) {
    const f32x4 r4 = (f32x4){bflo(R.rw.x), bfhi(R.rw.x), bflo(R.rw.y), bfhi(R.rw.y)}, k4 = (f32x4){bflo(R.kw.x), bfhi(R.kw.x), bflo(R.kw.y), bfhi(R.kw.y)};
    const f32x4 a4 = (f32x4){bflo(R.aw.x), bfhi(R.aw.x), bflo(R.aw.y), bfhi(R.aw.y)}, v4 = (f32x4){bflo(R.vw.x), bfhi(R.vw.x), bflo(R.vw.y), bfhi(R.vw.y)};
    f32x4 kkv = k4 * kk4; float ss = kkv[0] * kkv[0] + kkv[1] * kkv[1] + kkv[2] * kkv[2] + kkv[3] * kkv[3]; ss = sum16(ss);
    const float inv = 1.f / fmaxf(sqrtf(ss), 1e-12f); kkv = kkv * inv;
    const f32x4 kp = k4 * (1.f + (a4 - 1.f) * ka4), bb = kkv * a4;
    f32x4 w4; w4[0] = __expf(R.wl[0]); w4[1] = __expf(R.wl[1]); w4[2] = __expf(R.wl[2]); w4[3] = __expf(R.wl[3]);
    const int o = ts * 64 + 4 * skq;
    *(LAS f32x4*)(buf + 0 * TC * 64 + o) = -kkv; *(LAS f32x4*)(buf + 1 * TC * 64 + o) = w4; *(LAS f32x4*)(buf + 2 * TC * 64 + o) = bb;
    *(LAS f32x4*)(buf + 3 * TC * 64 + o) = kp; *(LAS f32x4*)(buf + 4 * TC * 64 + o) = r4; *(LAS f32x4*)(buf + 5 * TC * 64 + o) = v4;
}
template <bool IS_S> __device__ __forceinline__ void scan_steps(f32x4 (&S)[4], const LAS float* buf, LAS float* Yb, int rg, int kq) {
#pragma unroll 2
    for (int tt = 0; tt < TC; ++tt) {
        const int o = tt * 64 + 4 * kq;
        const f32x4 a4 = *(const LAS f32x4*)(buf + 0 * TC * 64 + o), w4 = *(const LAS f32x4*)(buf + 1 * TC * 64 + o), b4 = *(const LAS f32x4*)(buf + 2 * TC * 64 + o);
        const f32x4 k4 = *(const LAS f32x4*)(buf + 3 * TC * 64 + o), r4 = *(const LAS f32x4*)(buf + 4 * TC * 64 + o);
        f32x4 v4 = (f32x4){0.f, 0.f, 0.f, 0.f};
        if (IS_S) v4 = *(const LAS f32x4*)(buf + 5 * TC * 64 + tt * 64 + 4 * rg);
        float sa[4];
#pragma unroll
        for (int r = 0; r < 4; ++r) sa[r] = (S[r][0] * a4[0] + S[r][1] * a4[1]) + (S[r][2] * a4[2] + S[r][3] * a4[3]);
#pragma unroll
        for (int r = 0; r < 4; ++r) sa[r] = sum16(sa[r]);
        f32x4 y;
#pragma unroll
        for (int r = 0; r < 4; ++r) {
            if (IS_S) S[r] = S[r] * w4 + (sa[r] * b4 + v4[r] * k4); else S[r] = S[r] * w4 + sa[r] * b4;
            y[r] = (S[r][0] * r4[0] + S[r][1] * r4[1]) + (S[r][2] * r4[2] + S[r][3] * r4[3]);
        }
#pragma unroll
        for (int r = 0; r < 4; ++r) y[r] = sum16(y[r]);
        if (kq == 0) *(LAS f32x4*)(Yb + tt * 128 + 4 * rg) = y;
    }
}
__device__ __forceinline__ void p4_scan_seg(Frame& F) {
    LAS float* buf0 = (LAS float*)F.lds; LAS float* buf1 = (LAS float*)(F.lds + SC_BUF); LAS float* Yb = (LAS float*)(F.lds + 2 * SC_BUF);
    const bf16_t* RB = WSP(bf16_t, WS_RB); const bf16_t* KB = WSP(bf16_t, WS_KB); const bf16_t* VB = WSP(bf16_t, WS_VB); const bf16_t* AS = WSP(bf16_t, WS_AS);
    const float* WLOG = F.out; float* YL = WSP(float, WS_YS); bf16_t* Z = WSP(bf16_t, WS_Z); float* SE = WSP(float, WS_SE);
    const float* k_k = F.in[16]; const float* k_a = F.in[17];
    const int rg = F.tid >> 4, kq = F.tid & 15;
    const int ts = rg, skq = kq;
    for (int unit = blockIdx.x; unit < BATCH * 16 * NSEG; unit += F.G) {
        const int b = unit >> 7, h = (unit >> 3) & 15, seg = unit & 7;
        const int scol = h * 64 + 4 * skq; const size_t m0 = (size_t)b * SEQ + (size_t)seg * SEGLEN;
        const f32x4 kk4 = *(const f32x4*)(k_k + scol), ka4 = *(const f32x4*)(k_a + scol);
        f32x4 S[4];
#pragma unroll
        for (int r = 0; r < 4; ++r)
#pragma unroll
            for (int e = 0; e < 4; ++e) S[r][e] = (rg >= 16 && (4 * (rg - 16) + r) == (4 * kq + e)) ? 1.f : 0.f;
        ScanRegs R;
        scan_load(R, RB, KB, VB, AS, WLOG, m0 + ts, scol);
        scan_stage(R, buf0, ts, skq, kk4, ka4);
        __syncthreads();
        for (int chunk = 0; chunk < SEGLEN / TC; ++chunk) {
            LAS float* cb = (chunk & 1) ? buf1 : buf0; LAS float* nb = (chunk & 1) ? buf0 : buf1;
            const bool more = chunk + 1 < SEGLEN / TC;
            if (more) scan_load(R, RB, KB, VB, AS, WLOG, m0 + (size_t)(chunk + 1) * TC + ts, scol);
            if (rg < 16) scan_steps<true>(S, cb, Yb, rg, kq); else scan_steps<false>(S, cb, Yb, rg, kq);
            __syncthreads();
            if (more) scan_stage(R, nb, ts, skq, kk4, ka4);
            {
                const int tt = F.tid >> 4, c8 = (F.tid & 15) * 8; const size_t m = m0 + (size_t)chunk * TC + tt;
                const f32x4 y0 = *(const LAS f32x4*)(Yb + tt * 128 + c8), y1 = *(const LAS f32x4*)(Yb + tt * 128 + c8 + 4);
                if (c8 < 64) { float* p = YL + m * D + h * 64 + c8; *(f32x4*)p = y0; *(f32x4*)(p + 4) = y1; }
                else { u32x4 w; w.x = cvt_pk_bf16(y0[0], y0[1]); w.y = cvt_pk_bf16(y0[2], y0[3]); w.z = cvt_pk_bf16(y1[0], y1[1]); w.w = cvt_pk_bf16(y1[2], y1[3]);
                    *(u32x4*)(Z + m * D + h * 64 + (c8 - 64)) = w; }
            }
            __syncthreads();
        }
        {
            float* p = SE + (size_t)unit * 2 * 4096 + (rg >= 16 ? 4096 : 0) + (4 * (rg & 15)) * 64 + 4 * kq;
#pragma unroll
            for (int r = 0; r < 4; ++r) *(f32x4*)(p + r * 64) = S[r];
        }
    }
}

__device__ __forceinline__ void p5_fix_gnorm(Frame& F) {
    LAS float* Sst = (LAS float*)F.lds;
    const float* YL = WSP(float, WS_YS); const bf16_t* Z = WSP(bf16_t, WS_Z); const float* SE = WSP(float, WS_SE);
    const bf16_t* RB = WSP(bf16_t, WS_RB); const bf16_t* KB = WSP(bf16_t, WS_KB); const bf16_t* VB = WSP(bf16_t, WS_VB);
    const bf16_t* AS = WSP(bf16_t, WS_AS); const bf16_t* GG = WSP(bf16_t, WS_G); bf16_t* YG = WSP(bf16_t, WS_YG);
    const int lane = F.lane, q16 = lane & 15, qd = lane >> 4;
    for (int unit = blockIdx.x; unit < BATCH * 16 * NSEG; unit += F.G) {
        const int b = unit >> 7, h = (unit >> 3) & 15, seg = unit & 7;
        {
            const int v = F.tid >> 3, k8 = (F.tid & 7) * 8;
            float cur[8];
#pragma unroll
            for (int e = 0; e < 8; ++e) cur[e] = 0.f;
            for (int sp = 0; sp < seg; ++sp) {
                const float* Se = SE + (size_t)(unit - seg + sp) * 2 * 4096; const float* Ee = Se + 4096;
                __syncthreads();
#pragma unroll
                for (int e = 0; e < 8; ++e) Sst[v * 68 + k8 + e] = cur[e];
                __syncthreads();
                const f32x4 s0 = *(const f32x4*)(Se + v * 64 + k8), s1 = *(const f32x4*)(Se + v * 64 + k8 + 4);
                float nw[8] = {s0[0], s0[1], s0[2], s0[3], s1[0], s1[1], s1[2], s1[3]};
                if (sp > 0) {
#pragma unroll 4
                    for (int i = 0; i < 64; ++i) { const float sv = Sst[v * 68 + i]; const f32x4 e0 = *(const f32x4*)(Ee + i * 64 + k8), e1 = *(const f32x4*)(Ee + i * 64 + k8 + 4);
                        nw[0] += sv * e0[0]; nw[1] += sv * e0[1]; nw[2] += sv * e0[2]; nw[3] += sv * e0[3]; nw[4] += sv * e1[0]; nw[5] += sv * e1[1]; nw[6] += sv * e1[2]; nw[7] += sv * e1[3]; }
                }
#pragma unroll
                for (int e = 0; e < 8; ++e) cur[e] = nw[e];
            }
            __syncthreads();
#pragma unroll
            for (int e = 0; e < 8; ++e) Sst[v * 68 + k8 + e] = cur[e];
            __syncthreads();
        }
        bf16x8 af[4][2];
#pragma unroll
        for (int vt = 0; vt < 4; ++vt)
#pragma unroll
            for (int ks = 0; ks < 2; ++ks) { const LAS float* p = Sst + (16 * vt + q16) * 68 + 32 * ks + 8 * qd; const f32x4 x0 = *(const LAS f32x4*)p, x1 = *(const LAS f32x4*)(p + 4);
                union { bf16x8 v; unsigned u[4]; } t; t.u[0] = cvt_pk_bf16(x0[0], x0[1]); t.u[1] = cvt_pk_bf16(x0[2], x0[3]); t.u[2] = cvt_pk_bf16(x1[0], x1[1]); t.u[3] = cvt_pk_bf16(x1[2], x1[3]); af[vt][ks] = t.v; }
        f32x4 ka[4], rk[4], lg[4], lb[4];
#pragma unroll
        for (int vt = 0; vt < 4; ++vt) { const int c = h * 64 + 16 * vt + 4 * qd; ka[vt] = *(const f32x4*)(F.in[17] + c); rk[vt] = *(const f32x4*)(F.in[18] + c); lg[vt] = *(const f32x4*)(F.in[19] + c); lb[vt] = *(const f32x4*)(F.in[20] + c); }
        for (int tile = F.wave; tile < SEGLEN / 16; tile += NWAVES) {
            const size_t m = (size_t)b * SEQ + (size_t)seg * SEGLEN + tile * 16 + q16;
            const bf16x8 z0 = *(const bf16x8*)(Z + m * D + h * 64 + 8 * qd), z1 = *(const bf16x8*)(Z + m * D + h * 64 + 32 + 8 * qd);
            f32x4 y[4]; float s = 0.f, bn = 0.f;
            f32x4 vv[4], gg[4];
#pragma unroll
            for (int vt = 0; vt < 4; ++vt) {
                const size_t off = m * D + h * 64 + 16 * vt + 4 * qd;
                f32x4 a = *(const f32x4*)(YL + off);
                a = __builtin_amdgcn_mfma_f32_16x16x32_bf16(af[vt][0], z0, a, 0, 0, 0);
                a = __builtin_amdgcn_mfma_f32_16x16x32_bf16(af[vt][1], z1, a, 0, 0, 0);
                y[vt] = a;
                const u32x2 rw = *(const u32x2*)(RB + off), kw = *(const u32x2*)(KB + off), vw = *(const u32x2*)(VB + off), aw = *(const u32x2*)(AS + off), gw = *(const u32x2*)(GG + off);
                const f32x4 r4 = (f32x4){bflo(rw.x), bfhi(rw.x), bflo(rw.y), bfhi(rw.y)}, k4 = (f32x4){bflo(kw.x), bfhi(kw.x), bflo(kw.y), bfhi(kw.y)}, a4 = (f32x4){bflo(aw.x), bfhi(aw.x), bflo(aw.y), bfhi(aw.y)};
                vv[vt] = (f32x4){bflo(vw.x), bfhi(vw.x), bflo(vw.y), bfhi(vw.y)}; gg[vt] = (f32x4){bflo(gw.x), bfhi(gw.x), bflo(gw.y), bfhi(gw.y)};
                const f32x4 kp = k4 * (1.f + (a4 - 1.f) * ka[vt]); const f32x4 pr = r4 * kp * rk[vt];
                bn += (pr[0] + pr[1]) + (pr[2] + pr[3]);
            }
#pragma unroll
            for (int vt = 0; vt < 4; ++vt) s += (y[vt][0] + y[vt][1]) + (y[vt][2] + y[vt][3]);
            s += __shfl_xor(s, 16); s += __shfl_xor(s, 32); bn += __shfl_xor(bn, 16); bn += __shfl_xor(bn, 32);
            const float mean = s * (1.f / 64.f); float qv = 0.f;
#pragma unroll
            for (int vt = 0; vt < 4; ++vt) { y[vt] = y[vt] - mean; qv += (y[vt][0] * y[vt][0] + y[vt][1] * y[vt][1]) + (y[vt][2] * y[vt][2] + y[vt][3] * y[vt][3]); }
            qv += __shfl_xor(qv, 16); qv += __shfl_xor(qv, 32);
            const float rstd = 1.f / sqrtf(qv * (1.f / 64.f) + LNX_EPS);
#pragma unroll
            for (int vt = 0; vt < 4; ++vt) {
                const f32x4 o = ((y[vt] * rstd) * lg[vt] + lb[vt] + bn * vv[vt]) * gg[vt];
                u32x2 w; w.x = cvt_pk_bf16(o[0], o[1]); w.y = cvt_pk_bf16(o[2], o[3]);
                *(u32x2*)(YG + m * D + h * 64 + 16 * vt + 4 * qd) = w;
            }
        }
        __syncthreads();
    }
}

__device__ __forceinline__ void ln_apply(f32x4 (&v)[4], const float* g, const float* b, int lane) {
    float s = 0.f;
#pragma unroll
    for (int j = 0; j < 4; ++j) s += (v[j][0] + v[j][1]) + (v[j][2] + v[j][3]);
    const float mean = wave_sum(s) * (1.f / D); float s2 = 0.f;
#pragma unroll
    for (int j = 0; j < 4; ++j) { v[j] = v[j] - mean; s2 += (v[j][0] * v[j][0] + v[j][1] * v[j][1]) + (v[j][2] * v[j][2] + v[j][3] * v[j][3]); }
    const float rstd = 1.f / sqrtf(wave_sum(s2) * (1.f / D) + LN_EPS);
#pragma unroll
    for (int j = 0; j < 4; ++j) { const int c = 4 * lane + 256 * j; v[j] = v[j] * rstd * *(const f32x4*)(g + c) + *(const f32x4*)(b + c); }
}
__device__ __forceinline__ void mod_store(const f32x4 (&v)[4], const float* shift, const float* scale, bf16_t* orow, int lane) {
#pragma unroll
    for (int j = 0; j < 4; ++j) { const int c = 4 * lane + 256 * j; const f32x4 o = v[j] * (1.f + *(const f32x4*)(scale + c)) + *(const f32x4*)(shift + c);
        u32x2 w; w.x = cvt_pk_bf16(o[0], o[1]); w.y = cvt_pk_bf16(o[2], o[3]); *(u32x2*)(orow + c) = w; }
}
__device__ __forceinline__ void p_postnorm(Frame& F, const float* xres, const bf16_t* y, float* xout, int sub, int modA, bf16_t* outA, int modB, bf16_t* outB) {
    const int gw = F.vcu * NWAVES + F.wave, NGW = F.G * NWAVES;
    const float* MOD = WSP(float, WS_MOD); const float* g = F.in[4] + sub * D; const float* bb = F.in[5] + sub * D;
    for (int m = gw; m < T; m += NGW) {
        const int b = m >> 14; const float* gate = MOD + b * ADA_W + (sub * 3 + 2) * D;
        f32x4 v[4];
#pragma unroll
        for (int j = 0; j < 4; ++j) { const int c = 4 * F.lane + 256 * j;
            const u32x2 yw = *(const u32x2*)(y + (size_t)m * D + c); const f32x4 yv = (f32x4){bflo(yw.x), bfhi(yw.x), bflo(yw.y), bfhi(yw.y)};
            v[j] = DN_ALPHA * *(const f32x4*)(xres + (size_t)m * D + c) + (1.f + *(const f32x4*)(gate + c)) * yv; }
        ln_apply(v, g, bb, F.lane);
#pragma unroll
        for (int j = 0; j < 4; ++j) *(f32x4*)(xout + (size_t)m * D + 4 * F.lane + 256 * j) = v[j];
        if (outA) mod_store(v, MOD + b * ADA_W + modA, MOD + b * ADA_W + modA + D, outA + (size_t)m * D, F.lane);
        if (outB) mod_store(v, MOD + b * ADA_W + modB, MOD + b * ADA_W + modB + D, outB + (size_t)m * D, F.lane);
    }
}

constexpr int KS_STRIDE = 72;
constexpr int VT_STRIDE = 264;
__device__ __forceinline__ void p12_attn(Frame& F) {
    LAS bf16_t* Ks = (LAS bf16_t*)F.lds;
    LAS bf16_t* Vt = Ks + 256 * KS_STRIDE;
    const bf16_t* Q2 = WSP(bf16_t, WS_Q2); const bf16_t* K2 = WSP(bf16_t, WS_K2); const bf16_t* V2 = WSP(bf16_t, WS_V2);
    bf16_t* OG = WSP(bf16_t, WS_OG); float* LSE = WSP(float, WS_LSE);
    const int lane = F.lane, w = F.wave, q16 = lane & 15, qd = lane >> 4;
    for (int unit = F.vcu; unit < BATCH * 3 * 8 * 128; unit += F.G) {
        const int pb = unit & 127, hg = (unit >> 7) & 7, gb = unit >> 10, g = gb % 3, b = gb / 3;
        const int dil = g == 0 ? 1 : (g == 1 ? 4 : 16), nb = 128 / dil, phase = pb / nb, blk = pb % nb;
        const int hcol = (g * 8 + hg) * 64;
#pragma unroll
        for (int i = 0; i < 4; ++i) {
            const int ch = F.tid + 512 * i, key = ch >> 3, c8 = (ch & 7) * 8;
            const int pos = (blk - 1) * 128 + key;
            u32x4 kv = (u32x4){0u, 0u, 0u, 0u}, vv = (u32x4){0u, 0u, 0u, 0u};
            if (pos >= 0) { const size_t row = (size_t)b * SEQ + (size_t)pos * dil + phase;
                kv = *(const u32x4*)(K2 + row * QW + hcol + c8); vv = *(const u32x4*)(V2 + row * QW + hcol + c8); }
            *(LAS u32x4*)(Ks + key * KS_STRIDE + c8) = kv;
            Vt[(c8 + 0) * VT_STRIDE + key] = (bf16_t)(vv.x & 0xffff); Vt[(c8 + 1) * VT_STRIDE + key] = (bf16_t)(vv.x >> 16);
            Vt[(c8 + 2) * VT_STRIDE + key] = (bf16_t)(vv.y & 0xffff); Vt[(c8 + 3) * VT_STRIDE + key] = (bf16_t)(vv.y >> 16);
            Vt[(c8 + 4) * VT_STRIDE + key] = (bf16_t)(vv.z & 0xffff); Vt[(c8 + 5) * VT_STRIDE + key] = (bf16_t)(vv.z >> 16);
            Vt[(c8 + 6) * VT_STRIDE + key] = (bf16_t)(vv.w & 0xffff); Vt[(c8 + 7) * VT_STRIDE + key] = (bf16_t)(vv.w >> 16);
        }
        const int qi = 16 * w + q16;
        const size_t qrow = (size_t)b * SEQ + (size_t)(blk * 128 + qi) * dil + phase;
        const bf16x8 qf0 = *(const bf16x8*)(Q2 + qrow * QW + hcol + 8 * qd), qf1 = *(const bf16x8*)(Q2 + qrow * QW + hcol + 32 + 8 * qd);
        __syncthreads();
        const int kt0 = w < 6 ? w : 6;
        f32x4 s[10];
#pragma unroll
        for (int i = 0; i < 10; ++i) {
            const LAS bf16_t* kp = Ks + (16 * (kt0 + i) + q16) * KS_STRIDE + 8 * qd;
            const bf16x8 k0 = *(const LAS bf16x8*)kp, k1 = *(const LAS bf16x8*)(kp + 32);
            f32x4 a = (f32x4){0.f, 0.f, 0.f, 0.f};
            a = __builtin_amdgcn_mfma_f32_16x16x32_bf16(k0, qf0, a, 0, 0, 0);
            a = __builtin_amdgcn_mfma_f32_16x16x32_bf16(k1, qf1, a, 0, 0, 0);
            s[i] = a;
        }
        float mx = -1e30f;
#pragma unroll
        for (int i = 0; i < 10; ++i)
#pragma unroll
            for (int r = 0; r < 4; ++r) { const int kidx = 16 * (kt0 + i) + 4 * qd + r; const bool ok = (kidx >= qi) && (kidx <= qi + 128) && (blk > 0 || kidx >= 128);
                s[i][r] = ok ? s[i][r] : -1e30f; mx = fmaxf(mx, s[i][r]); }
        mx = fmaxf(mx, __shfl_xor(mx, 16)); mx = fmaxf(mx, __shfl_xor(mx, 32));
        float l = 0.f;
#pragma unroll
        for (int i = 0; i < 10; ++i)
#pragma unroll
            for (int r = 0; r < 4; ++r) { const float p = __expf(s[i][r] - mx); s[i][r] = p; l += p; }
        l += __shfl_xor(l, 16); l += __shfl_xor(l, 32);
        f32x4 o[4];
#pragma unroll
        for (int dt = 0; dt < 4; ++dt) o[dt] = (f32x4){0.f, 0.f, 0.f, 0.f};
#pragma unroll
        for (int i = 0; i < 5; ++i) {
            union { bf16x8 v; unsigned u[4]; } pf;
            pf.u[0] = cvt_pk_bf16(s[2 * i][0], s[2 * i][1]); pf.u[1] = cvt_pk_bf16(s[2 * i][2], s[2 * i][3]);
            pf.u[2] = cvt_pk_bf16(s[2 * i + 1][0], s[2 * i + 1][1]); pf.u[3] = cvt_pk_bf16(s[2 * i + 1][2], s[2 * i + 1][3]);
#pragma unroll
            for (int dt = 0; dt < 4; ++dt) {
                const LAS bf16_t* vp = Vt + (16 * dt + q16) * VT_STRIDE + 16 * (kt0 + 2 * i) + 4 * qd;
                union { bf16x8 v; s16x4 h[2]; } vf; vf.h[0] = *(const LAS s16x4*)vp; vf.h[1] = *(const LAS s16x4*)(vp + 16);
                o[dt] = __builtin_amdgcn_mfma_f32_16x16x32_bf16(vf.v, pf.v, o[dt], 0, 0, 0);
            }
        }
        const float il = 1.f / l;
        bf16_t* op = OG + (size_t)g * T * AOUT + qrow * AOUT + hg * 64 + 4 * qd;
#pragma unroll
        for (int dt = 0; dt < 4; ++dt) { u32x2 wv; wv.x = cvt_pk_bf16(o[dt][0] * il, o[dt][1] * il); wv.y = cvt_pk_bf16(o[dt][2] * il, o[dt][3] * il); *(u32x2*)(op + 16 * dt) = wv; }
        if (qd == 0) LSE[(size_t)g * T * 8 + qrow * 8 + hg] = mx + __logf(l);
        __syncthreads();
    }
}
__device__ __forceinline__ void p13_merge(Frame& F) {
    const bf16_t* OG = WSP(bf16_t, WS_OG); const float* LSE = WSP(float, WS_LSE); bf16_t* OM = WSP(bf16_t, WS_OM);
    for (int idx = F.vcu * 512 + F.tid; idx < T * 64; idx += F.G * 512) {
        const int m = idx >> 6, hg = (idx >> 3) & 7, c8 = (idx & 7) * 8;
        const float l0 = LSE[(size_t)0 * T * 8 + m * 8 + hg], l1 = LSE[(size_t)1 * T * 8 + m * 8 + hg], l2 = LSE[(size_t)2 * T * 8 + m * 8 + hg];
        const float mx = fmaxf(l0, fmaxf(l1, l2)); float w0 = __expf(l0 - mx), w1 = __expf(l1 - mx), w2 = __expf(l2 - mx); const float inv = 1.f / (w0 + w1 + w2); w0 *= inv; w1 *= inv; w2 *= inv;
        const size_t off = (size_t)m * AOUT + hg * 64 + c8;
        const u32x4 a = *(const u32x4*)(OG + off), bq = *(const u32x4*)(OG + (size_t)T * AOUT + off), c = *(const u32x4*)(OG + (size_t)2 * T * AOUT + off);
        u32x4 o;
        o.x = cvt_pk_bf16(w0 * bflo(a.x) + w1 * bflo(bq.x) + w2 * bflo(c.x), w0 * bfhi(a.x) + w1 * bfhi(bq.x) + w2 * bfhi(c.x));
        o.y = cvt_pk_bf16(w0 * bflo(a.y) + w1 * bflo(bq.y) + w2 * bflo(c.y), w0 * bfhi(a.y) + w1 * bfhi(bq.y) + w2 * bfhi(c.y));
        o.z = cvt_pk_bf16(w0 * bflo(a.z) + w1 * bflo(bq.z) + w2 * bflo(c.z), w0 * bfhi(a.z) + w1 * bfhi(bq.z) + w2 * bfhi(c.z));
        o.w = cvt_pk_bf16(w0 * bflo(a.w) + w1 * bflo(bq.w) + w2 * bflo(c.w), w0 * bfhi(a.w) + w1 * bfhi(bq.w) + w2 * bfhi(c.w));
        *(u32x4*)(OM + off) = o;
    }
}

__device__ __forceinline__ void p15_ln_route(Frame& F) {
    LAS float* RT = (LAS float*)F.lds;
    LAS int* lcnt = (LAS int*)(F.lds + 32768);
    LAS int* lbase = lcnt + 8;
    LAS int* lte = lcnt + 16;
    LAS int* ltr = lte + 256;
    LAS float* ltw = (LAS float*)(ltr + 256);
    const float* MOD = WSP(float, WS_MOD); const float* g = F.in[4] + 2 * D; const float* bb = F.in[5] + 2 * D;
    const float* X2 = WSP(float, WS_X2); const bf16_t* Y3 = WSP(bf16_t, WS_Y3); float* X3 = F.out; bf16_t* H4 = WSP(bf16_t, WS_H4);
    int* TOKE = (int*)(F.ws + WS_ROUTE + RT_TOKE); int* TOKR = (int*)(F.ws + WS_ROUTE + RT_TOKR); float* TOKW = (float*)(F.ws + WS_ROUTE + RT_TOKW);
    int* ROWTOK = (int*)(F.ws + WS_ROUTE + RT_ROWTOK);
    for (int i = F.tid; i < D * 8; i += 512) RT[i] = F.in[27][i];
    for (int i = F.vcu * 512 + F.tid; i < RMAX; i += F.G * 512) ROWTOK[i] = T;
    if (F.vcu == 0) for (int i = F.tid; i < D / 2; i += 512) ((unsigned*)(H4 + (size_t)T * D))[i] = 0u;
    __syncthreads();
    for (int chunk = F.vcu; chunk < T / 128; chunk += F.G) {
        if (F.tid < 8) lcnt[F.tid] = 0;
        __syncthreads();
        for (int i = 0; i < 16; ++i) {
            const int lr = F.wave * 16 + i, m = chunk * 128 + lr, b = m >> 14;
            const float* gate = MOD + b * ADA_W + (2 * 3 + 2) * D;
            f32x4 v[4];
#pragma unroll
            for (int j = 0; j < 4; ++j) { const int c = 4 * F.lane + 256 * j;
                const u32x2 yw = *(const u32x2*)(Y3 + (size_t)m * D + c); const f32x4 yv = (f32x4){bflo(yw.x), bfhi(yw.x), bflo(yw.y), bfhi(yw.y)};
                v[j] = DN_ALPHA * *(const f32x4*)(X2 + (size_t)m * D + c) + (1.f + *(const f32x4*)(gate + c)) * yv; }
            ln_apply(v, g, bb, F.lane);
#pragma unroll
            for (int j = 0; j < 4; ++j) *(f32x4*)(X3 + (size_t)m * D + 4 * F.lane + 256 * j) = v[j];
            const float* shift = MOD + b * ADA_W + (3 * 3 + 0) * D; const float* scale = MOD + b * ADA_W + (3 * 3 + 1) * D;
            float lg[8];
#pragma unroll
            for (int e = 0; e < 8; ++e) lg[e] = 0.f;
#pragma unroll
            for (int j = 0; j < 4; ++j) { const int c = 4 * F.lane + 256 * j; const f32x4 hh = v[j] * (1.f + *(const f32x4*)(scale + c)) + *(const f32x4*)(shift + c);
                u32x2 wv; wv.x = cvt_pk_bf16(hh[0], hh[1]); wv.y = cvt_pk_bf16(hh[2], hh[3]); *(u32x2*)(H4 + (size_t)m * D + c) = wv;
#pragma unroll
                for (int q = 0; q < 4; ++q) { const f32x4 r0 = *(const LAS f32x4*)(RT + (c + q) * 8), r1 = *(const LAS f32x4*)(RT + (c + q) * 8 + 4);
                    lg[0] += hh[q] * r0[0]; lg[1] += hh[q] * r0[1]; lg[2] += hh[q] * r0[2]; lg[3] += hh[q] * r0[3];
                    lg[4] += hh[q] * r1[0]; lg[5] += hh[q] * r1[1]; lg[6] += hh[q] * r1[2]; lg[7] += hh[q] * r1[3]; } }
#pragma unroll
            for (int e = 0; e < 8; ++e) lg[e] = wave_sum(lg[e]);
            int e1 = 0; float m1 = lg[0];
#pragma unroll
            for (int e = 1; e < 8; ++e) if (lg[e] > m1) { m1 = lg[e]; e1 = e; }
            int e2 = -1; float m2 = -3.0e38f;
#pragma unroll
            for (int e = 0; e < 8; ++e) if (e != e1 && lg[e] > m2) { m2 = lg[e]; e2 = e; }
            if (F.lane == 0) {
                const float w1 = 1.f / (1.f + __expf(m2 - m1));
                lte[lr * 2] = e1; lte[lr * 2 + 1] = e2; ltw[lr * 2] = w1; ltw[lr * 2 + 1] = 1.f - w1;
                ltr[lr * 2] = atomicAdd((int*)&lcnt[e1], 1); ltr[lr * 2 + 1] = atomicAdd((int*)&lcnt[e2], 1);
            }
        }
        __syncthreads();
        if (F.tid < 8) lbase[F.tid] = (int)__hip_atomic_fetch_add((unsigned*)(F.ctl + CW_CNT + F.tid), (unsigned)lcnt[F.tid], RLX_AGENT);
        __syncthreads();
        if (F.tid < 256) { const int m = chunk * 128 + (F.tid >> 1), s = F.tid & 1; const int e = lte[F.tid];
            TOKE[m * 2 + s] = e; TOKR[m * 2 + s] = lbase[e] + ltr[F.tid]; TOKW[m * 2 + s] = ltw[F.tid]; }
        __syncthreads();
    }
}
__device__ __forceinline__ void p16_place(Frame& F) {
    int* TOKE = (int*)(F.ws + WS_ROUTE + RT_TOKE); int* TOKR = (int*)(F.ws + WS_ROUTE + RT_TOKR);
    int* ROWTOK = (int*)(F.ws + WS_ROUTE + RT_ROWTOK); int* BLKEXP = (int*)(F.ws + WS_ROUTE + RT_BLKEXP);
    int pstart[8], pend[8]; int acc = 0;
#pragma unroll
    for (int e = 0; e < 8; ++e) { const int c = (int)__hip_atomic_load((unsigned*)(F.ctl + CW_CNT + e), RLX_AGENT); pstart[e] = acc; acc += (c + 255) / 256 * 256; pend[e] = acc; }
    for (int idx = F.vcu * 512 + F.tid; idx < T * 2; idx += F.G * 512) {
        const int e = TOKE[idx]; int ps = 0;
#pragma unroll
        for (int j = 0; j < 8; ++j) ps = (e == j) ? pstart[j] : ps;
        const int dest = ps + TOKR[idx]; ROWTOK[dest] = idx >> 1; TOKR[idx] = dest;
    }
    if (F.vcu == 0) {
        for (int blk = F.tid; blk < NBLKMAX; blk += 512) { int e = 0;
#pragma unroll
            for (int j = 0; j < 8; ++j) e += (pend[j] <= blk * 256) ? 1 : 0;
            BLKEXP[blk] = e < 8 ? e : 7; }
        if (F.tid == 0) __hip_atomic_store((unsigned*)(F.ctl + CW_NBLK), (unsigned)(acc / 256), RLX_AGENT);
    }
}
__device__ __forceinline__ void p19_final(Frame& F) {
    const int gw = F.vcu * NWAVES + F.wave, NGW = F.G * NWAVES;
    const float* MOD = WSP(float, WS_MOD); const float* g = F.in[4] + 3 * D; const float* bb = F.in[5] + 3 * D;
    const bf16_t* YB = WSP(bf16_t, WS_YB); const int* TOKR = (const int*)(F.ws + WS_ROUTE + RT_TOKR); const float* TOKW = (const float*)(F.ws + WS_ROUTE + RT_TOKW);
    float* X = F.out;
    for (int m = gw; m < T; m += NGW) {
        const int b = m >> 14; const float* gate = MOD + b * ADA_W + (3 * 3 + 2) * D;
        const int d0 = TOKR[m * 2], d1 = TOKR[m * 2 + 1]; const float w0 = TOKW[m * 2], w1 = TOKW[m * 2 + 1];
        f32x4 v[4];
#pragma unroll
        for (int j = 0; j < 4; ++j) { const int c = 4 * F.lane + 256 * j;
            const u32x2 a = *(const u32x2*)(YB + (size_t)d0 * D + c), q = *(const u32x2*)(YB + (size_t)d1 * D + c);
            const f32x4 y = (f32x4){w0 * bflo(a.x) + w1 * bflo(q.x), w0 * bfhi(a.x) + w1 * bfhi(q.x), w0 * bflo(a.y) + w1 * bflo(q.y), w0 * bfhi(a.y) + w1 * bfhi(q.y)};
            v[j] = DN_ALPHA * *(const f32x4*)(X + (size_t)m * D + c) + (1.f + *(const f32x4*)(gate + c)) * y; }
        ln_apply(v, g, bb, F.lane);
#pragma unroll
        for (int j = 0; j < 4; ++j) *(f32x4*)(X + (size_t)m * D + 4 * F.lane + 256 * j) = v[j];
    }
}

struct Args { const float* in[30]; float* out; unsigned char* ws; int ph_lo, ph_hi, li, pad; };
__global__ void __launch_bounds__(NWAVES * 64, 2) fwd(Args args) {
    extern __shared__ __attribute__((aligned(16))) unsigned char lds[];
    Frame F;
    F.lds = (LAS unsigned char*)lds;
    F.MISC = (volatile LAS unsigned*)(F.lds + MISC_OFF);
    F.tid = threadIdx.x; F.lane = F.tid & 63; F.wave = __builtin_amdgcn_readfirstlane(F.tid >> 6);
    F.G = gridDim.x; { const int bx = blockIdx.x; F.vcu = (F.G % 8 == 0) ? (bx % 8) * (F.G / 8) + bx / 8 : bx; }
    F.ws = args.ws; F.ctl = (gu32*)(args.ws + WS_CTL); F.out = args.out;
    F.in = args.in;
    for (int u = F.tid; u < (LDS_BYTES - LDSCTL_OFF) / 4; u += NWAVES * 64) ((LAS unsigned*)(F.lds + LDSCTL_OFF))[u] = 0u;
    __syncthreads();
    XcdBarrier bar; bar.bar = (unsigned*)(F.ctl + CW_BAR); bar.x = 0; bar.st = nullptr;
    if (N_LAUNCHES != NPH) bar = xcd_barrier_post((unsigned*)(F.ctl + CW_BAR) + args.li * XCD_BAR_WORDS, F.MISC + 8);
#define GRID_BAR() do { if (N_LAUNCHES != NPH) xcd_barrier(bar); } while (0)
    const int lo = args.ph_lo, hi = args.ph_hi;
#define IN(k) (lo <= (k) && (k) < hi)
#define BOTH(k) (IN(k) && IN((k) + 1))
    using namespace pg8;
    const int cid = (int)blockIdx.x;

    if (IN(0)) { p0_prologue(F); if (BOTH(0)) GRID_BAR(); }
    if (IN(1)) { p1_lerp(F); if (BOTH(1)) GRID_BAR(); }
    if (IN(2)) {
        Gemm g{WSP(bf16_t, WS_A6) + (size_t)3 * T * D, WSP(bf16_t, WS_WL1), D, D, (size_t)T * D * 2, (size_t)256 * D * 2, nullptr, nullptr, 0};
        StaticOrder S; S.init(T / 256, 1, 3, F.G, cid);
        EpiBf16Z<1, 0, 2> E{WSP(bf16_t, WS_L1), 256, (size_t)T * 256};
        gemm_phase<EpiBf16Z<1, 0, 2>, StaticOrder, true>(F.lds, g, S, E);
        if (BOTH(2)) GRID_BAR();
    }
    if (IN(3)) {
        { Gemm g{WSP(bf16_t, WS_A6), WSP(bf16_t, WS_WRKV), D, D, (size_t)T * D * 2, (size_t)D * D * 2, nullptr, nullptr, 0};
          StaticOrder S; S.init(T / 256, D / 256, 3, F.G, cid);
          EpiBf16Z<0, 0, 0> E{WSP(bf16_t, WS_RB), D, (size_t)T * D};
          gemm_phase<EpiBf16Z<0, 0, 0>, StaticOrder, true>(F.lds, g, S, E); }
        { Gemm g{WSP(bf16_t, WS_L1), WSP(bf16_t, WS_WL2), 256, 256, (size_t)T * 256 * 2, (size_t)D * 256 * 2, nullptr, nullptr, 0};
          StaticOrder S; S.init(T / 256, D / 256, 3, F.G, cid);
          EpiLora2 E{F.out, WSP(bf16_t, WS_AS), WSP(bf16_t, WS_G), F.in[8], F.in[11]};
          gemm_phase<EpiLora2, StaticOrder, true>(F.lds, g, S, E); }
        if (BOTH(3)) GRID_BAR();
    }
    if (IN(4)) { p4_scan_seg(F); if (BOTH(4)) GRID_BAR(); }
    if (IN(5)) { p5_fix_gnorm(F); if (BOTH(5)) GRID_BAR(); }
    if (IN(6)) {
        Gemm g{WSP(bf16_t, WS_YG), WSP(bf16_t, WS_WOUT), D, D, 0, 0, nullptr, nullptr, 0};
        StaticOrder S; S.init(T / 256, D / 256, 1, F.G, cid);
        EpiBf16Z<0, 0, 0> E{WSP(bf16_t, WS_Y1), D, 0};
        gemm_phase<EpiBf16Z<0, 0, 0>, StaticOrder, true>(F.lds, g, S, E);
        if (BOTH(6)) GRID_BAR();
    }
    if (IN(7)) { p_postnorm(F, F.in[0], WSP(bf16_t, WS_Y1), WSP(float, WS_X1), 0, (1 * 3 + 0) * D, WSP(bf16_t, WS_H2), 0, nullptr); if (BOTH(7)) GRID_BAR(); }
    if (IN(8)) {
        Gemm g{WSP(bf16_t, WS_H2), WSP(bf16_t, WS_WFGU), D, D, 0, 0, nullptr, nullptr, 0};
        StaticOrder S; S.init(T / 256, 2 * DFF / 256, 1, F.G, cid);
        EpiSwiglu E{WSP(bf16_t, WS_ACT), DFF};
        gemm_phase<EpiSwiglu, StaticOrder, true>(F.lds, g, S, E);
        if (BOTH(8)) GRID_BAR();
    }
    if (IN(9)) {
        Gemm g{WSP(bf16_t, WS_ACT), WSP(bf16_t, WS_WFDN), DFF, DFF, 0, 0, nullptr, nullptr, 0};
        StaticOrder S; S.init(T / 256, D / 256, 1, F.G, cid);
        EpiBf16Z<0, 0, 0> E{WSP(bf16_t, WS_Y2), D, 0};
        gemm_phase<EpiBf16Z<0, 0, 0>, StaticOrder, true>(F.lds, g, S, E);
        if (BOTH(9)) GRID_BAR();
    }
    if (IN(10)) { p_postnorm(F, WSP(float, WS_X1), WSP(bf16_t, WS_Y2), WSP(float, WS_X2), 1, 12 * D, WSP(bf16_t, WS_HKV), (2 * 3 + 0) * D, WSP(bf16_t, WS_H3)); if (BOTH(10)) GRID_BAR(); }
    if (IN(11)) {
        const float* cs = WSP(float, WS_ROPE); const float* sn = cs + SEQ * 32;
        { Gemm g{WSP(bf16_t, WS_HKV), WSP(bf16_t, WS_WKV), D, D, 0, 0, nullptr, nullptr, 0};
          StaticOrder S; S.init(T / 256, 2 * QW / 256, 1, F.G, cid);
          EpiRope E{WSP(bf16_t, WS_K2), WSP(bf16_t, WS_V2), QW, cs, sn, 1.f};
          gemm_phase<EpiRope, StaticOrder, true>(F.lds, g, S, E); }
        { Gemm g{WSP(bf16_t, WS_H3), WSP(bf16_t, WS_WQ), D, D, 0, 0, nullptr, nullptr, 0};
          StaticOrder S; S.init(T / 256, QW / 256, 1, F.G, cid);
          EpiRope E{WSP(bf16_t, WS_Q2), WSP(bf16_t, WS_Q2), QW, cs, sn, 0.125f};
          gemm_phase<EpiRope, StaticOrder, true>(F.lds, g, S, E); }
        if (BOTH(11)) GRID_BAR();
    }
    if (IN(12)) { p12_attn(F); if (BOTH(12)) GRID_BAR(); }
    if (IN(13)) { p13_merge(F); if (BOTH(13)) GRID_BAR(); }
    if (IN(14)) {
        Gemm g{WSP(bf16_t, WS_OM), WSP(bf16_t, WS_WO), AOUT, AOUT, 0, 0, nullptr, nullptr, 0};
        StaticOrder S; S.init(T / 256, D / 256, 1, F.G, cid);
        EpiBf16Z<0, 0, 0> E{WSP(bf16_t, WS_Y3), D, 0};
        gemm_phase<EpiBf16Z<0, 0, 0>, StaticOrder, true>(F.lds, g, S, E);
        if (BOTH(14)) GRID_BAR();
    }
    if (IN(15)) { p15_ln_route(F); if (BOTH(15)) GRID_BAR(); }
    if (IN(16)) { p16_place(F); if (BOTH(16)) GRID_BAR(); }
    if (IN(17)) {
        const int nblk = (int)__hip_atomic_load((unsigned*)(F.ctl + CW_NBLK), RLX_AGENT);
        Gemm g{WSP(bf16_t, WS_H4), WSP(bf16_t, WS_WMGU), D, D, 0, 0, (const int*)(F.ws + WS_ROUTE + RT_ROWTOK), (const int*)(F.ws + WS_ROUTE + RT_BLKEXP), (size_t)2 * DFE * D * 2};
        StaticOrder S; S.init(nblk, 2 * DFE / 256, 1, F.G, cid);
        EpiSwiglu E{WSP(bf16_t, WS_ACT2), DFE};
        gemm_phase<EpiSwiglu, StaticOrder, true>(F.lds, g, S, E);
        if (BOTH(17)) GRID_BAR();
    }
    if (IN(18)) {
        const int nblk = (int)__hip_atomic_load((unsigned*)(F.ctl + CW_NBLK), RLX_AGENT);
        Gemm g{WSP(bf16_t, WS_ACT2), WSP(bf16_t, WS_WMDN), DFE, DFE, 0, 0, nullptr, (const int*)(F.ws + WS_ROUTE + RT_BLKEXP), (size_t)D * DFE * 2};
        StaticOrder S; S.init(nblk, D / 256, 1, F.G, cid);
        EpiBf16Z<0, 0, 0> E{WSP(bf16_t, WS_YB), D, 0};
        gemm_phase<EpiBf16Z<0, 0, 0>, StaticOrder, true>(F.lds, g, S, E);
        if (BOTH(18)) GRID_BAR();
    }
    if (IN(19)) { p19_final(F); }
#undef IN
#undef BOTH
}

extern "C" void kernel_launch(void* const* d_in, const int* in_sizes, int n_in, void* d_out, int out_size, void* d_ws, size_t ws_size, hipStream_t stream) {
    static int grid = 0;
    if (grid == 0) {
        if (n_in != 30 || in_sizes[0] != T * D || out_size != T * D || ws_size < WS_END) { fprintf(stderr, "kernel_launch: unexpected shapes / workspace (%d inputs, ws %zu)\n", n_in, ws_size); grid = -1; return; }
        int dev = 0, cus = 0, per_cu = 0;
        if (hipGetDevice(&dev) != hipSuccess || hipDeviceGetAttribute(&cus, hipDeviceAttributeMultiprocessorCount, dev) != hipSuccess) { grid = -1; return; }
        if (hipFuncSetAttribute((const void*)fwd, hipFuncAttributeMaxDynamicSharedMemorySize, LDS_BYTES) != hipSuccess) { fprintf(stderr, "kernel_launch: hipFuncSetAttribute failed\n"); grid = -1; return; }
        if (hipOccupancyMaxActiveBlocksPerMultiprocessor(&per_cu, (const void*)fwd, NWAVES * 64, LDS_BYTES) != hipSuccess || per_cu < 1)
            fprintf(stderr, "kernel_launch: occupancy query reports %d workgroups per CU\n", per_cu);
        (void)hipGetLastError();
        grid = cus;
    }
    if (grid < 0) return;
    if (hipMemsetAsync((char*)d_ws + WS_CTL, 0, CTL_ZERO_BYTES, stream) != hipSuccess) return;
    Args a{};
    for (int i = 0; i < 30; ++i) a.in[i] = (const float*)d_in[i];
    a.out = (float*)d_out; a.ws = (unsigned char*)d_ws;
    for (int li = 0; li < N_LAUNCHES; ++li) {
        a.ph_lo = (N_LAUNCHES == NPH) ? li : 0; a.ph_hi = (N_LAUNCHES == NPH) ? li + 1 : NPH; a.li = (N_LAUNCHES == NPH) ? 0 : li;
        hipLaunchKernelGGL(fwd, dim3(grid), dim3(NWAVES * 64), LDS_BYTES, stream, a);
        if (hipPeekAtLastError() != hipSuccess) { fprintf(stderr, "kernel_launch: launch %d failed\n", li); break; }
    }
}
```

```cpp
#include <hip/hip_runtime.h>
#include <cstdio>
#include <cstdint>

#define LAS __attribute__((address_space(3)))
#define GAS __attribute__((address_space(1)))
typedef unsigned short bf16_t;
typedef short bf16x8 __attribute__((ext_vector_type(8)));
typedef short s16x4 __attribute__((ext_vector_type(4)));
typedef float f32x4 __attribute__((ext_vector_type(4)));
typedef float f32x2 __attribute__((ext_vector_type(2)));
typedef unsigned u32x4 __attribute__((ext_vector_type(4)));
typedef unsigned u32x2 __attribute__((ext_vector_type(2)));
typedef GAS unsigned gu32;
#define RLX_AGENT __ATOMIC_RELAXED, __HIP_MEMORY_SCOPE_AGENT

typedef __bf16 bf16x2_t __attribute__((ext_vector_type(2)));
__device__ __forceinline__ unsigned cvt_pk_bf16(float lo, float hi) { const f32x2 v = {lo, hi}; const bf16x2_t b = __builtin_convertvector(v, bf16x2_t); return __builtin_bit_cast(unsigned, b); }
__device__ __forceinline__ float bflo(unsigned w) { return __uint_as_float(w << 16); }
__device__ __forceinline__ float bfhi(unsigned w) { return __uint_as_float(w & 0xffff0000u); }
__device__ __forceinline__ float sigmoidf_(float x) { return 1.f / (1.f + __expf(-x)); }
__device__ __forceinline__ float tanhf_(float x) { return 1.f - 2.f / (1.f + __expf(2.f * x)); }
__device__ __forceinline__ float siluf_(float x) { return x / (1.f + __expf(-x)); }
__device__ __forceinline__ int ld_i32(const int* p) { return (int)__hip_atomic_load((const unsigned*)p, RLX_AGENT); }

constexpr int BATCH = 2, SEQ = 16384, D = 1024, T = BATCH * SEQ;
constexpr int ADA_W = 14336;
constexpr int DFF = 2816, NEXP = 8, DFE = 3584;
constexpr int QW = 1536, AOUT = 512;
constexpr int RMAX = (T * 2 / 256 + NEXP) * 256;
constexpr int NBLKMAX = RMAX / 256;
constexpr float LN_EPS = 1e-5f, LNX_EPS = 64e-5f;
constexpr float DN_ALPHA = 1.4142135623730951f;

namespace pg8 {
constexpr int BM = 256, BK = 64, HALF = 128, HTB = HALF * BK * 2, STAGE_BYTES = 8 * HTB, NXCD = 8, WGM = 8;
__host__ __device__ __forceinline__ int lds_byte(int r, int c) { const int st = (r >> 4) * 2 + (c >> 5), rr = r & 15, cc = c & 31, ob = rr * 64 + cc * 2; return st * 1024 + (ob ^ (((ob >> 9) & 1) << 5)); }
__host__ __device__ __forceinline__ void stage_rc(int b, int& R, int& C) { const int st = b / 1024, sb = b % 1024, swz = sb ^ (((sb >> 9) & 1) << 5); R = (st >> 1) * 16 + swz / 64; C = (st & 1) * 32 + (swz % 64) / 2; }
__host__ __device__ __forceinline__ int perm32(int rho) { const int n = rho >> 4, i = rho & 15; return 8 * (i >> 2) + 4 * n + (i & 3); }

struct Unit { int pm, pn, z; };
struct Gemm { const bf16_t* A; const bf16_t* Bt; int K, lda; size_t azs, bzs; const int* rowmap; const int* blk_exp; size_t bes; };

struct StaticOrder {
    int nM, nN, nZ, nwg, G, c;
    __device__ void init(int nM_, int nN_, int nZ_, int G_, int c_) { nM = nM_; nN = nN_; nZ = nZ_; nwg = nM * nN; G = G_; c = c_; }
    __device__ bool next(int i, Unit& u) const {
        const long L = (long)i * G + c; if (L >= (long)nwg * nZ) return false;
        u.z = (int)(L / nwg); int wgid = (int)(L % nwg);
        { const int q = nwg / NXCD, r = nwg % NXCD, xcd = wgid % NXCD, off = wgid / NXCD; wgid = (xcd < r ? xcd * (q + 1) : r * (q + 1) + (xcd - r) * q) + off; }
        const int nig = WGM * nN, gid = wgid / nig, fm = gid * WGM, gsz = (nM - fm) < WGM ? (nM - fm) : WGM;
        u.pm = fm + ((wgid % nig) % gsz); u.pn = (wgid % nig) / gsz; return true;
    }
};

#define EPI_LOOP_BEGIN \
    const int row0 = u.pm * BM + wr * 64 + fr, col0 = u.pn * BM + wc * 32 + 8 * fq; \
    _Pragma("unroll") for (int ai = 0; ai < 2; ++ai) _Pragma("unroll") for (int m = 0; m < 4; ++m) { const int row = row0 + ai * HALF + m * 16; \
    _Pragma("unroll") for (int bj = 0; bj < 2; ++bj) { const int col = col0 + bj * HALF; f32x4 v0 = acc[ai][bj][m][0], v1 = acc[ai][bj][m][1];
#define EPI_LOOP_END } }

__device__ __forceinline__ float act_apply(int a, float x) { return a == 1 ? tanhf_(x) : (a == 2 ? sigmoidf_(x) : x); }
template <int ACT0, int ACT1, int ACT2> struct EpiBf16Z {
    static constexpr bool PERM = true;
    bf16_t* O; int ldc; size_t ozs;
    __device__ __forceinline__ void operator()(const f32x4 (&acc)[2][2][4][2], const Unit& u, int wr, int wc, int fr, int fq) const {
        const int a = u.z == 0 ? ACT0 : (u.z == 1 ? ACT1 : ACT2); bf16_t* base = O + (size_t)u.z * ozs;
        EPI_LOOP_BEGIN
            if (a) { _Pragma("unroll") for (int e = 0; e < 4; ++e) { v0[e] = act_apply(a, v0[e]); v1[e] = act_apply(a, v1[e]); } }
            u32x4 w; w.x = cvt_pk_bf16(v0[0], v0[1]); w.y = cvt_pk_bf16(v0[2], v0[3]); w.z = cvt_pk_bf16(v1[0], v1[1]); w.w = cvt_pk_bf16(v1[2], v1[3]);
            *(u32x4*)(base + (size_t)row * ldc + col) = w;
        EPI_LOOP_END
    }
};
struct EpiLora2 {
    static constexpr bool PERM = true;
    float* WLOG; bf16_t* AS; bf16_t* G; const float* w0; const float* a0;
    __device__ __forceinline__ void operator()(const f32x4 (&acc)[2][2][4][2], const Unit& u, int wr, int wc, int fr, int fq) const {
        EPI_LOOP_BEGIN
            if (u.z == 0) {
                const f32x4 b0 = *(const f32x4*)(w0 + col), b1 = *(const f32x4*)(w0 + col + 4);
                _Pragma("unroll") for (int e = 0; e < 4; ++e) {
                    float x = -(v0[e] + b0[e]); float sp = fmaxf(x, 0.f) + __logf(1.f + __expf(-fabsf(x))); v0[e] = -__expf(-sp - 0.5f);
                    x = -(v1[e] + b1[e]); sp = fmaxf(x, 0.f) + __logf(1.f + __expf(-fabsf(x))); v1[e] = -__expf(-sp - 0.5f); }
                float* p = WLOG + (size_t)row * D + col; *(f32x4*)p = v0; *(f32x4*)(p + 4) = v1;
            } else {
                if (u.z == 1) { const f32x4 b0 = *(const f32x4*)(a0 + col), b1 = *(const f32x4*)(a0 + col + 4);
                    _Pragma("unroll") for (int e = 0; e < 4; ++e) { v0[e] = sigmoidf_(v0[e] + b0[e]); v1[e] = sigmoidf_(v1[e] + b1[e]); } }
                u32x4 w; w.x = cvt_pk_bf16(v0[0], v0[1]); w.y = cvt_pk_bf16(v0[2], v0[3]); w.z = cvt_pk_bf16(v1[0], v1[1]); w.w = cvt_pk_bf16(v1[2], v1[3]);
                *(u32x4*)((u.z == 1 ? AS : G) + (size_t)row * D + col) = w;
            }
        EPI_LOOP_END
    }
};
struct EpiF32 {
    static constexpr bool PERM = true;
    float* O; int ldc;
    __device__ __forceinline__ void operator()(const f32x4 (&acc)[2][2][4][2], const Unit& u, int wr, int wc, int fr, int fq) const {
        EPI_LOOP_BEGIN
            float* p = O + (size_t)row * ldc + col; *(f32x4*)p = v0; *(f32x4*)(p + 4) = v1;
        EPI_LOOP_END
    }
};
struct EpiSwiglu {
    static constexpr bool PERM = true;
    bf16_t* O; int ldo;
    __device__ __forceinline__ void operator()(const f32x4 (&acc)[2][2][4][2], const Unit& u, int wr, int wc, int fr, int fq) const {
        EPI_LOOP_BEGIN
            u32x2 w; w.x = cvt_pk_bf16(siluf_(v0[0]) * v0[1], siluf_(v0[2]) * v0[3]); w.y = cvt_pk_bf16(siluf_(v1[0]) * v1[1], siluf_(v1[2]) * v1[3]);
            *(u32x2*)(O + (size_t)row * ldo + (col >> 1)) = w;
        EPI_LOOP_END
    }
};
struct EpiRope {
    static constexpr bool PERM = true;
    bf16_t* O; bf16_t* O2; int ncol_rope; const float* cs; const float* sn; float scale;
    __device__ __forceinline__ void operator()(const f32x4 (&acc)[2][2][4][2], const Unit& u, int wr, int wc, int fr, int fq) const {
        EPI_LOOP_BEGIN
            bf16_t* dst;
            if (col < ncol_rope) {
                const int t = row & (SEQ - 1), i0 = (col & 63) >> 1;
                const f32x4 c4 = *(const f32x4*)(cs + (size_t)t * 32 + i0), s4 = *(const f32x4*)(sn + (size_t)t * 32 + i0);
                float a, b;
                a = v0[0]; b = v0[1]; v0[0] = (a * c4[0] - b * s4[0]) * scale; v0[1] = (b * c4[0] + a * s4[0]) * scale;
                a = v0[2]; b = v0[3]; v0[2] = (a * c4[1] - b * s4[1]) * scale; v0[3] = (b * c4[1] + a * s4[1]) * scale;
                a = v1[0]; b = v1[1]; v1[0] = (a * c4[2] - b * s4[2]) * scale; v1[1] = (b * c4[2] + a * s4[2]) * scale;
                a = v1[2]; b = v1[3]; v1[2] = (a * c4[3] - b * s4[3]) * scale; v1[3] = (b * c4[3] + a * s4[3]) * scale;
                dst = O + (size_t)row * ncol_rope + col;
            } else dst = O2 + (size_t)row * ncol_rope + (col - ncol_rope);
            u32x4 w; w.x = cvt_pk_bf16(v0[0], v0[1]); w.y = cvt_pk_bf16(v0[2], v0[3]); w.z = cvt_pk_bf16(v1[0], v1[1]); w.w = cvt_pk_bf16(v1[2], v1[3]);
            *(u32x4*)dst = w;
        EPI_LOOP_END
    }
};

template <class Epi, class Sched, bool ALIGN_EPI>
__device__ __forceinline__ void gemm_phase(LAS unsigned char* lds, const Gemm g, const Sched& S, const Epi& E) {
    const int tid = threadIdx.x, wid = __builtin_amdgcn_readfirstlane(tid >> 6), lane = tid & 63, wr = wid >> 2, wc = wid & 3, fr = lane & 15, fq = lane >> 4;
    const int K = g.K, nt = K / BK;
    int RA[2], CA[2]; unsigned voffB[2];
#pragma unroll
    for (int i = 0; i < 2; ++i) { int R, C; stage_rc(tid * 16 + i * 8192, R, C); const int Rb = Epi::PERM ? ((R & ~31) + perm32(R & 31)) : R;
        RA[i] = R; CA[i] = C; voffB[i] = (unsigned)(Rb * K + C) * 2u; }
    const size_t kstep = (size_t)(BK * 2);
    const size_t hstepB = (size_t)HALF * K * 2, tstepB = 2 * hstepB;
    const unsigned ldsw = (unsigned)wid * 1024u;
    const int aoff = lds_byte(wr * 64 + fr, fq * 8), boff = lds_byte(wc * 32 + fr, fq * 8);
#define PG8_SA(b, h) (((b) * 2 + (h)) * HTB)
#define PG8_SB(b, h) ((4 + (b) * 2 + (h)) * HTB)
#define PG8_STAGE(bufoff, gbase, voff) do { _Pragma("unroll") for (int _i = 0; _i < 2; ++_i) \
        __builtin_amdgcn_global_load_lds((const unsigned*)((const char*)(gbase) + (voff)[_i]), (LAS unsigned*)(lds + (bufoff) + ldsw + _i * 8192), 16, 0, 0); } while (0)
#define PG8_VOFFA(v, uu) do { _Pragma("unroll") for (int _h = 0; _h < 2; ++_h) _Pragma("unroll") for (int _i = 0; _i < 2; ++_i) { int _row = (uu).pm * BM + _h * HALF + RA[_i]; \
        if (g.rowmap) _row = g.rowmap[_row]; (v)[_h][_i] = (unsigned)((size_t)(uu).z * g.azs) + (unsigned)(_row * g.lda + CA[_i]) * 2u; } } while (0)
#define PG8_BBASE(uu) ((const char*)g.Bt + (size_t)(uu).z * g.bzs + (g.blk_exp ? (size_t)ld_i32(g.blk_exp + (uu).pm) * g.bes : (size_t)0) + (size_t)(uu).pn * tstepB)
#define PG8_LDA(dst, b, h) do { _Pragma("unroll") for (int m = 0; m < 4; ++m) _Pragma("unroll") for (int k = 0; k < 2; ++k) dst[m][k] = *(const LAS bf16x8*)(lds + PG8_SA(b, h) + aoff + m * 2048 + k * 1024); } while (0)
#define PG8_LDB(dst, b, h) do { _Pragma("unroll") for (int n = 0; n < 2; ++n) _Pragma("unroll") for (int k = 0; k < 2; ++k) dst[n][k] = *(const LAS bf16x8*)(lds + PG8_SB(b, h) + boff + n * 2048 + k * 1024); } while (0)
#define PG8_MMA(ai, bj, At, Bt) do { __builtin_amdgcn_s_setprio(1); _Pragma("unroll") for (int m = 0; m < 4; ++m) _Pragma("unroll") for (int n = 0; n < 2; ++n) _Pragma("unroll") for (int k = 0; k < 2; ++k) \
        acc[ai][bj][m][n] = __builtin_amdgcn_mfma_f32_16x16x32_bf16(Bt[n][k], At[m][k], acc[ai][bj][m][n], 0, 0, 0); __builtin_amdgcn_s_setprio(0); } while (0)
#define PG8_WAIT_V(n) asm volatile("s_waitcnt vmcnt(" #n ")" ::: "memory")
#define PG8_WAIT_L(n) asm volatile("s_waitcnt lgkmcnt(" #n ")" ::: "memory")
#define PG8_BAR __builtin_amdgcn_s_barrier()
#define PG8_SCHED __builtin_amdgcn_sched_barrier(0)
    Unit cur, nxt; int ui = 0;
    if (!S.next(0, cur)) return;
    f32x4 acc[2][2][4][2];
#pragma unroll
    for (int a = 0; a < 2; ++a)
#pragma unroll
        for (int b = 0; b < 2; ++b)
#pragma unroll
            for (int m = 0; m < 4; ++m)
#pragma unroll
                for (int n = 0; n < 2; ++n) acc[a][b][m][n] = (f32x4){0.f, 0.f, 0.f, 0.f};
    bf16x8 At[4][2], B0[2][2], B1[2][2];
    unsigned vc[2][2], vn[2][2];
    const char* const Ab = (const char*)g.A;
    const char* cB = PG8_BBASE(cur);
    PG8_VOFFA(vc, cur);
    PG8_STAGE(PG8_SB(0, 0), cB, voffB); PG8_STAGE(PG8_SB(0, 1), cB + hstepB, voffB); PG8_STAGE(PG8_SA(0, 0), Ab, vc[0]); PG8_STAGE(PG8_SA(0, 1), Ab, vc[1]);
    if (wr == 1) PG8_BAR;
    PG8_WAIT_V(2); PG8_BAR;
    PG8_STAGE(PG8_SB(1, 0), cB + kstep, voffB); PG8_STAGE(PG8_SA(1, 0), Ab + kstep, vc[0]); PG8_STAGE(PG8_SB(1, 1), cB + hstepB + kstep, voffB);
    PG8_WAIT_V(6); PG8_BAR;
    for (;;) {
        const bool has_next = S.next(ui + 1, nxt);
        const char* nB = cB;
        if (has_next) { nB = PG8_BBASE(nxt); PG8_VOFFA(vn, nxt); }
        else {
#pragma unroll
            for (int h = 0; h < 2; ++h)
#pragma unroll
                for (int i = 0; i < 2; ++i) vn[h][i] = vc[h][i];
        }
        for (int t = 0; t < nt; t += 2) {
            const bool last = (t == nt - 2);
            const char* a1 = Ab + (size_t)(t + 1) * kstep;
            const char* a2 = last ? Ab : Ab + (size_t)(t + 2) * kstep; const char* b2 = last ? nB : cB + (size_t)(t + 2) * kstep;
            const char* a3 = a2 + kstep; const char* b3 = b2 + kstep;
            unsigned v2[2][2];
#pragma unroll
            for (int h = 0; h < 2; ++h)
#pragma unroll
                for (int i = 0; i < 2; ++i) v2[h][i] = last ? vn[h][i] : vc[h][i];
            PG8_LDB(B0, 0, 0); PG8_LDB(B1, 0, 1); PG8_SCHED; PG8_LDA(At, 0, 0); PG8_STAGE(PG8_SA(1, 1), a1, vc[1]);
            PG8_WAIT_V(8); PG8_WAIT_L(0); PG8_BAR; PG8_MMA(0, 0, At, B0); PG8_MMA(0, 1, At, B1); PG8_BAR; PG8_SCHED;
            PG8_LDA(At, 0, 1); PG8_STAGE(PG8_SB(0, 0), b2, voffB); PG8_STAGE(PG8_SB(0, 1), b2 + hstepB, voffB); PG8_STAGE(PG8_SA(0, 0), a2, v2[0]);
            PG8_WAIT_V(8); PG8_WAIT_L(0); PG8_BAR; PG8_MMA(1, 0, At, B0); PG8_MMA(1, 1, At, B1); PG8_BAR; PG8_SCHED;
            PG8_LDB(B0, 1, 0); PG8_LDB(B1, 1, 1); PG8_SCHED; PG8_LDA(At, 1, 0); PG8_STAGE(PG8_SA(0, 1), a2, v2[1]);
            PG8_WAIT_V(8); PG8_WAIT_L(0); PG8_BAR; PG8_MMA(0, 0, At, B0); PG8_MMA(0, 1, At, B1); PG8_BAR; PG8_SCHED;
            PG8_LDA(At, 1, 1); PG8_STAGE(PG8_SB(1, 0), b3, voffB); PG8_STAGE(PG8_SB(1, 1), b3 + hstepB, voffB); PG8_STAGE(PG8_SA(1, 0), a3, v2[0]);
            PG8_WAIT_V(8); PG8_WAIT_L(0); PG8_BAR; PG8_MMA(1, 0, At, B0); PG8_MMA(1, 1, At, B1); PG8_BAR; PG8_SCHED;
        }
        if constexpr (ALIGN_EPI) { if (wr == 0) PG8_BAR; }
        E(acc, cur, wr, wc, fr, fq);
        if (!has_next) break;
#pragma unroll
        for (int a = 0; a < 2; ++a)
#pragma unroll
            for (int b = 0; b < 2; ++b)
#pragma unroll
                for (int m = 0; m < 4; ++m)
#pragma unroll
                    for (int n = 0; n < 2; ++n) acc[a][b][m][n] = (f32x4){0.f, 0.f, 0.f, 0.f};
        cur = nxt; cB = nB; ++ui;
#pragma unroll
        for (int h = 0; h < 2; ++h)
#pragma unroll
            for (int i = 0; i < 2; ++i) vc[h][i] = vn[h][i];
        if constexpr (ALIGN_EPI) { if (wr == 1) PG8_BAR; }
    }
    PG8_WAIT_V(0);
    if constexpr (!ALIGN_EPI) { if (wr == 0) PG8_BAR; }
    PG8_BAR;
#undef PG8_SA
#undef PG8_SB
#undef PG8_STAGE
#undef PG8_VOFFA
#undef PG8_BBASE
#undef PG8_LDA
#undef PG8_LDB
#undef PG8_MMA
#undef PG8_WAIT_V
#undef PG8_WAIT_L
#undef PG8_BAR
#undef PG8_SCHED
}
}

constexpr int NWAVES = 8;
constexpr int NPH = 20;
#ifndef MK_N_LAUNCHES
#define MK_N_LAUNCHES 1
#endif
constexpr int N_LAUNCHES = MK_N_LAUNCHES;

constexpr size_t MiB = 1u << 20;
constexpr size_t WS_CTL = 0, CTL_ZERO_BYTES = 1 * MiB;
constexpr size_t WS_MOD = 1 * MiB;
constexpr size_t WS_ROPE = 2 * MiB;
constexpr size_t WS_WRKV = 6 * MiB;
constexpr size_t WS_WL1 = 12 * MiB;
constexpr size_t WS_WL2 = 14 * MiB;
constexpr size_t WS_WOUT = 16 * MiB;
constexpr size_t WS_WFGU = 18 * MiB;
constexpr size_t WS_WFDN = 29 * MiB;
constexpr size_t WS_WKV = 35 * MiB;
constexpr size_t WS_WQ = 41 * MiB;
constexpr size_t WS_WO = 44 * MiB;
constexpr size_t WS_WMGU = 46 * MiB;
constexpr size_t WS_WMDN = 158 * MiB;
constexpr size_t WS_AR = 216 * MiB;
constexpr size_t AR(size_t mib) { return WS_AR + mib * MiB; }
constexpr size_t WS_A6 = AR(0);
constexpr size_t WS_L1 = AR(384);
constexpr size_t WS_RB = AR(432), WS_KB = AR(496), WS_VB = AR(560);
constexpr size_t WS_AS = AR(192), WS_G = AR(256);
constexpr size_t WS_YS = AR(0);
constexpr size_t WS_YG = AR(128);
constexpr size_t WS_RF = AR(0), WS_YF = AR(64), WS_QF = AR(128), WS_PF = AR(320);
constexpr size_t WS_SF = AR(192);
constexpr size_t WS_WCF = AR(384);
constexpr size_t WS_BON = AR(386);
constexpr size_t WS_Y1 = AR(320);
constexpr size_t WS_X1 = AR(448);
constexpr size_t WS_H2 = AR(576);
constexpr size_t WS_ACT = AR(0);
constexpr size_t WS_Y2 = AR(176);
constexpr size_t WS_X2 = AR(304);
constexpr size_t WS_HKV = AR(0), WS_H3 = AR(64);
constexpr size_t WS_K2 = AR(128), WS_V2 = AR(432), WS_Q2 = AR(528);
constexpr size_t WS_OG = AR(0);
constexpr size_t WS_LSE = AR(96);
constexpr size_t WS_OM = AR(224);
constexpr size_t WS_Y3 = AR(432);
constexpr size_t WS_H4 = AR(0);
constexpr size_t WS_ROUTE = AR(66);
constexpr size_t WS_ACT2 = AR(70);
constexpr size_t WS_YB = AR(532);
constexpr size_t WS_END = AR(664);
static_assert(WS_END <= 896 * MiB, "workspace");
static_assert((size_t)RMAX * DFE * 2 <= 462 * MiB && (size_t)RMAX * D * 2 <= 132 * MiB, "moe buffers");
constexpr size_t RT_TOKE = 0;
constexpr size_t RT_TOKR = 256 * 1024;
constexpr size_t RT_TOKW = 512 * 1024;
constexpr size_t RT_ROWTOK = 768 * 1024;
constexpr size_t RT_BLKEXP = 1280 * 1024;
constexpr int CW_BAR = 4096;
constexpr int CW_CNT = 16384;
constexpr int CW_NBLK = 16448;

constexpr int RING_BYTES = 131072;
constexpr int LDSCTL_OFF = RING_BYTES, MISC_OFF = LDSCTL_OFF + 320;
constexpr int LDS_BYTES = 147456;

#define LDS_WAIT() asm volatile("s_waitcnt lgkmcnt(0)" ::: "memory")
#define VM_WAIT() asm volatile("s_waitcnt vmcnt(0)" ::: "memory")

#define XB_TMO      128
#define XB_XCNT(j)  (256  + 64 * (j))
#define XB_XSUB(j)  (1280 + 64 * (j))
#define XB_XGEN(j)  (2304 + 64 * (j))
#define XB_TOP      3328
#define XB_TOPGEN   3392
#define XCD_BAR_WORDS 3456
#define XB_SPIN_CAP (1u << 22)

__device__ __forceinline__ unsigned xb_ld(unsigned* p)              { return __hip_atomic_load(p, __ATOMIC_RELAXED, __HIP_MEMORY_SCOPE_AGENT); }
__device__ __forceinline__ unsigned xb_add(unsigned* p, unsigned v) { return __hip_atomic_fetch_add(p, v, __ATOMIC_RELAXED, __HIP_MEMORY_SCOPE_AGENT); }
__device__ __forceinline__ unsigned xb_xcc_id() { return (unsigned)__builtin_amdgcn_s_getreg((3 << 11) | 20) & 0xFu; }
#define XB_SPIN(cond, bar) do { unsigned _sp = 0; while (cond) { __builtin_amdgcn_s_sleep(1); \
    if ((++_sp & 255u) == 0u) { if (xb_ld(&(bar)[XB_TMO])) break; if (_sp > XB_SPIN_CAP) { atomicAdd(&(bar)[XB_TMO], 1u); break; } } } } while (0)

struct XcdBarrier { unsigned* bar; unsigned x; volatile LAS unsigned* st; };
__device__ __forceinline__ XcdBarrier xcd_barrier_post(unsigned* bar, volatile LAS unsigned* st) {
    XcdBarrier b; b.bar = bar; b.x = xb_xcc_id(); b.st = st;
    if (threadIdx.x == 0) (void)xb_add(&bar[XB_XCNT(b.x)], 1u);
    return b;
}
__device__ __forceinline__ void xcd_barrier_complete(unsigned* bar, unsigned x, unsigned& nloc, unsigned& nx) {
    const unsigned G = gridDim.x * gridDim.y * gridDim.z;
    unsigned sum, cnt, mine, sp = 0u;
    for (;;) {
        sum = 0u; cnt = 0u; mine = 0u;
#pragma unroll
        for (unsigned j = 0; j < 16; ++j) { const unsigned c = xb_ld(&bar[XB_XCNT(j)]); sum += c; cnt += (c > 0u) ? 1u : 0u; mine = (j == x) ? c : mine; }
        if (sum == G) break;
        __builtin_amdgcn_s_sleep(1);
        if ((++sp & 255u) == 0u) { if (xb_ld(&bar[XB_TMO])) break; if (sp > XB_SPIN_CAP) { atomicAdd(&bar[XB_TMO], 1u); break; } }
    }
    nloc = mine > 0u ? mine : 1u; nx = cnt > 0u ? cnt : 1u;
}
__device__ __forceinline__ void xcd_barrier(const XcdBarrier& b) {
    asm volatile("s_waitcnt vmcnt(0)" ::: "memory");
    __syncthreads();
    if (threadIdx.x == 0) {
        unsigned* bar = b.bar;
        __builtin_amdgcn_s_waitcnt(0);
        unsigned nloc = b.st[0], nx = b.st[1];
        if (nloc == 0u) { xcd_barrier_complete(bar, b.x, nloc, nx); b.st[0] = nloc; b.st[1] = nx; }
        const unsigned old = xb_add(&bar[XB_XSUB(b.x)], 1u);
        const unsigned gen = old / nloc;
        if (old + 1u == (gen + 1u) * nloc) {
            __builtin_amdgcn_fence(__ATOMIC_RELEASE, "agent");
            asm volatile("s_waitcnt vmcnt(0)" ::: "memory");
            const unsigned og = xb_add(&bar[XB_TOP], 1u);
            const unsigned tg = og / nx;
            if (og + 1u == (tg + 1u) * nx) xb_add(&bar[XB_TOPGEN], 1u);
            else XB_SPIN(xb_ld(&bar[XB_TOPGEN]) == tg, bar);
            __builtin_amdgcn_fence(__ATOMIC_ACQUIRE, "agent");
            xb_add(&bar[XB_XGEN(b.x)], 1u);
            asm volatile("s_waitcnt vmcnt(0)" ::: "memory");
        } else {
            XB_SPIN(xb_ld(&bar[XB_XGEN(b.x)]) == gen, bar);
            __builtin_amdgcn_fence(__ATOMIC_ACQUIRE, "agent");
            asm volatile("s_waitcnt vmcnt(0)" ::: "memory");
        }
    }
    __syncthreads();
}

struct Frame {
    LAS unsigned char* lds;
    volatile LAS unsigned* MISC;
    gu32* ctl;
    int tid, lane, wave;
    int vcu, G;
    const float* const* in;
    float* out;
    unsigned char* ws;
};
#define WSP(type, off) ((type*)(F.ws + (off)))

__device__ __forceinline__ float wave_sum(float v) {
#pragma unroll
    for (int o = 1; o < 64; o <<= 1) v += __shfl_xor(v, o);
    return v;
}

__device__ __forceinline__ int colmap(int kind, int half, int n) {
    if (kind == 1) return (n & 1) ? half + (n >> 1) : (n >> 1);
    if (kind == 2 || (kind == 3 && n < QW)) { const int hd = n >> 6, p = n & 63; return hd * 64 + ((p & 1) * 32 + (p >> 1)); }
    return n;
}
__device__ __forceinline__ void cvt_item(const float* W, int ldw, int Kv, int Nv, bf16_t* WT, int Kout, int Nout, int kind, int half, LAS float* scr, int item, int lane) {
    const int nblk = Nout / 32, kb = item / nblk, nb = item % nblk, k0 = 64 * kb, n0 = 32 * nb;
    const int nn = n0 + (lane & 31); const int sc = colmap(kind, half, nn); const bool nok = nn < Nv;
#pragma unroll 8
    for (int i = 0; i < 32; ++i) { const int kk = 2 * i + (lane >> 5); float v = 0.f; if (nok && (k0 + kk) < Kv) v = W[(size_t)(k0 + kk) * ldw + sc]; scr[kk * 33 + (lane & 31)] = v; }
    LDS_WAIT(); asm volatile("" ::: "memory");
    const int c = lane & 7;
#pragma unroll
    for (int j = 0; j < 4; ++j) { const int n = (lane >> 3) + 8 * j; const LAS float* s = scr + (8 * c) * 33 + n;
        u32x4 o; o.x = cvt_pk_bf16(s[0 * 33], s[1 * 33]); o.y = cvt_pk_bf16(s[2 * 33], s[3 * 33]); o.z = cvt_pk_bf16(s[4 * 33], s[5 * 33]); o.w = cvt_pk_bf16(s[6 * 33], s[7 * 33]);
        *(u32x4*)(WT + (size_t)(n0 + n) * Kout + k0 + 8 * c) = o; }
    LDS_WAIT(); asm volatile("" ::: "memory");
}
__device__ __forceinline__ int invmap(int kind, int half, int sc) {
    if (kind == 1) return sc < half ? 2 * sc : 2 * (sc - half) + 1;
    if (kind == 2 || (kind == 3 && sc < QW)) { const int hd = sc >> 6, d = sc & 63; return hd * 64 + (d < 32 ? 2 * d : 2 * (d - 32) + 1); }
    return sc;
}
constexpr int CV_STRIDE = 68;
__device__ __forceinline__ void cvt_item64(const float* W, int ldw, bf16_t* WT, int Kout, int nblk, int kind, int half, LAS bf16_t* scr, int item, int lane) {
    const int kb = item / nblk, nb = item % nblk, k0 = 64 * kb, n0 = 64 * nb;
    const int c4 = lane & 15, kr = lane >> 4;
    f32x4 v[8][2];
#pragma unroll
    for (int i = 0; i < 8; ++i)
#pragma unroll
        for (int e = 0; e < 2; ++e) v[i][e] = __builtin_nontemporal_load((const f32x4*)(W + (size_t)(k0 + 8 * i + 2 * kr + e) * ldw + n0 + 4 * c4));
#pragma unroll
    for (int i = 0; i < 8; ++i)
#pragma unroll
        for (int e = 0; e < 4; ++e) *(LAS unsigned*)(scr + (4 * c4 + e) * CV_STRIDE + 8 * i + 2 * kr) = cvt_pk_bf16(v[i][0][e], v[i][1][e]);
    LDS_WAIT(); asm volatile("" ::: "memory");
    const int c = lane & 7;
#pragma unroll
    for (int j = 0; j < 8; ++j) { const int n = (lane >> 3) + 8 * j; const LAS bf16_t* sp = scr + n * CV_STRIDE + 8 * c;
        const u32x2 a = *(const LAS u32x2*)sp, b = *(const LAS u32x2*)(sp + 4);
        *(u32x4*)(WT + (size_t)invmap(kind, half, n0 + n) * Kout + k0 + 8 * c) = (u32x4){a.x, a.y, b.x, b.y}; }
    LDS_WAIT(); asm volatile("" ::: "memory");
}
__device__ __forceinline__ void p0_prologue(Frame& F) {
    {
        LAS float* part = (LAS float*)F.lds;
        const float* c = F.in[1]; const float* aw = F.in[2]; const float* ab = F.in[3]; float* MOD = WSP(float, WS_MOD);
        for (int it = F.vcu; it < ADA_W / 64; it += F.G) {
            const int j = it * 64 + F.lane; float s0 = 0.f, s1 = 0.f;
#pragma unroll 8
            for (int k = F.wave * 128; k < F.wave * 128 + 128; ++k) { const float w = aw[(size_t)k * ADA_W + j]; s0 += siluf_(c[k]) * w; s1 += siluf_(c[D + k]) * w; }
            part[(F.wave * 2 + 0) * 64 + F.lane] = s0; part[(F.wave * 2 + 1) * 64 + F.lane] = s1;
            __syncthreads();
            if (F.wave < 2) { float s = ab[j];
#pragma unroll
                for (int w = 0; w < 8; ++w) s += part[(w * 2 + F.wave) * 64 + F.lane];
                MOD[F.wave * ADA_W + j] = s; }
            __syncthreads();
        }
    }
    {
        float* cs = WSP(float, WS_ROPE); float* sn = cs + SEQ * 32;
        for (int idx = F.vcu * 512 + F.tid; idx < SEQ * 32; idx += F.G * 512) {
            const int t = idx >> 5, i = idx & 31;
            const float inv = powf(10000.0f, -(float)i / 32.0f); const float ang = (float)t * inv;
            cs[idx] = cosf(ang); sn[idx] = sinf(ang);
        }
    }
    LAS float* scr = (LAS float*)(F.lds + F.wave * 16384);
    LAS bf16_t* scrh = (LAS bf16_t*)(F.lds + F.wave * 16384);
    const int gw = F.vcu * NWAVES + F.wave, NGW = F.G * NWAVES;
    {
        constexpr int J_MGU = 16 * 112, J_MDN = 56 * 16, J_RKV = 16 * 48, J_OUT = 16 * 16, J_FGU = 16 * 88, J_FDN = 44 * 16, J_KV = 16 * 48, J_Q = 16 * 24, J_O = 8 * 16;
        constexpr int NJ = 8 * J_MGU + 8 * J_MDN + J_RKV + J_OUT + J_FGU + J_FDN + J_KV + J_Q + J_O;
        for (int it = gw; it < NJ; it += NGW) {
            int r = it;
            if (r < 8 * J_MGU) { const int e = r / J_MGU; cvt_item64(F.in[28] + (size_t)e * D * 2 * DFE, 2 * DFE, WSP(bf16_t, WS_WMGU) + (size_t)e * 2 * DFE * D, D, 112, 1, DFE, scrh, r % J_MGU, F.lane); continue; } r -= 8 * J_MGU;
            if (r < 8 * J_MDN) { const int e = r / J_MDN; cvt_item64(F.in[29] + (size_t)e * DFE * D, D, WSP(bf16_t, WS_WMDN) + (size_t)e * D * DFE, DFE, 16, 0, 0, scrh, r % J_MDN, F.lane); continue; } r -= 8 * J_MDN;
            if (r < J_RKV) { cvt_item64(F.in[7], 3 * D, WSP(bf16_t, WS_WRKV), D, 48, 0, 0, scrh, r, F.lane); continue; } r -= J_RKV;
            if (r < J_OUT) { cvt_item64(F.in[21], D, WSP(bf16_t, WS_WOUT), D, 16, 0, 0, scrh, r, F.lane); continue; } r -= J_OUT;
            if (r < J_FGU) { cvt_item64(F.in[25], 2 * DFF, WSP(bf16_t, WS_WFGU), D, 88, 1, DFF, scrh, r, F.lane); continue; } r -= J_FGU;
            if (r < J_FDN) { cvt_item64(F.in[26], D, WSP(bf16_t, WS_WFDN), DFF, 16, 0, 0, scrh, r, F.lane); continue; } r -= J_FDN;
            if (r < J_KV) { cvt_item64(F.in[22], 2 * QW, WSP(bf16_t, WS_WKV), D, 48, 3, 0, scrh, r, F.lane); continue; } r -= J_KV;
            if (r < J_Q) { cvt_item64(F.in[23], QW, WSP(bf16_t, WS_WQ), D, 24, 2, 0, scrh, r, F.lane); continue; } r -= J_Q;
            cvt_item64(F.in[24], D, WSP(bf16_t, WS_WO), AOUT, 16, 0, 0, scrh, r, F.lane);
        }
    }
    {
        constexpr int I_L1 = 16 * 8, I_L2 = 4 * 32;
        for (int it = gw; it < 3 * I_L1 + 3 * I_L2; it += NGW) {
            int r = it;
            if (r < I_L1) { cvt_item(F.in[9], 64, D, 64, WSP(bf16_t, WS_WL1), D, 256, 0, 0, scr, r, F.lane); continue; } r -= I_L1;
            if (r < I_L1) { cvt_item(F.in[12], 64, D, 64, WSP(bf16_t, WS_WL1) + 256 * D, D, 256, 0, 0, scr, r, F.lane); continue; } r -= I_L1;
            if (r < I_L1) { cvt_item(F.in[14], 160, D, 160, WSP(bf16_t, WS_WL1) + 2 * 256 * D, D, 256, 0, 0, scr, r, F.lane); continue; } r -= I_L1;
            if (r < I_L2) { cvt_item(F.in[10], D, 64, D, WSP(bf16_t, WS_WL2), 256, D, 0, 0, scr, r, F.lane); continue; } r -= I_L2;
            if (r < I_L2) { cvt_item(F.in[13], D, 64, D, WSP(bf16_t, WS_WL2) + D * 256, 256, D, 0, 0, scr, r, F.lane); continue; } r -= I_L2;
            cvt_item(F.in[15], D, 160, D, WSP(bf16_t, WS_WL2) + 2 * D * 256, 256, D, 0, 0, scr, r, F.lane);
        }
    }
}

__device__ __forceinline__ void p1_lerp(Frame& F) {
    const int gw = F.vcu * NWAVES + F.wave, NGW = F.G * NWAVES;
    const float* x = F.in[0]; const float* mu = F.in[6]; const float* MOD = WSP(float, WS_MOD); bf16_t* A6 = WSP(bf16_t, WS_A6);
    for (int m = gw; m < T; m += NGW) {
        const int b = m >> 14, t = m & (SEQ - 1);
#pragma unroll
        for (int j = 0; j < 4; ++j) {
            const int c = 4 * F.lane + 256 * j;
            const f32x4 sh = *(const f32x4*)(MOD + b * ADA_W + 0 * D + c), sc = *(const f32x4*)(MOD + b * ADA_W + 1 * D + c);
            const f32x4 xc = *(const f32x4*)(x + (size_t)m * D + c);
            const f32x4 hc = xc * (1.f + sc) + sh;
            f32x4 hp = (f32x4){0.f, 0.f, 0.f, 0.f};
            if (t > 0) { const f32x4 xp = *(const f32x4*)(x + (size_t)(m - 1) * D + c); hp = xp * (1.f + sc) + sh; }
            const f32x4 xx = hp - hc;
#pragma unroll
            for (int p = 0; p < 6; ++p) {
                const f32x4 mv = *(const f32x4*)(mu + p * D + c); const f32x4 o = hc + xx * mv;
                u32x2 w; w.x = cvt_pk_bf16(o[0], o[1]); w.y = cvt_pk_bf16(o[2], o[3]);
                *(u32x2*)(A6 + (size_t)p * T * D + (size_t)m * D + c) = w;
            }
        }
    }
}

template <int CTRL> __device__ __forceinline__ float dpp_mov(float v) { return __int_as_float(__builtin_amdgcn_update_dpp(0, __float_as_int(v), CTRL, 0xF, 0xF, false)); }
__device__ __forceinline__ float sum16(float v) { v += dpp_mov<0xB1>(v); v += dpp_mov<0x4E>(v); v += dpp_mov<0x141>(v); v += dpp_mov<0x140>(v); return v; }
__device__ __forceinline__ float rdl(float v, int l) { return __int_as_float(__builtin_amdgcn_readlane(__float_as_int(v), l)); }
__device__ __forceinline__ float wsum(float v) { v = sum16(v); return (rdl(v, 0) + rdl(v, 16)) + (rdl(v, 32) + rdl(v, 48)); }
__device__ __forceinline__ unsigned short bf1(float x) { return (unsigned short)(cvt_pk_bf16(x, x) & 0xffffu); }
constexpr int CH = 64, NCH = SEQ / CH, NUNIT = BATCH * 16 * NCH;
constexpr int CS = 72;
constexpr int L_AT = 0, L_RT = 9216, L_BT = 18432, L_KT = 27648, L_ATT = 36864, L_BTT = 46080, L_KTT = 55296, L_VT = 64512, L_AAB = 73728, L_AAK = 82944, L_ARB = 92160, L_ARK = 101376;
constexpr int L_XT = L_BT;
constexpr int L_TI = 110592, L_WC = 112640, L_TOT = 112896;
#define FRAG(base, row, ks) (*(const LAS bf16x8*)((base) + (row) * CS + 32 * (ks) + 8 * qd))
#define MF(a, b, c) __builtin_amdgcn_mfma_f32_16x16x32_bf16((a), (b), (c), 0, 0, 0)
__device__ __forceinline__ bf16x8 pack8(const f32x4 a, const f32x4 b) { union { bf16x8 v; unsigned u[4]; } t; t.u[0] = cvt_pk_bf16(a[0], a[1]); t.u[1] = cvt_pk_bf16(a[2], a[3]); t.u[2] = cvt_pk_bf16(b[0], b[1]); t.u[3] = cvt_pk_bf16(b[2], b[3]); return t.v; }
__device__ __forceinline__ f32x4 unpk4(const u32x2 w) { return (f32x4){bflo(w.x), bfhi(w.x), bflo(w.y), bfhi(w.y)}; }

struct ChIn { unsigned short r[8], k[8], v[8], a[8]; float wl[8]; };
__device__ __forceinline__ void ch_load(ChIn& I, const bf16_t* RB, const bf16_t* KB, const bf16_t* VB, const bf16_t* AS, const float* WLOG, size_t m0, int col) {
#pragma unroll
    for (int i = 0; i < 8; ++i) { const size_t o = (m0 + i) * D + col; I.r[i] = RB[o]; I.k[i] = KB[o]; I.v[i] = VB[o]; I.a[i] = AS[o]; I.wl[i] = WLOG[o]; }
}
__device__ __forceinline__ void p4a_chunk(Frame& F) {
    LAS unsigned char* L = F.lds;
    LAS bf16_t* At = (LAS bf16_t*)(L + L_AT); LAS bf16_t* Rt = (LAS bf16_t*)(L + L_RT); LAS bf16_t* Bt = (LAS bf16_t*)(L + L_BT); LAS bf16_t* Kt = (LAS bf16_t*)(L + L_KT);
    LAS bf16_t* AtT = (LAS bf16_t*)(L + L_ATT); LAS bf16_t* BtT = (LAS bf16_t*)(L + L_BTT); LAS bf16_t* KtT = (LAS bf16_t*)(L + L_KTT); LAS bf16_t* VT = (LAS bf16_t*)(L + L_VT);
    LAS bf16_t* AAB = (LAS bf16_t*)(L + L_AAB); LAS bf16_t* AAK = (LAS bf16_t*)(L + L_AAK); LAS bf16_t* ARB = (LAS bf16_t*)(L + L_ARB); LAS bf16_t* ARK = (LAS bf16_t*)(L + L_ARK);
    LAS bf16_t* XT = (LAS bf16_t*)(L + L_XT); LAS bf16_t* TI = (LAS bf16_t*)(L + L_TI); LAS float* WC = (LAS float*)(L + L_WC); LAS float* TOT = (LAS float*)(L + L_TOT);
    const bf16_t* RB = WSP(bf16_t, WS_RB); const bf16_t* KB = WSP(bf16_t, WS_KB); const bf16_t* VB = WSP(bf16_t, WS_VB); const bf16_t* AS = WSP(bf16_t, WS_AS); const float* WLOG = F.out;
    u32x4* PF = WSP(u32x4, WS_PF); u32x4* QF = WSP(u32x4, WS_QF); u32x4* RF = WSP(u32x4, WS_RF); u32x4* YF = WSP(u32x4, WS_YF); float* WCF = WSP(float, WS_WCF); float* BON = WSP(float, WS_BON);
    const int lane = F.lane, w = F.wave, q16 = lane & 15, qd = lane >> 4;
    ChIn I;
    int unit = F.vcu;
    if (unit < NUNIT) { const int bh = unit >> 8, ch = unit & 255; ch_load(I, RB, KB, VB, AS, WLOG, (size_t)(bh >> 4) * SEQ + ch * CH + 8 * w, (bh & 15) * 64 + lane); }
    for (; unit < NUNIT; unit += F.G) {
        const int bh = unit >> 8, ch = unit & 255, b = bh >> 4, h = bh & 15;
        const size_t m0 = (size_t)b * SEQ + (size_t)ch * CH;
        const int col = h * 64 + lane;
        float r_[8], kp_[8], kn_[8], a_[8], cwl[8];
        {
            const float kkc = F.in[16][col], kac = F.in[17][col], rkc = F.in[18][col];
            float run = 0.f;
#pragma unroll
            for (int i = 0; i < 8; ++i) {
                const float r = __uint_as_float((unsigned)I.r[i] << 16), k = __uint_as_float((unsigned)I.k[i] << 16), a = __uint_as_float((unsigned)I.a[i] << 16);
                run += I.wl[i]; cwl[i] = run;
                const float kkv = k * kkc; const float ss = wsum(kkv * kkv); const float inv = 1.f / fmaxf(sqrtf(ss), 1e-12f);
                const float kp = k * (1.f + (a - 1.f) * kac); const float bn = wsum(r * kp * rkc);
                if (lane == 0) BON[(m0 + 8 * w + i) * 16 + h] = bn;
                r_[i] = r; kp_[i] = kp; kn_[i] = kkv * inv; a_[i] = a;
            }
            TOT[w * 64 + lane] = run;
        }
        __syncthreads();
        {
            float off = 0.f, tot = 0.f;
#pragma unroll
            for (int ww = 0; ww < 8; ++ww) { const float tv = TOT[ww * 64 + lane]; tot += tv; off += (ww < w) ? tv : 0.f; }
            if (w == 0) { WC[lane] = __expf(tot); WCF[(size_t)unit * 64 + lane] = __expf(tot); }
            float at[8], bt[8], kt[8];
#pragma unroll
            for (int i = 0; i < 8; ++i) {
                const float cw = off + cwl[i]; const float ein = __expf(cw), eex = __expf(cw - I.wl[i]), einv = __expf(-cw);
                at[i] = -kn_[i] * eex; bt[i] = kn_[i] * a_[i] * einv; kt[i] = kp_[i] * einv; const float rt = r_[i] * ein;
                const int t = 8 * w + i;
                At[t * CS + lane] = bf1(at[i]); Rt[t * CS + lane] = bf1(rt); Bt[t * CS + lane] = bf1(bt[i]); Kt[t * CS + lane] = bf1(kt[i]);
            }
            u32x4 pa, pb, pk, pv;
            pa.x = cvt_pk_bf16(at[0], at[1]); pa.y = cvt_pk_bf16(at[2], at[3]); pa.z = cvt_pk_bf16(at[4], at[5]); pa.w = cvt_pk_bf16(at[6], at[7]);
            pb.x = cvt_pk_bf16(bt[0], bt[1]); pb.y = cvt_pk_bf16(bt[2], bt[3]); pb.z = cvt_pk_bf16(bt[4], bt[5]); pb.w = cvt_pk_bf16(bt[6], bt[7]);
            pk.x = cvt_pk_bf16(kt[0], kt[1]); pk.y = cvt_pk_bf16(kt[2], kt[3]); pk.z = cvt_pk_bf16(kt[4], kt[5]); pk.w = cvt_pk_bf16(kt[6], kt[7]);
            pv.x = (unsigned)I.v[0] | ((unsigned)I.v[1] << 16); pv.y = (unsigned)I.v[2] | ((unsigned)I.v[3] << 16); pv.z = (unsigned)I.v[4] | ((unsigned)I.v[5] << 16); pv.w = (unsigned)I.v[6] | ((unsigned)I.v[7] << 16);
            *(LAS u32x4*)(AtT + lane * CS + 8 * w) = pa; *(LAS u32x4*)(BtT + lane * CS + 8 * w) = pb; *(LAS u32x4*)(KtT + lane * CS + 8 * w) = pk; *(LAS u32x4*)(VT + lane * CS + 8 * w) = pv;
        }
        { const int nu = unit + F.G; if (nu < NUNIT) { const int nbh = nu >> 8, nch = nu & 255; ch_load(I, RB, KB, VB, AS, WLOG, (size_t)(nbh >> 4) * SEQ + nch * CH + 8 * w, (nbh & 15) * 64 + lane); } }
        __syncthreads();
        {
            const int tt = w >> 1, half = w & 1;
            const LAS bf16_t* src = half ? Rt : At; LAS bf16_t* d0 = half ? ARB : AAB; LAS bf16_t* d1 = half ? ARK : AAK;
            const bf16x8 s0 = FRAG(src, 16 * tt + q16, 0), s1 = FRAG(src, 16 * tt + q16, 1);
#pragma unroll
            for (int jt = 0; jt < 4; ++jt) {
                f32x4 e0 = (f32x4){0.f, 0.f, 0.f, 0.f}, e1 = e0;
                if (jt <= tt) {
                    e0 = MF(FRAG(Bt, 16 * jt + q16, 0), s0, e0); e0 = MF(FRAG(Bt, 16 * jt + q16, 1), s1, e0);
                    e1 = MF(FRAG(Kt, 16 * jt + q16, 0), s0, e1); e1 = MF(FRAG(Kt, 16 * jt + q16, 1), s1, e1);
#pragma unroll
                    for (int r = 0; r < 4; ++r) { const int j = 16 * jt + 4 * qd + r, t = 16 * tt + q16; const bool ok = half ? (j <= t) : (j < t); e0[r] = ok ? e0[r] : 0.f; e1[r] = ok ? e1[r] : 0.f; }
                }
                u32x2 o0, o1; o0.x = cvt_pk_bf16(e0[0], e0[1]); o0.y = cvt_pk_bf16(e0[2], e0[3]); o1.x = cvt_pk_bf16(e1[0], e1[1]); o1.y = cvt_pk_bf16(e1[2], e1[3]);
                *(LAS u32x2*)(d0 + (16 * tt + q16) * CS + 16 * jt + 4 * qd) = o0; *(LAS u32x2*)(d1 + (16 * tt + q16) * CS + 16 * jt + 4 * qd) = o1;
            }
        }
        __syncthreads();
        f32x4 Z[4];
        if (w < 4) {
            float Tc[16];
#pragma unroll
            for (int r = 0; r < 16; ++r) Tc[r] = (r == q16) ? 1.f : 0.f;
#pragma unroll
            for (int r = 1; r < 16; ++r) {
                const LAS bf16_t* np_ = AAB + (16 * w + r) * CS + 16 * w;
                const u32x4 n0 = *(const LAS u32x4*)np_, n1 = *(const LAS u32x4*)(np_ + 8);
                const float nv[16] = {bflo(n0.x), bfhi(n0.x), bflo(n0.y), bfhi(n0.y), bflo(n0.z), bfhi(n0.z), bflo(n0.w), bfhi(n0.w), bflo(n1.x), bfhi(n1.x), bflo(n1.y), bfhi(n1.y), bflo(n1.z), bfhi(n1.z), bflo(n1.w), bfhi(n1.w)};
                float acc = Tc[r];
#pragma unroll
                for (int s = 0; s < r; ++s) acc += nv[s] * Tc[s];
                Tc[r] = acc;
            }
            if (qd == 0) {
#pragma unroll
                for (int r = 0; r < 16; ++r) TI[(w * 16 + r) * 16 + q16] = bf1(Tc[r]);
            }
#pragma unroll
            for (int i = 0; i < 4; ++i) Z[i] = unpk4(*(const LAS u32x2*)(AtT + (16 * w + q16) * CS + 16 * i + 4 * qd));
        } else {
            const int vt = w - 4;
            const bf16x8 v0 = FRAG(VT, 16 * vt + q16, 0), v1 = FRAG(VT, 16 * vt + q16, 1);
#pragma unroll
            for (int i = 0; i < 4; ++i) {
                f32x4 g = (f32x4){0.f, 0.f, 0.f, 0.f};
                g = MF(FRAG(AAK, 16 * i + q16, 0), v0, g);
                if (i >= 2) g = MF(FRAG(AAK, 16 * i + q16, 1), v1, g);
                Z[i] = g;
            }
        }
        __syncthreads();
        {
            const f32x4 zz = (f32x4){0.f, 0.f, 0.f, 0.f};
            f32x4 X[4];
#pragma unroll
            for (int i = 0; i < 4; ++i) {
                if (i >= 1) {
                    union { bf16x8 v; u32x2 h[2]; } af;
                    af.h[0] = *(const LAS u32x2*)(AAB + (16 * i + q16) * CS + 0 + 4 * qd);
                    af.h[1] = (i >= 2) ? *(const LAS u32x2*)(AAB + (16 * i + q16) * CS + 16 + 4 * qd) : (u32x2){0u, 0u};
                    Z[i] = MF(af.v, pack8(X[0], (i >= 2) ? X[1] : zz), Z[i]);
                    if (i == 3) { af.h[0] = *(const LAS u32x2*)(AAB + (16 * i + q16) * CS + 32 + 4 * qd); af.h[1] = (u32x2){0u, 0u}; Z[i] = MF(af.v, pack8(X[2], zz), Z[i]); }
                }
                union { bf16x8 v; u32x2 h[2]; } tf; tf.h[0] = *(const LAS u32x2*)(TI + (i * 16 + q16) * 16 + 4 * qd); tf.h[1] = (u32x2){0u, 0u};
                X[i] = MF(tf.v, pack8(Z[i], zz), zz);
                u32x2 o; o.x = cvt_pk_bf16(X[i][0], X[i][1]); o.y = cvt_pk_bf16(X[i][2], X[i][3]);
                *(LAS u32x2*)(XT + (16 * w + q16) * CS + 16 * i + 4 * qd) = o;
            }
        }
        __syncthreads();
        {
            const int hi = w >> 1, lo = w & 1;
            const size_t fo = ((size_t)unit * 8 + w) * 64 + lane;
            {
                const bf16x8 b0 = FRAG(BtT, 16 * hi + q16, 0), b1 = FRAG(BtT, 16 * hi + q16, 1);
                f32x4 d[2];
#pragma unroll
                for (int e = 0; e < 2; ++e) { const int kt = 2 * lo + e; f32x4 a = (f32x4){0.f, 0.f, 0.f, 0.f}; a = MF(FRAG(XT, 16 * kt + q16, 0), b0, a); a = MF(FRAG(XT, 16 * kt + q16, 1), b1, a); d[e] = a * WC[16 * hi + q16]; }
                const bf16x8 o = pack8(d[0], d[1]); PF[fo] = *(const u32x4*)&o;
            }
            {
                const bf16x8 u0 = FRAG(XT, 64 + 16 * hi + q16, 0), u1 = FRAG(XT, 64 + 16 * hi + q16, 1), v0 = FRAG(VT, 16 * hi + q16, 0), v1 = FRAG(VT, 16 * hi + q16, 1);
                f32x4 d[2];
#pragma unroll
                for (int e = 0; e < 2; ++e) { const int kt = 2 * lo + e; f32x4 a = (f32x4){0.f, 0.f, 0.f, 0.f};
                    a = MF(FRAG(BtT, 16 * kt + q16, 0), u0, a); a = MF(FRAG(BtT, 16 * kt + q16, 1), u1, a); a = MF(FRAG(KtT, 16 * kt + q16, 0), v0, a); a = MF(FRAG(KtT, 16 * kt + q16, 1), v1, a);
                    d[e] = a * *(const LAS f32x4*)(WC + 16 * kt + 4 * qd); }
                const bf16x8 o = pack8(d[0], d[1]); QF[fo] = *(const u32x4*)&o;
            }
            {
                const bf16x8 b0 = FRAG(ARB, 16 * hi + q16, 0), b1 = FRAG(ARB, 16 * hi + q16, 1);
                f32x4 d[2];
#pragma unroll
                for (int e = 0; e < 2; ++e) { const int ct = 2 * lo + e; f32x4 a = unpk4(*(const LAS u32x2*)(Rt + (16 * hi + q16) * CS + 16 * ct + 4 * qd));
                    a = MF(FRAG(XT, 16 * ct + q16, 0), b0, a); if (hi >= 2) a = MF(FRAG(XT, 16 * ct + q16, 1), b1, a); d[e] = a; }
                const bf16x8 o = pack8(d[0], d[1]); RF[fo] = *(const u32x4*)&o;
            }
            {
                const bf16x8 b0 = FRAG(ARB, 16 * hi + q16, 0), b1 = FRAG(ARB, 16 * hi + q16, 1), k0 = FRAG(ARK, 16 * hi + q16, 0), k1 = FRAG(ARK, 16 * hi + q16, 1);
                f32x4 d[2];
#pragma unroll
                for (int e = 0; e < 2; ++e) { const int vt = 2 * lo + e; f32x4 a = (f32x4){0.f, 0.f, 0.f, 0.f};
                    a = MF(FRAG(XT, 64 + 16 * vt + q16, 0), b0, a); a = MF(FRAG(VT, 16 * vt + q16, 0), k0, a);
                    if (hi >= 2) { a = MF(FRAG(XT, 64 + 16 * vt + q16, 1), b1, a); a = MF(FRAG(VT, 16 * vt + q16, 1), k1, a); }
                    d[e] = a; }
                const bf16x8 o = pack8(d[0], d[1]); YF[fo] = *(const u32x4*)&o;
            }
        }
    }
}
__device__ __forceinline__ void p4b_chain(Frame& F) {
    if (F.wave != 0) return;
    const u32x4* PF = WSP(u32x4, WS_PF); const u32x4* QF = WSP(u32x4, WS_QF); const float* WCF = WSP(float, WS_WCF); u32x4* SF = WSP(u32x4, WS_SF);
    const int lane = F.lane, qd = lane >> 4;
    for (int job = F.vcu; job < BATCH * 16 * 4; job += F.G) {
        const int bh = job >> 2, vt = job & 3;
        f32x4 S[4];
#pragma unroll
        for (int kt = 0; kt < 4; ++kt) S[kt] = (f32x4){0.f, 0.f, 0.f, 0.f};
        u32x4 pf[2][8], qf[2][2]; f32x4 wc[2][4];
#define CHAIN_LOAD(buf, u) do { _Pragma("unroll") for (int x = 0; x < 8; ++x) pf[buf][x] = PF[((size_t)(u) * 8 + x) * 64 + lane]; \
        _Pragma("unroll") for (int x = 0; x < 2; ++x) qf[buf][x] = QF[((size_t)(u) * 8 + vt * 2 + x) * 64 + lane]; \
        _Pragma("unroll") for (int kt = 0; kt < 4; ++kt) wc[buf][kt] = *(const f32x4*)(WCF + (size_t)(u) * 64 + 16 * kt + 4 * qd); } while (0)
#define CHAIN_STEP(buf, u) do { \
        const bf16x8 s0 = pack8(S[0], S[1]), s1 = pack8(S[2], S[3]); \
        SF[((size_t)(u) * 8 + vt * 2 + 0) * 64 + lane] = *(const u32x4*)&s0; SF[((size_t)(u) * 8 + vt * 2 + 1) * 64 + lane] = *(const u32x4*)&s1; \
        f32x4 n[4]; \
        n[0] = unpk4((u32x2){qf[buf][0].x, qf[buf][0].y}) + wc[buf][0] * S[0]; n[1] = unpk4((u32x2){qf[buf][0].z, qf[buf][0].w}) + wc[buf][1] * S[1]; \
        n[2] = unpk4((u32x2){qf[buf][1].x, qf[buf][1].y}) + wc[buf][2] * S[2]; n[3] = unpk4((u32x2){qf[buf][1].z, qf[buf][1].w}) + wc[buf][3] * S[3]; \
        _Pragma("unroll") for (int kt = 0; kt < 4; ++kt) { n[kt] = MF(*(const bf16x8*)&pf[buf][kt * 2 + 0], s0, n[kt]); n[kt] = MF(*(const bf16x8*)&pf[buf][kt * 2 + 1], s1, n[kt]); } \
        _Pragma("unroll") for (int kt = 0; kt < 4; ++kt) S[kt] = n[kt]; } while (0)
        const size_t u0 = (size_t)bh * NCH;
        CHAIN_LOAD(0, u0);
        for (int c = 0; c < NCH; c += 2) {
            CHAIN_LOAD(1, u0 + c + 1);
            CHAIN_STEP(0, u0 + c);
            if (c + 2 < NCH) CHAIN_LOAD(0, u0 + c + 2);
            CHAIN_STEP(1, u0 + c + 1);
        }
#undef CHAIN_LOAD
#undef CHAIN_STEP
    }
}
__device__ __forceinline__ void p5_chunk_out(Frame& F) {
    const u32x4* SF = WSP(u32x4, WS_SF); const u32x4* RF = WSP(u32x4, WS_RF); const u32x4* YF = WSP(u32x4, WS_YF); const float* BON = WSP(float, WS_BON);
    const bf16_t* VB = WSP(bf16_t, WS_VB); const bf16_t* GG = WSP(bf16_t, WS_G); bf16_t* YG = WSP(bf16_t, WS_YG);
    const int lane = F.lane, q16 = lane & 15, qd = lane >> 4;
    const int gw = F.vcu * NWAVES + F.wave, NGW = F.G * NWAVES;
    for (int job = gw; job < NUNIT * 4; job += NGW) {
        const int unit = job >> 2, tt = job & 3, bh = unit >> 8, ch = unit & 255, b = bh >> 4, h = bh & 15;
        const size_t m = (size_t)b * SEQ + (size_t)ch * CH + 16 * tt + q16;
        const u32x4 r0 = RF[((size_t)unit * 8 + tt * 2 + 0) * 64 + lane], r1 = RF[((size_t)unit * 8 + tt * 2 + 1) * 64 + lane];
        const u32x4 y0 = YF[((size_t)unit * 8 + tt * 2 + 0) * 64 + lane], y1 = YF[((size_t)unit * 8 + tt * 2 + 1) * 64 + lane];
        f32x4 y[4];
        y[0] = unpk4((u32x2){y0.x, y0.y}); y[1] = unpk4((u32x2){y0.z, y0.w}); y[2] = unpk4((u32x2){y1.x, y1.y}); y[3] = unpk4((u32x2){y1.z, y1.w});
#pragma unroll
        for (int vt = 0; vt < 4; ++vt) {
            const u32x4 s0 = SF[((size_t)unit * 8 + vt * 2 + 0) * 64 + lane], s1 = SF[((size_t)unit * 8 + vt * 2 + 1) * 64 + lane];
            y[vt] = MF(*(const bf16x8*)&s0, *(const bf16x8*)&r0, y[vt]); y[vt] = MF(*(const bf16x8*)&s1, *(const bf16x8*)&r1, y[vt]);
        }
        const float bn = BON[m * 16 + h];
        float s = 0.f;
#pragma unroll
        for (int vt = 0; vt < 4; ++vt) s += (y[vt][0] + y[vt][1]) + (y[vt][2] + y[vt][3]);
        s += __shfl_xor(s, 16); s += __shfl_xor(s, 32);
        const float mean = s * (1.f / 64.f); float qv = 0.f;
#pragma unroll
        for (int vt = 0; vt < 4; ++vt) { y[vt] = y[vt] - mean; qv += (y[vt][0] * y[vt][0] + y[vt][1] * y[vt][1]) + (y[vt][2] * y[vt][2] + y[vt][3] * y[vt][3]); }
        qv += __shfl_xor(qv, 16); qv += __shfl_xor(qv, 32);
        const float rstd = 1.f / sqrtf(qv * (1.f / 64.f) + LNX_EPS);
#pragma unroll
        for (int vt = 0; vt < 4; ++vt) {
            const int c = h * 64 + 16 * vt + 4 * qd; const size_t off = m * D + c;
            const f32x4 vv = unpk4(*(const u32x2*)(VB + off)), gg = unpk4(*(const u32x2*)(GG + off));
            const f32x4 o = ((y[vt] * rstd) * *(const f32x4*)(F.in[19] + c) + *(const f32x4*)(F.in[20] + c) + bn * vv) * gg;
            u32x2 wv; wv.x = cvt_pk_bf16(o[0], o[1]); wv.y = cvt_pk_bf16(o[2], o[3]);
            *(u32x2*)(YG + off) = wv;
        }
    }
}
#undef FRAG
#undef MF

__device__ __forceinline__ void ln_apply(f32x4 (&v)[4], const float* g, const float* b, int lane) {
    float s = 0.f;
#pragma unroll
    for (int j = 0; j < 4; ++j) s += (v[j][0] + v[j][1]) + (v[j][2] + v[j][3]);
    const float mean = wave_sum(s) * (1.f / D); float s2 = 0.f;
#pragma unroll
    for (int j = 0; j < 4; ++j) { v[j] = v[j] - mean; s2 += (v[j][0] * v[j][0] + v[j][1] * v[j][1]) + (v[j][2] * v[j][2] + v[j][3] * v[j][3]); }
    const float rstd = 1.f / sqrtf(wave_sum(s2) * (1.f / D) + LN_EPS);
#pragma unroll
    for (int j = 0; j < 4; ++j) { const int c = 4 * lane + 256 * j; v[j] = v[j] * rstd * *(const f32x4*)(g + c) + *(const f32x4*)(b + c); }
}
__device__ __forceinline__ void mod_store(const f32x4 (&v)[4], const float* shift, const float* scale, bf16_t* orow, int lane) {
#pragma unroll
    for (int j = 0; j < 4; ++j) { const int c = 4 * lane + 256 * j; const f32x4 o = v[j] * (1.f + *(const f32x4*)(scale + c)) + *(const f32x4*)(shift + c);
        u32x2 w; w.x = cvt_pk_bf16(o[0], o[1]); w.y = cvt_pk_bf16(o[2], o[3]); *(u32x2*)(orow + c) = w; }
}
__device__ __forceinline__ void p_postnorm(Frame& F, const float* xres, const bf16_t* y, float* xout, int sub, int modA, bf16_t* outA, int modB, bf16_t* outB) {
    const int gw = F.vcu * NWAVES + F.wave, NGW = F.G * NWAVES;
    const float* MOD = WSP(float, WS_MOD); const float* g = F.in[4] + sub * D; const float* bb = F.in[5] + sub * D;
    for (int m = gw; m < T; m += NGW) {
        const int b = m >> 14; const float* gate = MOD + b * ADA_W + (sub * 3 + 2) * D;
        f32x4 v[4];
#pragma unroll
        for (int j = 0; j < 4; ++j) { const int c = 4 * F.lane + 256 * j;
            const u32x2 yw = *(const u32x2*)(y + (size_t)m * D + c); const f32x4 yv = (f32x4){bflo(yw.x), bfhi(yw.x), bflo(yw.y), bfhi(yw.y)};
            v[j] = DN_ALPHA * *(const f32x4*)(xres + (size_t)m * D + c) + (1.f + *(const f32x4*)(gate + c)) * yv; }
        ln_apply(v, g, bb, F.lane);
#pragma unroll
        for (int j = 0; j < 4; ++j) *(f32x4*)(xout + (size_t)m * D + 4 * F.lane + 256 * j) = v[j];
        if (outA) mod_store(v, MOD + b * ADA_W + modA, MOD + b * ADA_W + modA + D, outA + (size_t)m * D, F.lane);
        if (outB) mod_store(v, MOD + b * ADA_W + modB, MOD + b * ADA_W + modB + D, outB + (size_t)m * D, F.lane);
    }
}

constexpr int KS_STRIDE = 72;
constexpr int VT_STRIDE = 264;
__device__ __forceinline__ void p12_attn(Frame& F) {
    LAS bf16_t* Ks = (LAS bf16_t*)F.lds;
    LAS bf16_t* Vt = Ks + 256 * KS_STRIDE;
    const bf16_t* Q2 = WSP(bf16_t, WS_Q2); const bf16_t* K2 = WSP(bf16_t, WS_K2); const bf16_t* V2 = WSP(bf16_t, WS_V2);
    bf16_t* OG = WSP(bf16_t, WS_OG); float* LSE = WSP(float, WS_LSE);
    const int lane = F.lane, w = F.wave, q16 = lane & 15, qd = lane >> 4;
    for (int unit = F.vcu; unit < BATCH * 3 * 8 * 128; unit += F.G) {
        const int pb = unit & 127, hg = (unit >> 7) & 7, gb = unit >> 10, g = gb % 3, b = gb / 3;
        const int dil = g == 0 ? 1 : (g == 1 ? 4 : 16), nb = 128 / dil, phase = pb / nb, blk = pb % nb;
        const int hcol = (g * 8 + hg) * 64;
#pragma unroll
        for (int i = 0; i < 4; ++i) {
            const int ch = F.tid + 512 * i, key = ch >> 3, c8 = (ch & 7) * 8;
            const int pos = (blk - 1) * 128 + key;
            u32x4 kv = (u32x4){0u, 0u, 0u, 0u}, vv = (u32x4){0u, 0u, 0u, 0u};
            if (pos >= 0) { const size_t row = (size_t)b * SEQ + (size_t)pos * dil + phase;
                kv = *(const u32x4*)(K2 + row * QW + hcol + c8); vv = *(const u32x4*)(V2 + row * QW + hcol + c8); }
            *(LAS u32x4*)(Ks + key * KS_STRIDE + c8) = kv;
            Vt[(c8 + 0) * VT_STRIDE + key] = (bf16_t)(vv.x & 0xffff); Vt[(c8 + 1) * VT_STRIDE + key] = (bf16_t)(vv.x >> 16);
            Vt[(c8 + 2) * VT_STRIDE + key] = (bf16_t)(vv.y & 0xffff); Vt[(c8 + 3) * VT_STRIDE + key] = (bf16_t)(vv.y >> 16);
            Vt[(c8 + 4) * VT_STRIDE + key] = (bf16_t)(vv.z & 0xffff); Vt[(c8 + 5) * VT_STRIDE + key] = (bf16_t)(vv.z >> 16);
            Vt[(c8 + 6) * VT_STRIDE + key] = (bf16_t)(vv.w & 0xffff); Vt[(c8 + 7) * VT_STRIDE + key] = (bf16_t)(vv.w >> 16);
        }
        const int qi = 16 * w + q16;
        const size_t qrow = (size_t)b * SEQ + (size_t)(blk * 128 + qi) * dil + phase;
        const bf16x8 qf0 = *(const bf16x8*)(Q2 + qrow * QW + hcol + 8 * qd), qf1 = *(const bf16x8*)(Q2 + qrow * QW + hcol + 32 + 8 * qd);
        __syncthreads();
        const int kt0 = w < 6 ? w : 6;
        f32x4 s[10];
#pragma unroll
        for (int i = 0; i < 10; ++i) {
            const LAS bf16_t* kp = Ks + (16 * (kt0 + i) + q16) * KS_STRIDE + 8 * qd;
            const bf16x8 k0 = *(const LAS bf16x8*)kp, k1 = *(const LAS bf16x8*)(kp + 32);
            f32x4 a = (f32x4){0.f, 0.f, 0.f, 0.f};
            a = __builtin_amdgcn_mfma_f32_16x16x32_bf16(k0, qf0, a, 0, 0, 0);
            a = __builtin_amdgcn_mfma_f32_16x16x32_bf16(k1, qf1, a, 0, 0, 0);
            s[i] = a;
        }
        float mx = -1e30f;
#pragma unroll
        for (int i = 0; i < 10; ++i)
#pragma unroll
            for (int r = 0; r < 4; ++r) { const int kidx = 16 * (kt0 + i) + 4 * qd + r; const bool ok = (kidx >= qi) && (kidx <= qi + 128) && (blk > 0 || kidx >= 128);
                s[i][r] = ok ? s[i][r] : -1e30f; mx = fmaxf(mx, s[i][r]); }
        mx = fmaxf(mx, __shfl_xor(mx, 16)); mx = fmaxf(mx, __shfl_xor(mx, 32));
        float l = 0.f;
#pragma unroll
        for (int i = 0; i < 10; ++i)
#pragma unroll
            for (int r = 0; r < 4; ++r) { const float p = __expf(s[i][r] - mx); s[i][r] = p; l += p; }
        l += __shfl_xor(l, 16); l += __shfl_xor(l, 32);
        f32x4 o[4];
#pragma unroll
        for (int dt = 0; dt < 4; ++dt) o[dt] = (f32x4){0.f, 0.f, 0.f, 0.f};
#pragma unroll
        for (int i = 0; i < 5; ++i) {
            union { bf16x8 v; unsigned u[4]; } pf;
            pf.u[0] = cvt_pk_bf16(s[2 * i][0], s[2 * i][1]); pf.u[1] = cvt_pk_bf16(s[2 * i][2], s[2 * i][3]);
            pf.u[2] = cvt_pk_bf16(s[2 * i + 1][0], s[2 * i + 1][1]); pf.u[3] = cvt_pk_bf16(s[2 * i + 1][2], s[2 * i + 1][3]);
#pragma unroll
            for (int dt = 0; dt < 4; ++dt) {
                const LAS bf16_t* vp = Vt + (16 * dt + q16) * VT_STRIDE + 16 * (kt0 + 2 * i) + 4 * qd;
                union { bf16x8 v; s16x4 h[2]; } vf; vf.h[0] = *(const LAS s16x4*)vp; vf.h[1] = *(const LAS s16x4*)(vp + 16);
                o[dt] = __builtin_amdgcn_mfma_f32_16x16x32_bf16(vf.v, pf.v, o[dt], 0, 0, 0);
            }
        }
        const float il = 1.f / l;
        bf16_t* op = OG + (size_t)g * T * AOUT + qrow * AOUT + hg * 64 + 4 * qd;
#pragma unroll
        for (int dt = 0; dt < 4; ++dt) { u32x2 wv; wv.x = cvt_pk_bf16(o[dt][0] * il, o[dt][1] * il); wv.y = cvt_pk_bf16(o[dt][2] * il, o[dt][3] * il); *(u32x2*)(op + 16 * dt) = wv; }
        if (qd == 0) LSE[(size_t)g * T * 8 + qrow * 8 + hg] = mx + __logf(l);
        __syncthreads();
    }
}
__device__ __forceinline__ void p13_merge(Frame& F) {
    const bf16_t* OG = WSP(bf16_t, WS_OG); const float* LSE = WSP(float, WS_LSE); bf16_t* OM = WSP(bf16_t, WS_OM);
    for (int idx = F.vcu * 512 + F.tid; idx < T * 64; idx += F.G * 512) {
        const int m = idx >> 6, hg = (idx >> 3) & 7, c8 = (idx & 7) * 8;
        const float l0 = LSE[(size_t)0 * T * 8 + m * 8 + hg], l1 = LSE[(size_t)1 * T * 8 + m * 8 + hg], l2 = LSE[(size_t)2 * T * 8 + m * 8 + hg];
        const float mx = fmaxf(l0, fmaxf(l1, l2)); float w0 = __expf(l0 - mx), w1 = __expf(l1 - mx), w2 = __expf(l2 - mx); const float inv = 1.f / (w0 + w1 + w2); w0 *= inv; w1 *= inv; w2 *= inv;
        const size_t off = (size_t)m * AOUT + hg * 64 + c8;
        const u32x4 a = *(const u32x4*)(OG + off), bq = *(const u32x4*)(OG + (size_t)T * AOUT + off), c = *(const u32x4*)(OG + (size_t)2 * T * AOUT + off);
        u32x4 o;
        o.x = cvt_pk_bf16(w0 * bflo(a.x) + w1 * bflo(bq.x) + w2 * bflo(c.x), w0 * bfhi(a.x) + w1 * bfhi(bq.x) + w2 * bfhi(c.x));
        o.y = cvt_pk_bf16(w0 * bflo(a.y) + w1 * bflo(bq.y) + w2 * bflo(c.y), w0 * bfhi(a.y) + w1 * bfhi(bq.y) + w2 * bfhi(c.y));
        o.z = cvt_pk_bf16(w0 * bflo(a.z) + w1 * bflo(bq.z) + w2 * bflo(c.z), w0 * bfhi(a.z) + w1 * bfhi(bq.z) + w2 * bfhi(c.z));
        o.w = cvt_pk_bf16(w0 * bflo(a.w) + w1 * bflo(bq.w) + w2 * bflo(c.w), w0 * bfhi(a.w) + w1 * bfhi(bq.w) + w2 * bfhi(c.w));
        *(u32x4*)(OM + off) = o;
    }
}

__device__ __forceinline__ void p15_ln_route(Frame& F) {
    LAS float* RT = (LAS float*)F.lds;
    LAS int* lcnt = (LAS int*)(F.lds + 32768);
    LAS int* lbase = lcnt + 8;
    LAS int* lte = lcnt + 16;
    LAS int* ltr = lte + 256;
    LAS float* ltw = (LAS float*)(ltr + 256);
    const float* MOD = WSP(float, WS_MOD); const float* g = F.in[4] + 2 * D; const float* bb = F.in[5] + 2 * D;
    const float* X2 = WSP(float, WS_X2); const bf16_t* Y3 = WSP(bf16_t, WS_Y3); float* X3 = F.out; bf16_t* H4 = WSP(bf16_t, WS_H4);
    int* TOKE = (int*)(F.ws + WS_ROUTE + RT_TOKE); int* TOKR = (int*)(F.ws + WS_ROUTE + RT_TOKR); float* TOKW = (float*)(F.ws + WS_ROUTE + RT_TOKW);
    int* ROWTOK = (int*)(F.ws + WS_ROUTE + RT_ROWTOK);
    for (int i = F.tid; i < D * 8; i += 512) RT[i] = F.in[27][i];
    for (int i = F.vcu * 512 + F.tid; i < RMAX; i += F.G * 512) ROWTOK[i] = T;
    if (F.vcu == 0) for (int i = F.tid; i < D / 2; i += 512) ((unsigned*)(H4 + (size_t)T * D))[i] = 0u;
    __syncthreads();
    for (int chunk = F.vcu; chunk < T / 128; chunk += F.G) {
        if (F.tid < 8) lcnt[F.tid] = 0;
        __syncthreads();
        for (int i = 0; i < 16; ++i) {
            const int lr = F.wave * 16 + i, m = chunk * 128 + lr, b = m >> 14;
            const float* gate = MOD + b * ADA_W + (2 * 3 + 2) * D;
            f32x4 v[4];
#pragma unroll
            for (int j = 0; j < 4; ++j) { const int c = 4 * F.lane + 256 * j;
                const u32x2 yw = *(const u32x2*)(Y3 + (size_t)m * D + c); const f32x4 yv = (f32x4){bflo(yw.x), bfhi(yw.x), bflo(yw.y), bfhi(yw.y)};
                v[j] = DN_ALPHA * *(const f32x4*)(X2 + (size_t)m * D + c) + (1.f + *(const f32x4*)(gate + c)) * yv; }
            ln_apply(v, g, bb, F.lane);
#pragma unroll
            for (int j = 0; j < 4; ++j) *(f32x4*)(X3 + (size_t)m * D + 4 * F.lane + 256 * j) = v[j];
            const float* shift = MOD + b * ADA_W + (3 * 3 + 0) * D; const float* scale = MOD + b * ADA_W + (3 * 3 + 1) * D;
            float lg[8];
#pragma unroll
            for (int e = 0; e < 8; ++e) lg[e] = 0.f;
#pragma unroll
            for (int j = 0; j < 4; ++j) { const int c = 4 * F.lane + 256 * j; const f32x4 hh = v[j] * (1.f + *(const f32x4*)(scale + c)) + *(const f32x4*)(shift + c);
                u32x2 wv; wv.x = cvt_pk_bf16(hh[0], hh[1]); wv.y = cvt_pk_bf16(hh[2], hh[3]); *(u32x2*)(H4 + (size_t)m * D + c) = wv;
#pragma unroll
                for (int q = 0; q < 4; ++q) { const f32x4 r0 = *(const LAS f32x4*)(RT + (c + q) * 8), r1 = *(const LAS f32x4*)(RT + (c + q) * 8 + 4);
                    lg[0] += hh[q] * r0[0]; lg[1] += hh[q] * r0[1]; lg[2] += hh[q] * r0[2]; lg[3] += hh[q] * r0[3];
                    lg[4] += hh[q] * r1[0]; lg[5] += hh[q] * r1[1]; lg[6] += hh[q] * r1[2]; lg[7] += hh[q] * r1[3]; } }
#pragma unroll
            for (int e = 0; e < 8; ++e) lg[e] = wave_sum(lg[e]);
            int e1 = 0; float m1 = lg[0];
#pragma unroll
            for (int e = 1; e < 8; ++e) if (lg[e] > m1) { m1 = lg[e]; e1 = e; }
            int e2 = -1; float m2 = -3.0e38f;
#pragma unroll
            for (int e = 0; e < 8; ++e) if (e != e1 && lg[e] > m2) { m2 = lg[e]; e2 = e; }
            if (e2 < 0) { e2 = (e1 + 1) & 7; m2 = m1; }
            if (F.lane == 0) {
                const float w1 = 1.f / (1.f + __expf(m2 - m1));
                lte[lr * 2] = e1; lte[lr * 2 + 1] = e2; ltw[lr * 2] = w1; ltw[lr * 2 + 1] = 1.f - w1;
                ltr[lr * 2] = atomicAdd((int*)&lcnt[e1], 1); ltr[lr * 2 + 1] = atomicAdd((int*)&lcnt[e2], 1);
            }
        }
        __syncthreads();
        if (F.tid < 8) lbase[F.tid] = (int)__hip_atomic_fetch_add((unsigned*)(F.ctl + CW_CNT + F.tid), (unsigned)lcnt[F.tid], RLX_AGENT);
        __syncthreads();
        if (F.tid < 256) { const int m = chunk * 128 + (F.tid >> 1), s = F.tid & 1; const int e = lte[F.tid];
            TOKE[m * 2 + s] = e; TOKR[m * 2 + s] = lbase[e] + ltr[F.tid]; TOKW[m * 2 + s] = ltw[F.tid]; }
        __syncthreads();
    }
}
__device__ __forceinline__ void p16_place(Frame& F) {
    int* TOKE = (int*)(F.ws + WS_ROUTE + RT_TOKE); int* TOKR = (int*)(F.ws + WS_ROUTE + RT_TOKR);
    int* ROWTOK = (int*)(F.ws + WS_ROUTE + RT_ROWTOK); int* BLKEXP = (int*)(F.ws + WS_ROUTE + RT_BLKEXP);
    int pstart[8], pend[8]; int acc = 0;
#pragma unroll
    for (int e = 0; e < 8; ++e) { const int c = (int)__hip_atomic_load((unsigned*)(F.ctl + CW_CNT + e), RLX_AGENT); pstart[e] = acc; acc += (c + 255) / 256 * 256; pend[e] = acc; }
    for (int idx = F.vcu * 512 + F.tid; idx < T * 2; idx += F.G * 512) {
        const int e = TOKE[idx]; int ps = 0;
#pragma unroll
        for (int j = 0; j < 8; ++j) ps = (e == j) ? pstart[j] : ps;
        const int dest = ps + TOKR[idx]; ROWTOK[dest] = idx >> 1; TOKR[idx] = dest;
    }
    if (F.vcu == 0) {
        for (int blk = F.tid; blk < NBLKMAX; blk += 512) { int e = 0;
#pragma unroll
            for (int j = 0; j < 8; ++j) e += (pend[j] <= blk * 256) ? 1 : 0;
            BLKEXP[blk] = e < 8 ? e : 7; }
        if (F.tid == 0) __hip_atomic_store((unsigned*)(F.ctl + CW_NBLK), (unsigned)(acc / 256), RLX_AGENT);
    }
}
__device__ __forceinline__ void p19_final(Frame& F) {
    const int gw = F.vcu * NWAVES + F.wave, NGW = F.G * NWAVES;
    const float* MOD = WSP(float, WS_MOD); const float* g = F.in[4] + 3 * D; const float* bb = F.in[5] + 3 * D;
    const bf16_t* YB = WSP(bf16_t, WS_YB); const int* TOKR = (const int*)(F.ws + WS_ROUTE + RT_TOKR); const float* TOKW = (const float*)(F.ws + WS_ROUTE + RT_TOKW);
    float* X = F.out;
    for (int m = gw; m < T; m += NGW) {
        const int b = m >> 14; const float* gate = MOD + b * ADA_W + (3 * 3 + 2) * D;
        const int d0 = TOKR[m * 2], d1 = TOKR[m * 2 + 1]; const float w0 = TOKW[m * 2], w1 = TOKW[m * 2 + 1];
        f32x4 v[4];
#pragma unroll
        for (int j = 0; j < 4; ++j) { const int c = 4 * F.lane + 256 * j;
            const u32x2 a = *(const u32x2*)(YB + (size_t)d0 * D + c), q = *(const u32x2*)(YB + (size_t)d1 * D + c);
            const f32x4 y = (f32x4){w0 * bflo(a.x) + w1 * bflo(q.x), w0 * bfhi(a.x) + w1 * bfhi(q.x), w0 * bflo(a.y) + w1 * bflo(q.y), w0 * bfhi(a.y) + w1 * bfhi(q.y)};
            v[j] = DN_ALPHA * *(const f32x4*)(X + (size_t)m * D + c) + (1.f + *(const f32x4*)(gate + c)) * y; }
        ln_apply(v, g, bb, F.lane);
#pragma unroll
        for (int j = 0; j < 4; ++j) *(f32x4*)(X + (size_t)m * D + 4 * F.lane + 256 * j) = v[j];
    }
}

struct Args { const float* in[30]; float* out; unsigned char* ws; int ph_lo, ph_hi, li, pad; };
__global__ void __launch_bounds__(NWAVES * 64, 2) fwd(Args args) {
    extern __shared__ __attribute__((aligned(16))) unsigned char lds[];
    Frame F;
    F.lds = (LAS unsigned char*)lds;
    F.MISC = (volatile LAS unsigned*)(F.lds + MISC_OFF);
    F.tid = threadIdx.x; F.lane = F.tid & 63; F.wave = __builtin_amdgcn_readfirstlane(F.tid >> 6);
    F.G = gridDim.x; { const int bx = blockIdx.x; F.vcu = (F.G % 8 == 0) ? (bx % 8) * (F.G / 8) + bx / 8 : bx; }
    F.ws = args.ws; F.ctl = (gu32*)(args.ws + WS_CTL); F.out = args.out;
    F.in = args.in;
    for (int u = F.tid; u < (LDS_BYTES - LDSCTL_OFF) / 4; u += NWAVES * 64) ((LAS unsigned*)(F.lds + LDSCTL_OFF))[u] = 0u;
    __syncthreads();
    XcdBarrier bar; bar.bar = (unsigned*)(F.ctl + CW_BAR); bar.x = 0; bar.st = nullptr;
    if (N_LAUNCHES != NPH) bar = xcd_barrier_post((unsigned*)(F.ctl + CW_BAR) + args.li * XCD_BAR_WORDS, F.MISC + 8);
#define GRID_BAR() do { if (N_LAUNCHES != NPH) xcd_barrier(bar); } while (0)
    const int lo = args.ph_lo, hi = args.ph_hi;
#define IN(k) (lo <= (k) && (k) < hi)
#define BOTH(k) (IN(k) && IN((k) + 1))
    using namespace pg8;
    const int cid = (int)blockIdx.x;

    if (IN(0)) { p0_prologue(F); if (BOTH(0)) GRID_BAR(); }
    if (IN(1)) { p1_lerp(F); if (BOTH(1)) GRID_BAR(); }
    if (IN(2)) {
        Gemm g{WSP(bf16_t, WS_A6) + (size_t)3 * T * D, WSP(bf16_t, WS_WL1), D, D, (size_t)T * D * 2, (size_t)256 * D * 2, nullptr, nullptr, 0};
        StaticOrder S; S.init(T / 256, 1, 3, F.G, cid);
        EpiBf16Z<1, 0, 2> E{WSP(bf16_t, WS_L1), 256, (size_t)T * 256};
        gemm_phase<EpiBf16Z<1, 0, 2>, StaticOrder, true>(F.lds, g, S, E);
        if (BOTH(2)) GRID_BAR();
    }
    if (IN(3)) {
        { Gemm g{WSP(bf16_t, WS_A6), WSP(bf16_t, WS_WRKV), D, D, (size_t)T * D * 2, (size_t)D * D * 2, nullptr, nullptr, 0};
          StaticOrder S; S.init(T / 256, D / 256, 3, F.G, cid);
          EpiBf16Z<0, 0, 0> E{WSP(bf16_t, WS_RB), D, (size_t)T * D};
          gemm_phase<EpiBf16Z<0, 0, 0>, StaticOrder, true>(F.lds, g, S, E); }
        { Gemm g{WSP(bf16_t, WS_L1), WSP(bf16_t, WS_WL2), 256, 256, (size_t)T * 256 * 2, (size_t)D * 256 * 2, nullptr, nullptr, 0};
          StaticOrder S; S.init(T / 256, D / 256, 3, F.G, cid);
          EpiLora2 E{F.out, WSP(bf16_t, WS_AS), WSP(bf16_t, WS_G), F.in[8], F.in[11]};
          gemm_phase<EpiLora2, StaticOrder, true>(F.lds, g, S, E); }
        if (BOTH(3)) GRID_BAR();
    }
    if (IN(4)) { p4a_chunk(F); GRID_BAR(); p4b_chain(F); if (BOTH(4)) GRID_BAR(); }
    if (IN(5)) { p5_chunk_out(F); if (BOTH(5)) GRID_BAR(); }
    if (IN(6)) {
        Gemm g{WSP(bf16_t, WS_YG), WSP(bf16_t, WS_WOUT), D, D, 0, 0, nullptr, nullptr, 0};
        StaticOrder S; S.init(T / 256, D / 256, 1, F.G, cid);
        EpiBf16Z<0, 0, 0> E{WSP(bf16_t, WS_Y1), D, 0};
        gemm_phase<EpiBf16Z<0, 0, 0>, StaticOrder, true>(F.lds, g, S, E);
        if (BOTH(6)) GRID_BAR();
    }
    if (IN(7)) { p_postnorm(F, F.in[0], WSP(bf16_t, WS_Y1), WSP(float, WS_X1), 0, (1 * 3 + 0) * D, WSP(bf16_t, WS_H2), 0, nullptr); if (BOTH(7)) GRID_BAR(); }
    if (IN(8)) {
        Gemm g{WSP(bf16_t, WS_H2), WSP(bf16_t, WS_WFGU), D, D, 0, 0, nullptr, nullptr, 0};
        StaticOrder S; S.init(T / 256, 2 * DFF / 256, 1, F.G, cid);
        EpiSwiglu E{WSP(bf16_t, WS_ACT), DFF};
        gemm_phase<EpiSwiglu, StaticOrder, true>(F.lds, g, S, E);
        if (BOTH(8)) GRID_BAR();
    }
    if (IN(9)) {
        Gemm g{WSP(bf16_t, WS_ACT), WSP(bf16_t, WS_WFDN), DFF, DFF, 0, 0, nullptr, nullptr, 0};
        StaticOrder S; S.init(T / 256, D / 256, 1, F.G, cid);
        EpiBf16Z<0, 0, 0> E{WSP(bf16_t, WS_Y2), D, 0};
        gemm_phase<EpiBf16Z<0, 0, 0>, StaticOrder, true>(F.lds, g, S, E);
        if (BOTH(9)) GRID_BAR();
    }
    if (IN(10)) { p_postnorm(F, WSP(float, WS_X1), WSP(bf16_t, WS_Y2), WSP(float, WS_X2), 1, 12 * D, WSP(bf16_t, WS_HKV), (2 * 3 + 0) * D, WSP(bf16_t, WS_H3)); if (BOTH(10)) GRID_BAR(); }
    if (IN(11)) {
        const float* cs = WSP(float, WS_ROPE); const float* sn = cs + SEQ * 32;
        { Gemm g{WSP(bf16_t, WS_HKV), WSP(bf16_t, WS_WKV), D, D, 0, 0, nullptr, nullptr, 0};
          StaticOrder S; S.init(T / 256, 2 * QW / 256, 1, F.G, cid);
          EpiRope E{WSP(bf16_t, WS_K2), WSP(bf16_t, WS_V2), QW, cs, sn, 1.f};
          gemm_phase<EpiRope, StaticOrder, true>(F.lds, g, S, E); }
        { Gemm g{WSP(bf16_t, WS_H3), WSP(bf16_t, WS_WQ), D, D, 0, 0, nullptr, nullptr, 0};
          StaticOrder S; S.init(T / 256, QW / 256, 1, F.G, cid);
          EpiRope E{WSP(bf16_t, WS_Q2), WSP(bf16_t, WS_Q2), QW, cs, sn, 0.125f};
          gemm_phase<EpiRope, StaticOrder, true>(F.lds, g, S, E); }
        if (BOTH(11)) GRID_BAR();
    }
    if (IN(12)) { p12_attn(F); if (BOTH(12)) GRID_BAR(); }
    if (IN(13)) { p13_merge(F); if (BOTH(13)) GRID_BAR(); }
    if (IN(14)) {
        Gemm g{WSP(bf16_t, WS_OM), WSP(bf16_t, WS_WO), AOUT, AOUT, 0, 0, nullptr, nullptr, 0};
        StaticOrder S; S.init(T / 256, D / 256, 1, F.G, cid);
        EpiBf16Z<0, 0, 0> E{WSP(bf16_t, WS_Y3), D, 0};
        gemm_phase<EpiBf16Z<0, 0, 0>, StaticOrder, true>(F.lds, g, S, E);
        if (BOTH(14)) GRID_BAR();
    }
    if (IN(15)) { p15_ln_route(F); if (BOTH(15)) GRID_BAR(); }
    if (IN(16)) { p16_place(F); if (BOTH(16)) GRID_BAR(); }
    if (IN(17)) {
        const int nblk = (int)__hip_atomic_load((unsigned*)(F.ctl + CW_NBLK), RLX_AGENT);
        Gemm g{WSP(bf16_t, WS_H4), WSP(bf16_t, WS_WMGU), D, D, 0, 0, (const int*)(F.ws + WS_ROUTE + RT_ROWTOK), (const int*)(F.ws + WS_ROUTE + RT_BLKEXP), (size_t)2 * DFE * D * 2};
        StaticOrder S; S.init(nblk, 2 * DFE / 256, 1, F.G, cid);
        EpiSwiglu E{WSP(bf16_t, WS_ACT2), DFE};
        gemm_phase<EpiSwiglu, StaticOrder, true>(F.lds, g, S, E);
        if (BOTH(17)) GRID_BAR();
    }
    if (IN(18)) {
        const int nblk = (int)__hip_atomic_load((unsigned*)(F.ctl + CW_NBLK), RLX_AGENT);
        Gemm g{WSP(bf16_t, WS_ACT2), WSP(bf16_t, WS_WMDN), DFE, DFE, 0, 0, nullptr, (const int*)(F.ws + WS_ROUTE + RT_BLKEXP), (size_t)D * DFE * 2};
        StaticOrder S; S.init(nblk, D / 256, 1, F.G, cid);
        EpiBf16Z<0, 0, 0> E{WSP(bf16_t, WS_YB), D, 0};
        gemm_phase<EpiBf16Z<0, 0, 0>, StaticOrder, true>(F.lds, g, S, E);
        if (BOTH(18)) GRID_BAR();
    }
    if (IN(19)) { p19_final(F); }
#undef IN
#undef BOTH
}

extern "C" void kernel_launch(void* const* d_in, const int* in_sizes, int n_in, void* d_out, int out_size, void* d_ws, size_t ws_size, hipStream_t stream) {
    static int grid = 0;
    if (grid == 0) {
        if (n_in != 30 || in_sizes[0] != T * D || out_size != T * D || ws_size < WS_END) { fprintf(stderr, "kernel_launch: unexpected shapes / workspace (%d inputs, ws %zu)\n", n_in, ws_size); grid = -1; return; }
        int dev = 0, cus = 0, per_cu = 0;
        if (hipGetDevice(&dev) != hipSuccess || hipDeviceGetAttribute(&cus, hipDeviceAttributeMultiprocessorCount, dev) != hipSuccess) { grid = -1; return; }
        if (hipFuncSetAttribute((const void*)fwd, hipFuncAttributeMaxDynamicSharedMemorySize, LDS_BYTES) != hipSuccess) { fprintf(stderr, "kernel_launch: hipFuncSetAttribute failed\n"); grid = -1; return; }
        if (hipOccupancyMaxActiveBlocksPerMultiprocessor(&per_cu, (const void*)fwd, NWAVES * 64, LDS_BYTES) != hipSuccess || per_cu < 1)
            fprintf(stderr, "kernel_launch: occupancy query reports %d workgroups per CU\n", per_cu);
        (void)hipGetLastError();
        grid = cus;
    }
    if (grid < 0) return;
    if (hipMemsetAsync((char*)d_ws + WS_CTL, 0, CTL_ZERO_BYTES, stream) != hipSuccess) return;
    Args a{};
    for (int i = 0; i < 30; ++i) a.in[i] = (const float*)d_in[i];
    a.out = (float*)d_out; a.ws = (unsigned char*)d_ws;
    for (int li = 0; li < N_LAUNCHES; ++li) {
        a.ph_lo = (N_LAUNCHES == NPH) ? li : 0; a.ph_hi = (N_LAUNCHES == NPH) ? li + 1 : NPH; a.li = (N_LAUNCHES == NPH) ? 0 : li;
        hipLaunchKernelGGL(fwd, dim3(grid), dim3(NWAVES * 64), LDS_BYTES, stream, a);
        if (hipPeekAtLastError() != hipSuccess) { fprintf(stderr, "kernel_launch: launch %d failed\n", li); break; }
    }
}
```

```cpp
#include <hip/hip_runtime.h>
#include <cstdio>
#include <cstdint>

#define LAS __attribute__((address_space(3)))
#define GAS __attribute__((address_space(1)))
typedef unsigned short bf16_t;
typedef short bf16x8 __attribute__((ext_vector_type(8)));
typedef short s16x4 __attribute__((ext_vector_type(4)));
typedef float f32x4 __attribute__((ext_vector_type(4)));
typedef float f32x2 __attribute__((ext_vector_type(2)));
typedef unsigned u32x4 __attribute__((ext_vector_type(4)));
typedef unsigned u32x2 __attribute__((ext_vector_type(2)));
typedef GAS unsigned gu32;
#define RLX_AGENT __ATOMIC_RELAXED, __HIP_MEMORY_SCOPE_AGENT

typedef __bf16 bf16x2_t __attribute__((ext_vector_type(2)));
__device__ __forceinline__ unsigned cvt_pk_bf16(float lo, float hi) { const f32x2 v = {lo, hi}; const bf16x2_t b = __builtin_convertvector(v, bf16x2_t); return __builtin_bit_cast(unsigned, b); }
typedef int i32x4 __attribute__((ext_vector_type(4)));
__device__ __forceinline__ unsigned q8u(float x) { return (unsigned)(int)fminf(fmaxf(rintf(x), -127.f), 127.f) & 0xffu; }
__device__ __forceinline__ unsigned pk4_i8(float a, float b, float c, float d) { return q8u(a) | (q8u(b) << 8) | (q8u(c) << 16) | (q8u(d) << 24); }
constexpr float QW_STEP = 6.0f / (32.0f * 127.0f), QW_INV = 1.0f / QW_STEP;
__device__ __forceinline__ float bflo(unsigned w) { return __uint_as_float(w << 16); }
__device__ __forceinline__ float bfhi(unsigned w) { return __uint_as_float(w & 0xffff0000u); }
__device__ __forceinline__ float sigmoidf_(float x) { return 1.f / (1.f + __expf(-x)); }
__device__ __forceinline__ float tanhf_(float x) { return 1.f - 2.f / (1.f + __expf(2.f * x)); }
__device__ __forceinline__ float siluf_(float x) { return x / (1.f + __expf(-x)); }
__device__ __forceinline__ int ld_i32(const int* p) { return (int)__hip_atomic_load((const unsigned*)p, RLX_AGENT); }

constexpr int BATCH = 2, SEQ = 16384, D = 1024, T = BATCH * SEQ;
constexpr int ADA_W = 14336;
constexpr int DFF = 2816, NEXP = 8, DFE = 3584;
constexpr int QW = 1536, AOUT = 512;
constexpr int RMAX = (T * 2 / 256 + NEXP) * 256;
constexpr int NBLKMAX = RMAX / 256;
constexpr float LN_EPS = 1e-5f, LNX_EPS = 64e-5f;
constexpr float DN_ALPHA = 1.4142135623730951f;

namespace pg8 {
constexpr int BM = 256, BK = 64, HALF = 128, HTB = HALF * BK * 2, STAGE_BYTES = 8 * HTB, NXCD = 8, WGM = 8;
__host__ __device__ __forceinline__ int lds_byte(int r, int c) { const int st = (r >> 4) * 2 + (c >> 5), rr = r & 15, cc = c & 31, ob = rr * 64 + cc * 2; return st * 1024 + (ob ^ (((ob >> 9) & 1) << 5)); }
__host__ __device__ __forceinline__ void stage_rc(int b, int& R, int& C) { const int st = b / 1024, sb = b % 1024, swz = sb ^ (((sb >> 9) & 1) << 5); R = (st >> 1) * 16 + swz / 64; C = (st & 1) * 32 + (swz % 64) / 2; }
__host__ __device__ __forceinline__ int perm32(int rho) { const int n = rho >> 4, i = rho & 15; return 8 * (i >> 2) + 4 * n + (i & 3); }

struct Unit { int pm, pn, z; };
struct Gemm { const bf16_t* A; const bf16_t* Bt; int K, lda; size_t azs, bzs; const int* rowmap; const int* blk_exp; size_t bes; };

struct StaticOrder {
    int nM, nN, nZ, nwg, G, c;
    __device__ void init(int nM_, int nN_, int nZ_, int G_, int c_) { nM = nM_; nN = nN_; nZ = nZ_; nwg = nM * nN; G = G_; c = c_; }
    __device__ bool next(int i, Unit& u) const {
        const long L = (long)i * G + c; if (L >= (long)nwg * nZ) return false;
        u.z = (int)(L / nwg); int wgid = (int)(L % nwg);
        { const int q = nwg / NXCD, r = nwg % NXCD, xcd = wgid % NXCD, off = wgid / NXCD; wgid = (xcd < r ? xcd * (q + 1) : r * (q + 1) + (xcd - r) * q) + off; }
        const int nig = WGM * nN, gid = wgid / nig, fm = gid * WGM, gsz = (nM - fm) < WGM ? (nM - fm) : WGM;
        u.pm = fm + ((wgid % nig) % gsz); u.pn = (wgid % nig) / gsz; return true;
    }
};

#define EPI_LOOP_BEGIN \
    const int row0 = u.pm * BM + wr * 64 + fr, col0 = u.pn * BM + wc * 32 + 8 * fq; \
    _Pragma("unroll") for (int ai = 0; ai < 2; ++ai) _Pragma("unroll") for (int m = 0; m < 4; ++m) { const int row = row0 + ai * HALF + m * 16; \
    _Pragma("unroll") for (int bj = 0; bj < 2; ++bj) { const int col = col0 + bj * HALF; f32x4 v0 = acc[ai][bj][m][0], v1 = acc[ai][bj][m][1];
#define EPI_LOOP_END } }

__device__ __forceinline__ float act_apply(int a, float x) { return a == 1 ? tanhf_(x) : (a == 2 ? sigmoidf_(x) : x); }
template <int ACT0, int ACT1, int ACT2> struct EpiBf16Z {
    static constexpr bool PERM = true;
    bf16_t* O; int ldc; size_t ozs;
    __device__ __forceinline__ void operator()(const f32x4 (&acc)[2][2][4][2], const Unit& u, int wr, int wc, int fr, int fq) const {
        const int a = u.z == 0 ? ACT0 : (u.z == 1 ? ACT1 : ACT2); bf16_t* base = O + (size_t)u.z * ozs;
        EPI_LOOP_BEGIN
            if (a) { _Pragma("unroll") for (int e = 0; e < 4; ++e) { v0[e] = act_apply(a, v0[e]); v1[e] = act_apply(a, v1[e]); } }
            u32x4 w; w.x = cvt_pk_bf16(v0[0], v0[1]); w.y = cvt_pk_bf16(v0[2], v0[3]); w.z = cvt_pk_bf16(v1[0], v1[1]); w.w = cvt_pk_bf16(v1[2], v1[3]);
            *(u32x4*)(base + (size_t)row * ldc + col) = w;
        EPI_LOOP_END
    }
};
struct EpiLora2 {
    static constexpr bool PERM = true;
    float* WLOG; bf16_t* AS; bf16_t* G; const float* w0; const float* a0;
    __device__ __forceinline__ void operator()(const f32x4 (&acc)[2][2][4][2], const Unit& u, int wr, int wc, int fr, int fq) const {
        EPI_LOOP_BEGIN
            if (u.z == 0) {
                const f32x4 b0 = *(const f32x4*)(w0 + col), b1 = *(const f32x4*)(w0 + col + 4);
                _Pragma("unroll") for (int e = 0; e < 4; ++e) {
                    float x = -(v0[e] + b0[e]); float sp = fmaxf(x, 0.f) + __logf(1.f + __expf(-fabsf(x))); v0[e] = -__expf(-sp - 0.5f);
                    x = -(v1[e] + b1[e]); sp = fmaxf(x, 0.f) + __logf(1.f + __expf(-fabsf(x))); v1[e] = -__expf(-sp - 0.5f); }
                float* p = WLOG + (size_t)row * D + col; *(f32x4*)p = v0; *(f32x4*)(p + 4) = v1;
            } else {
                if (u.z == 1) { const f32x4 b0 = *(const f32x4*)(a0 + col), b1 = *(const f32x4*)(a0 + col + 4);
                    _Pragma("unroll") for (int e = 0; e < 4; ++e) { v0[e] = sigmoidf_(v0[e] + b0[e]); v1[e] = sigmoidf_(v1[e] + b1[e]); } }
                u32x4 w; w.x = cvt_pk_bf16(v0[0], v0[1]); w.y = cvt_pk_bf16(v0[2], v0[3]); w.z = cvt_pk_bf16(v1[0], v1[1]); w.w = cvt_pk_bf16(v1[2], v1[3]);
                *(u32x4*)((u.z == 1 ? AS : G) + (size_t)row * D + col) = w;
            }
        EPI_LOOP_END
    }
};
struct EpiF32 {
    static constexpr bool PERM = true;
    float* O; int ldc;
    __device__ __forceinline__ void operator()(const f32x4 (&acc)[2][2][4][2], const Unit& u, int wr, int wc, int fr, int fq) const {
        EPI_LOOP_BEGIN
            float* p = O + (size_t)row * ldc + col; *(f32x4*)p = v0; *(f32x4*)(p + 4) = v1;
        EPI_LOOP_END
    }
};
struct EpiSwiglu {
    static constexpr bool PERM = true;
    bf16_t* O; int ldo;
    __device__ __forceinline__ void operator()(const f32x4 (&acc)[2][2][4][2], const Unit& u, int wr, int wc, int fr, int fq) const {
        EPI_LOOP_BEGIN
            u32x2 w; w.x = cvt_pk_bf16(siluf_(v0[0]) * v0[1], siluf_(v0[2]) * v0[3]); w.y = cvt_pk_bf16(siluf_(v1[0]) * v1[1], siluf_(v1[2]) * v1[3]);
            *(u32x2*)(O + (size_t)row * ldo + (col >> 1)) = w;
        EPI_LOOP_END
    }
};
struct EpiSwigluQ {
    static constexpr bool PERM = true;
    bf16_t* O; int ldo; const float* rs; const int* rowmap; float ws;
    __device__ __forceinline__ void operator()(const f32x4 (&acc)[2][2][4][2], const Unit& u, int wr, int wc, int fr, int fq) const {
        const int row0 = u.pm * BM + wr * 64 + fr, col0 = u.pn * BM + wc * 32 + 8 * fq;
#pragma unroll
        for (int ai = 0; ai < 2; ++ai)
#pragma unroll
            for (int m = 0; m < 4; ++m) { const int row = row0 + ai * HALF + m * 16; const float sc = rs[rowmap ? rowmap[row] : row] * ws;
#pragma unroll
                for (int bj = 0; bj < 2; ++bj) { const int col = col0 + bj * HALF; const f32x4 v0 = acc[ai][bj][m][0] * sc, v1 = acc[ai][bj][m][1] * sc;
                    u32x2 w; w.x = cvt_pk_bf16(siluf_(v0[0]) * v0[1], siluf_(v0[2]) * v0[3]); w.y = cvt_pk_bf16(siluf_(v1[0]) * v1[1], siluf_(v1[2]) * v1[3]);
                    *(u32x2*)(O + (size_t)row * ldo + (col >> 1)) = w; } }
    }
};
struct EpiRope {
    static constexpr bool PERM = true;
    bf16_t* O; bf16_t* O2; int ncol_rope; const float* cs; const float* sn; float scale;
    __device__ __forceinline__ void operator()(const f32x4 (&acc)[2][2][4][2], const Unit& u, int wr, int wc, int fr, int fq) const {
        EPI_LOOP_BEGIN
            bf16_t* dst;
            if (col < ncol_rope) {
                const int t = row & (SEQ - 1), i0 = (col & 63) >> 1;
                const f32x4 c4 = *(const f32x4*)(cs + (size_t)t * 32 + i0), s4 = *(const f32x4*)(sn + (size_t)t * 32 + i0);
                float a, b;
                a = v0[0]; b = v0[1]; v0[0] = (a * c4[0] - b * s4[0]) * scale; v0[1] = (b * c4[0] + a * s4[0]) * scale;
                a = v0[2]; b = v0[3]; v0[2] = (a * c4[1] - b * s4[1]) * scale; v0[3] = (b * c4[1] + a * s4[1]) * scale;
                a = v1[0]; b = v1[1]; v1[0] = (a * c4[2] - b * s4[2]) * scale; v1[1] = (b * c4[2] + a * s4[2]) * scale;
                a = v1[2]; b = v1[3]; v1[2] = (a * c4[3] - b * s4[3]) * scale; v1[3] = (b * c4[3] + a * s4[3]) * scale;
                dst = O + (size_t)row * ncol_rope + col;
            } else dst = O2 + (size_t)row * ncol_rope + (col - ncol_rope);
            u32x4 w; w.x = cvt_pk_bf16(v0[0], v0[1]); w.y = cvt_pk_bf16(v0[2], v0[3]); w.z = cvt_pk_bf16(v1[0], v1[1]); w.w = cvt_pk_bf16(v1[2], v1[3]);
            *(u32x4*)dst = w;
        EPI_LOOP_END
    }
};

template <class Epi, class Sched, bool ALIGN_EPI, int MODE = 0>
__device__ __forceinline__ void gemm_phase(LAS unsigned char* lds, const Gemm g, const Sched& S, const Epi& E) {
    const int tid = threadIdx.x, wid = __builtin_amdgcn_readfirstlane(tid >> 6), lane = tid & 63, wr = wid >> 2, wc = wid & 3, fr = lane & 15, fq = lane >> 4;
    const int K = g.K, nt = K / BK;
    int RA[2], CA[2]; unsigned voffB[2];
#pragma unroll
    for (int i = 0; i < 2; ++i) { int R, C; stage_rc(tid * 16 + i * 8192, R, C); const int Rb = Epi::PERM ? ((R & ~31) + perm32(R & 31)) : R;
        RA[i] = R; CA[i] = C; voffB[i] = (unsigned)(Rb * K + C) * 2u; }
    const size_t kstep = (size_t)(BK * 2);
    const size_t hstepB = (size_t)HALF * K * 2, tstepB = 2 * hstepB;
    const unsigned ldsw = (unsigned)wid * 1024u;
    const int aoff = lds_byte(wr * 64 + fr, fq * 8), boff = lds_byte(wc * 32 + fr, fq * 8);
#define PG8_SA(b, h) (((b) * 2 + (h)) * HTB)
#define PG8_SB(b, h) ((4 + (b) * 2 + (h)) * HTB)
#define PG8_STAGE(bufoff, gbase, voff) do { _Pragma("unroll") for (int _i = 0; _i < 2; ++_i) \
        __builtin_amdgcn_global_load_lds((const unsigned*)((const char*)(gbase) + (voff)[_i]), (LAS unsigned*)(lds + (bufoff) + ldsw + _i * 8192), 16, 0, 0); } while (0)
#define PG8_VOFFA(v, uu) do { _Pragma("unroll") for (int _h = 0; _h < 2; ++_h) _Pragma("unroll") for (int _i = 0; _i < 2; ++_i) { int _row = (uu).pm * BM + _h * HALF + RA[_i]; \
        if (g.rowmap) _row = g.rowmap[_row]; (v)[_h][_i] = (unsigned)((size_t)(uu).z * g.azs) + (unsigned)(_row * g.lda + CA[_i]) * 2u; } } while (0)
#define PG8_BBASE(uu) ((const char*)g.Bt + (size_t)(uu).z * g.bzs + (g.blk_exp ? (size_t)ld_i32(g.blk_exp + (uu).pm) * g.bes : (size_t)0) + (size_t)(uu).pn * tstepB)
#define PG8_LDA(dst, b, h) do { _Pragma("unroll") for (int m = 0; m < 4; ++m) _Pragma("unroll") for (int k = 0; k < 2; ++k) dst[m][k] = *(const LAS bf16x8*)(lds + PG8_SA(b, h) + aoff + m * 2048 + k * 1024); } while (0)
#define PG8_LDB(dst, b, h) do { _Pragma("unroll") for (int n = 0; n < 2; ++n) _Pragma("unroll") for (int k = 0; k < 2; ++k) dst[n][k] = *(const LAS bf16x8*)(lds + PG8_SB(b, h) + boff + n * 2048 + k * 1024); } while (0)
#define PG8_MMA(ai, bj, At, Bt) do { __builtin_amdgcn_s_setprio(1); _Pragma("unroll") for (int m = 0; m < 4; ++m) _Pragma("unroll") for (int n = 0; n < 2; ++n) _Pragma("unroll") for (int k = 0; k < 2; ++k) { \
        if constexpr (MODE == 1) acc[ai][bj][m][n] = __builtin_bit_cast(f32x4, __builtin_amdgcn_mfma_i32_16x16x64_i8(__builtin_bit_cast(i32x4, Bt[n][k]), __builtin_bit_cast(i32x4, At[m][k]), __builtin_bit_cast(i32x4, acc[ai][bj][m][n]), 0, 0, 0)); \
        else acc[ai][bj][m][n] = __builtin_amdgcn_mfma_f32_16x16x32_bf16(Bt[n][k], At[m][k], acc[ai][bj][m][n], 0, 0, 0); } __builtin_amdgcn_s_setprio(0); } while (0)
#define PG8_WAIT_V(n) asm volatile("s_waitcnt vmcnt(" #n ")" ::: "memory")
#define PG8_WAIT_L(n) asm volatile("s_waitcnt lgkmcnt(" #n ")" ::: "memory")
#define PG8_BAR __builtin_amdgcn_s_barrier()
#define PG8_SCHED __builtin_amdgcn_sched_barrier(0)
    Unit cur, nxt; int ui = 0;
    if (!S.next(0, cur)) return;
    f32x4 acc[2][2][4][2];
#pragma unroll
    for (int a = 0; a < 2; ++a)
#pragma unroll
        for (int b = 0; b < 2; ++b)
#pragma unroll
            for (int m = 0; m < 4; ++m)
#pragma unroll
                for (int n = 0; n < 2; ++n) acc[a][b][m][n] = (f32x4){0.f, 0.f, 0.f, 0.f};
    bf16x8 At[4][2], B0[2][2], B1[2][2];
    unsigned vc[2][2], vn[2][2];
    const char* const Ab = (const char*)g.A;
    const char* cB = PG8_BBASE(cur);
    PG8_VOFFA(vc, cur);
    PG8_STAGE(PG8_SB(0, 0), cB, voffB); PG8_STAGE(PG8_SB(0, 1), cB + hstepB, voffB); PG8_STAGE(PG8_SA(0, 0), Ab, vc[0]); PG8_STAGE(PG8_SA(0, 1), Ab, vc[1]);
    if (wr == 1) PG8_BAR;
    PG8_WAIT_V(2); PG8_BAR;
    PG8_STAGE(PG8_SB(1, 0), cB + kstep, voffB); PG8_STAGE(PG8_SA(1, 0), Ab + kstep, vc[0]); PG8_STAGE(PG8_SB(1, 1), cB + hstepB + kstep, voffB);
    PG8_WAIT_V(6); PG8_BAR;
    for (;;) {
        const bool has_next = S.next(ui + 1, nxt);
        const char* nB = cB;
        if (has_next) { nB = PG8_BBASE(nxt); PG8_VOFFA(vn, nxt); }
        else {
#pragma unroll
            for (int h = 0; h < 2; ++h)
#pragma unroll
                for (int i = 0; i < 2; ++i) vn[h][i] = vc[h][i];
        }
        for (int t = 0; t < nt; t += 2) {
            const bool last = (t == nt - 2);
            const char* a1 = Ab + (size_t)(t + 1) * kstep;
            const char* a2 = last ? Ab : Ab + (size_t)(t + 2) * kstep; const char* b2 = last ? nB : cB + (size_t)(t + 2) * kstep;
            const char* a3 = a2 + kstep; const char* b3 = b2 + kstep;
            unsigned v2[2][2];
#pragma unroll
            for (int h = 0; h < 2; ++h)
#pragma unroll
                for (int i = 0; i < 2; ++i) v2[h][i] = last ? vn[h][i] : vc[h][i];
            PG8_LDB(B0, 0, 0); PG8_LDB(B1, 0, 1); PG8_SCHED; PG8_LDA(At, 0, 0); PG8_STAGE(PG8_SA(1, 1), a1, vc[1]);
            PG8_WAIT_V(8); PG8_WAIT_L(0); PG8_BAR; PG8_MMA(0, 0, At, B0); PG8_MMA(0, 1, At, B1); PG8_BAR; PG8_SCHED;
            PG8_LDA(At, 0, 1); PG8_STAGE(PG8_SB(0, 0), b2, voffB); PG8_STAGE(PG8_SB(0, 1), b2 + hstepB, voffB); PG8_STAGE(PG8_SA(0, 0), a2, v2[0]);
            PG8_WAIT_V(8); PG8_WAIT_L(0); PG8_BAR; PG8_MMA(1, 0, At, B0); PG8_MMA(1, 1, At, B1); PG8_BAR; PG8_SCHED;
            PG8_LDB(B0, 1, 0); PG8_LDB(B1, 1, 1); PG8_SCHED; PG8_LDA(At, 1, 0); PG8_STAGE(PG8_SA(0, 1), a2, v2[1]);
            PG8_WAIT_V(8); PG8_WAIT_L(0); PG8_BAR; PG8_MMA(0, 0, At, B0); PG8_MMA(0, 1, At, B1); PG8_BAR; PG8_SCHED;
            PG8_LDA(At, 1, 1); PG8_STAGE(PG8_SB(1, 0), b3, voffB); PG8_STAGE(PG8_SB(1, 1), b3 + hstepB, voffB); PG8_STAGE(PG8_SA(1, 0), a3, v2[0]);
            PG8_WAIT_V(8); PG8_WAIT_L(0); PG8_BAR; PG8_MMA(1, 0, At, B0); PG8_MMA(1, 1, At, B1); PG8_BAR; PG8_SCHED;
        }
        if constexpr (ALIGN_EPI) { if (wr == 0) PG8_BAR; }
        if constexpr (MODE == 1) {
#pragma unroll
            for (int a = 0; a < 2; ++a)
#pragma unroll
                for (int b = 0; b < 2; ++b)
#pragma unroll
                    for (int m = 0; m < 4; ++m)
#pragma unroll
                        for (int n = 0; n < 2; ++n) acc[a][b][m][n] = __builtin_convertvector(__builtin_bit_cast(i32x4, acc[a][b][m][n]), f32x4);
        }
        E(acc, cur, wr, wc, fr, fq);
        if (!has_next) break;
#pragma unroll
        for (int a = 0; a < 2; ++a)
#pragma unroll
            for (int b = 0; b < 2; ++b)
#pragma unroll
                for (int m = 0; m < 4; ++m)
#pragma unroll
                    for (int n = 0; n < 2; ++n) acc[a][b][m][n] = (f32x4){0.f, 0.f, 0.f, 0.f};
        cur = nxt; cB = nB; ++ui;
#pragma unroll
        for (int h = 0; h < 2; ++h)
#pragma unroll
            for (int i = 0; i < 2; ++i) vc[h][i] = vn[h][i];
        if constexpr (ALIGN_EPI) { if (wr == 1) PG8_BAR; }
    }
    PG8_WAIT_V(0);
    if constexpr (!ALIGN_EPI) { if (wr == 0) PG8_BAR; }
    PG8_BAR;
#undef PG8_SA
#undef PG8_SB
#undef PG8_STAGE
#undef PG8_VOFFA
#undef PG8_BBASE
#undef PG8_LDA
#undef PG8_LDB
#undef PG8_MMA
#undef PG8_WAIT_V
#undef PG8_WAIT_L
#undef PG8_BAR
#undef PG8_SCHED
}
}

constexpr int NWAVES = 8;
constexpr int NPH = 20;
#ifndef MK_N_LAUNCHES
#define MK_N_LAUNCHES 1
#endif
constexpr int N_LAUNCHES = MK_N_LAUNCHES;

constexpr size_t MiB = 1u << 20;
constexpr size_t WS_CTL = 0, CTL_ZERO_BYTES = 1 * MiB;
constexpr size_t WS_MOD = 1 * MiB;
constexpr size_t WS_ROPE = 2 * MiB;
constexpr size_t WS_WRKV = 6 * MiB;
constexpr size_t WS_WL1 = 12 * MiB;
constexpr size_t WS_WL2 = 14 * MiB;
constexpr size_t WS_WOUT = 16 * MiB;
constexpr size_t WS_WFGU = 18 * MiB;
constexpr size_t WS_WFDN = 29 * MiB;
constexpr size_t WS_WKV = 35 * MiB;
constexpr size_t WS_WQ = 41 * MiB;
constexpr size_t WS_WO = 44 * MiB;
constexpr size_t WS_WMGU = 46 * MiB;
constexpr size_t WS_WMDN = 158 * MiB;
constexpr size_t WS_AR = 216 * MiB;
constexpr size_t AR(size_t mib) { return WS_AR + mib * MiB; }
constexpr size_t WS_A6 = AR(0);
constexpr size_t WS_L1 = AR(384);
constexpr size_t WS_RB = AR(432), WS_KB = AR(496), WS_VB = AR(560);
constexpr size_t WS_AS = AR(192), WS_G = AR(256);
constexpr size_t WS_YS = AR(0);
constexpr size_t WS_YG = AR(128);
constexpr size_t WS_RF = AR(0), WS_YF = AR(64), WS_QF = AR(128), WS_PF = AR(320);
constexpr size_t WS_SF = AR(192);
constexpr size_t WS_WCF = AR(384);
constexpr size_t WS_BON = AR(386);
constexpr size_t WS_Y1 = AR(320);
constexpr size_t WS_X1 = AR(448);
constexpr size_t WS_H2 = AR(576);
constexpr size_t WS_RSH2 = AR(616);
constexpr size_t WS_ACT = AR(0);
constexpr size_t WS_Y2 = AR(176);
constexpr size_t WS_X2 = AR(304);
constexpr size_t WS_HKV = AR(0), WS_H3 = AR(64);
constexpr size_t WS_K2 = AR(128), WS_V2 = AR(432), WS_Q2 = AR(528);
constexpr size_t WS_OG = AR(0);
constexpr size_t WS_LSE = AR(96);
constexpr size_t WS_OM = AR(224);
constexpr size_t WS_Y3 = AR(432);
constexpr size_t WS_H4 = AR(0);
constexpr size_t WS_ROUTE = AR(66);
constexpr size_t WS_ACT2 = AR(70);
constexpr size_t WS_YB = AR(532);
constexpr size_t WS_END = AR(664);
static_assert(WS_END <= 896 * MiB, "workspace");
static_assert((size_t)RMAX * DFE * 2 <= 462 * MiB && (size_t)RMAX * D * 2 <= 132 * MiB, "moe buffers");
constexpr size_t RT_TOKE = 0;
constexpr size_t RT_TOKR = 256 * 1024;
constexpr size_t RT_TOKW = 512 * 1024;
constexpr size_t RT_ROWTOK = 768 * 1024;
constexpr size_t RT_BLKEXP = 1280 * 1024;
constexpr size_t RT_RSH4 = 1536 * 1024;
constexpr int CW_BAR = 4096;
constexpr int CW_CNT = 16384;
constexpr int CW_NBLK = 16448;

constexpr int RING_BYTES = 131072;
constexpr int LDSCTL_OFF = RING_BYTES, MISC_OFF = LDSCTL_OFF + 320;
constexpr int LDS_BYTES = 147456;

#define LDS_WAIT() asm volatile("s_waitcnt lgkmcnt(0)" ::: "memory")
#define VM_WAIT() asm volatile("s_waitcnt vmcnt(0)" ::: "memory")

#define XB_TMO      128
#define XB_XCNT(j)  (256  + 64 * (j))
#define XB_XSUB(j)  (1280 + 64 * (j))
#define XB_XGEN(j)  (2304 + 64 * (j))
#define XB_TOP      3328
#define XB_TOPGEN   3392
#define XCD_BAR_WORDS 3456
#define XB_SPIN_CAP (1u << 22)

__device__ __forceinline__ unsigned xb_ld(unsigned* p)              { return __hip_atomic_load(p, __ATOMIC_RELAXED, __HIP_MEMORY_SCOPE_AGENT); }
__device__ __forceinline__ unsigned xb_add(unsigned* p, unsigned v) { return __hip_atomic_fetch_add(p, v, __ATOMIC_RELAXED, __HIP_MEMORY_SCOPE_AGENT); }
__device__ __forceinline__ unsigned xb_xcc_id() { return (unsigned)__builtin_amdgcn_s_getreg((3 << 11) | 20) & 0xFu; }
#define XB_SPIN(cond, bar) do { unsigned _sp = 0; while (cond) { __builtin_amdgcn_s_sleep(1); \
    if ((++_sp & 255u) == 0u) { if (xb_ld(&(bar)[XB_TMO])) break; if (_sp > XB_SPIN_CAP) { atomicAdd(&(bar)[XB_TMO], 1u); break; } } } } while (0)

struct XcdBarrier { unsigned* bar; unsigned x; volatile LAS unsigned* st; };
__device__ __forceinline__ XcdBarrier xcd_barrier_post(unsigned* bar, volatile LAS unsigned* st) {
    XcdBarrier b; b.bar = bar; b.x = xb_xcc_id(); b.st = st;
    if (threadIdx.x == 0) (void)xb_add(&bar[XB_XCNT(b.x)], 1u);
    return b;
}
__device__ __forceinline__ void xcd_barrier_complete(unsigned* bar, unsigned x, unsigned& nloc, unsigned& nx) {
    const unsigned G = gridDim.x * gridDim.y * gridDim.z;
    unsigned sum, cnt, mine, sp = 0u;
    for (;;) {
        sum = 0u; cnt = 0u; mine = 0u;
#pragma unroll
        for (unsigned j = 0; j < 16; ++j) { const unsigned c = xb_ld(&bar[XB_XCNT(j)]); sum += c; cnt += (c > 0u) ? 1u : 0u; mine = (j == x) ? c : mine; }
        if (sum == G) break;
        __builtin_amdgcn_s_sleep(1);
        if ((++sp & 255u) == 0u) { if (xb_ld(&bar[XB_TMO])) break; if (sp > XB_SPIN_CAP) { atomicAdd(&bar[XB_TMO], 1u); break; } }
    }
    nloc = mine > 0u ? mine : 1u; nx = cnt > 0u ? cnt : 1u;
}
__device__ __forceinline__ void xcd_barrier(const XcdBarrier& b) {
    asm volatile("s_waitcnt vmcnt(0)" ::: "memory");
    __syncthreads();
    if (threadIdx.x == 0) {
        unsigned* bar = b.bar;
        __builtin_amdgcn_s_waitcnt(0);
        unsigned nloc = b.st[0], nx = b.st[1];
        if (nloc == 0u) { xcd_barrier_complete(bar, b.x, nloc, nx); b.st[0] = nloc; b.st[1] = nx; }
        const unsigned old = xb_add(&bar[XB_XSUB(b.x)], 1u);
        const unsigned gen = old / nloc;
        if (old + 1u == (gen + 1u) * nloc) {
            __builtin_amdgcn_fence(__ATOMIC_RELEASE, "agent");
            asm volatile("s_waitcnt vmcnt(0)" ::: "memory");
            const unsigned og = xb_add(&bar[XB_TOP], 1u);
            const unsigned tg = og / nx;
            if (og + 1u == (tg + 1u) * nx) xb_add(&bar[XB_TOPGEN], 1u);
            else XB_SPIN(xb_ld(&bar[XB_TOPGEN]) == tg, bar);
            __builtin_amdgcn_fence(__ATOMIC_ACQUIRE, "agent");
            xb_add(&bar[XB_XGEN(b.x)], 1u);
            asm volatile("s_waitcnt vmcnt(0)" ::: "memory");
        } else {
            XB_SPIN(xb_ld(&bar[XB_XGEN(b.x)]) == gen, bar);
            __builtin_amdgcn_fence(__ATOMIC_ACQUIRE, "agent");
            asm volatile("s_waitcnt vmcnt(0)" ::: "memory");
        }
    }
    __syncthreads();
}

struct Frame {
    LAS unsigned char* lds;
    volatile LAS unsigned* MISC;
    gu32* ctl;
    int tid, lane, wave;
    int vcu, G;
    const float* const* in;
    float* out;
    unsigned char* ws;
};
#define WSP(type, off) ((type*)(F.ws + (off)))

__device__ __forceinline__ float wave_sum(float v) {
#pragma unroll
    for (int o = 1; o < 64; o <<= 1) v += __shfl_xor(v, o);
    return v;
}

__device__ __forceinline__ int colmap(int kind, int half, int n) {
    if (kind == 1) return (n & 1) ? half + (n >> 1) : (n >> 1);
    if (kind == 2 || (kind == 3 && n < QW)) { const int hd = n >> 6, p = n & 63; return hd * 64 + ((p & 1) * 32 + (p >> 1)); }
    return n;
}
__device__ __forceinline__ void cvt_item(const float* W, int ldw, int Kv, int Nv, bf16_t* WT, int Kout, int Nout, int kind, int half, LAS float* scr, int item, int lane) {
    const int nblk = Nout / 32, kb = item / nblk, nb = item % nblk, k0 = 64 * kb, n0 = 32 * nb;
    const int nn = n0 + (lane & 31); const int sc = colmap(kind, half, nn); const bool nok = nn < Nv;
#pragma unroll 8
    for (int i = 0; i < 32; ++i) { const int kk = 2 * i + (lane >> 5); float v = 0.f; if (nok && (k0 + kk) < Kv) v = W[(size_t)(k0 + kk) * ldw + sc]; scr[kk * 33 + (lane & 31)] = v; }
    LDS_WAIT(); asm volatile("" ::: "memory");
    const int c = lane & 7;
#pragma unroll
    for (int j = 0; j < 4; ++j) { const int n = (lane >> 3) + 8 * j; const LAS float* s = scr + (8 * c) * 33 + n;
        u32x4 o; o.x = cvt_pk_bf16(s[0 * 33], s[1 * 33]); o.y = cvt_pk_bf16(s[2 * 33], s[3 * 33]); o.z = cvt_pk_bf16(s[4 * 33], s[5 * 33]); o.w = cvt_pk_bf16(s[6 * 33], s[7 * 33]);
        *(u32x4*)(WT + (size_t)(n0 + n) * Kout + k0 + 8 * c) = o; }
    LDS_WAIT(); asm volatile("" ::: "memory");
}
__device__ __forceinline__ int invmap(int kind, int half, int sc) {
    if (kind == 1) return sc < half ? 2 * sc : 2 * (sc - half) + 1;
    if (kind == 2 || (kind == 3 && sc < QW)) { const int hd = sc >> 6, d = sc & 63; return hd * 64 + (d < 32 ? 2 * d : 2 * (d - 32) + 1); }
    return sc;
}
constexpr int CV_STRIDE = 68;
__device__ __forceinline__ void cvt_item64(const float* W, int ldw, bf16_t* WT, int Kout, int nblk, int kind, int half, LAS bf16_t* scr, int item, int lane) {
    const int kb = item / nblk, nb = item % nblk, k0 = 64 * kb, n0 = 64 * nb;
    const int c4 = lane & 15, kr = lane >> 4;
    f32x4 v[8][2];
#pragma unroll
    for (int i = 0; i < 8; ++i)
#pragma unroll
        for (int e = 0; e < 2; ++e) v[i][e] = __builtin_nontemporal_load((const f32x4*)(W + (size_t)(k0 + 8 * i + 2 * kr + e) * ldw + n0 + 4 * c4));
#pragma unroll
    for (int i = 0; i < 8; ++i)
#pragma unroll
        for (int e = 0; e < 4; ++e) *(LAS unsigned*)(scr + (4 * c4 + e) * CV_STRIDE + 8 * i + 2 * kr) = cvt_pk_bf16(v[i][0][e], v[i][1][e]);
    LDS_WAIT(); asm volatile("" ::: "memory");
    const int c = lane & 7;
#pragma unroll
    for (int j = 0; j < 8; ++j) { const int n = (lane >> 3) + 8 * j; const LAS bf16_t* sp = scr + n * CV_STRIDE + 8 * c;
        const u32x2 a = *(const LAS u32x2*)sp, b = *(const LAS u32x2*)(sp + 4);
        *(u32x4*)(WT + (size_t)invmap(kind, half, n0 + n) * Kout + k0 + 8 * c) = (u32x4){a.x, a.y, b.x, b.y}; }
    LDS_WAIT(); asm volatile("" ::: "memory");
}
constexpr int CV8_STRIDE = 80;
__device__ __forceinline__ void cvt_item64_q8(const float* W, int ldw, unsigned char* WT, int Kout, int nblk, int kind, int half, float scale, LAS unsigned char* scr, int item, int lane) {
    const int kb = item / nblk, nb = item % nblk, k0 = 64 * kb, n0 = 64 * nb;
    const int c4 = lane & 15, kr = lane >> 4;
    f32x4 v[4][4];
#pragma unroll
    for (int i = 0; i < 4; ++i)
#pragma unroll
        for (int e = 0; e < 4; ++e) v[i][e] = __builtin_nontemporal_load((const f32x4*)(W + (size_t)(k0 + 16 * i + 4 * kr + e) * ldw + n0 + 4 * c4));
#pragma unroll
    for (int i = 0; i < 4; ++i)
#pragma unroll
        for (int e = 0; e < 4; ++e) *(LAS unsigned*)(scr + (4 * c4 + e) * CV8_STRIDE + 16 * i + 4 * kr) = pk4_i8(v[i][0][e] * scale, v[i][1][e] * scale, v[i][2][e] * scale, v[i][3][e] * scale);
    LDS_WAIT(); asm volatile("" ::: "memory");
    const int c = lane & 3;
#pragma unroll
    for (int j = 0; j < 4; ++j) { const int n = (lane >> 2) + 16 * j;
        *(u32x4*)(WT + (size_t)invmap(kind, half, n0 + n) * Kout + k0 + 16 * c) = *(const LAS u32x4*)(scr + n * CV8_STRIDE + 16 * c); }
    LDS_WAIT(); asm volatile("" ::: "memory");
}
__device__ __forceinline__ void p0_prologue(Frame& F) {
    {
        LAS float* part = (LAS float*)F.lds;
        const float* c = F.in[1]; const float* aw = F.in[2]; const float* ab = F.in[3]; float* MOD = WSP(float, WS_MOD);
        for (int it = F.vcu; it < ADA_W / 64; it += F.G) {
            const int j = it * 64 + F.lane; float s0 = 0.f, s1 = 0.f;
#pragma unroll 8
            for (int k = F.wave * 128; k < F.wave * 128 + 128; ++k) { const float w = aw[(size_t)k * ADA_W + j]; s0 += siluf_(c[k]) * w; s1 += siluf_(c[D + k]) * w; }
            part[(F.wave * 2 + 0) * 64 + F.lane] = s0; part[(F.wave * 2 + 1) * 64 + F.lane] = s1;
            __syncthreads();
            if (F.wave < 2) { float s = ab[j];
#pragma unroll
                for (int w = 0; w < 8; ++w) s += part[(w * 2 + F.wave) * 64 + F.lane];
                MOD[F.wave * ADA_W + j] = s; }
            __syncthreads();
        }
    }
    {
        float* cs = WSP(float, WS_ROPE); float* sn = cs + SEQ * 32;
        for (int idx = F.vcu * 512 + F.tid; idx < SEQ * 32; idx += F.G * 512) {
            const int t = idx >> 5, i = idx & 31;
            const float inv = powf(10000.0f, -(float)i / 32.0f); const float ang = (float)t * inv;
            cs[idx] = cosf(ang); sn[idx] = sinf(ang);
        }
    }
    LAS float* scr = (LAS float*)(F.lds + F.wave * 16384);
    LAS bf16_t* scrh = (LAS bf16_t*)(F.lds + F.wave * 16384);
    const int gw = F.vcu * NWAVES + F.wave, NGW = F.G * NWAVES;
    {
        constexpr int J_MGU = 16 * 112, J_MDN = 56 * 16, J_RKV = 16 * 48, J_OUT = 16 * 16, J_FGU = 16 * 88, J_FDN = 44 * 16, J_KV = 16 * 48, J_Q = 16 * 24, J_O = 8 * 16;
        constexpr int NJ = 8 * J_MGU + 8 * J_MDN + J_RKV + J_OUT + J_FGU + J_FDN + J_KV + J_Q + J_O;
        for (int it = gw; it < NJ; it += NGW) {
            int r = it;
            if (r < 8 * J_MGU) { const int e = r / J_MGU; cvt_item64_q8(F.in[28] + (size_t)e * D * 2 * DFE, 2 * DFE, WSP(unsigned char, WS_WMGU) + (size_t)e * 2 * DFE * D, D, 112, 1, DFE, QW_INV, (LAS unsigned char*)scrh, r % J_MGU, F.lane); continue; } r -= 8 * J_MGU;
            if (r < 8 * J_MDN) { const int e = r / J_MDN; cvt_item64(F.in[29] + (size_t)e * DFE * D, D, WSP(bf16_t, WS_WMDN) + (size_t)e * D * DFE, DFE, 16, 0, 0, scrh, r % J_MDN, F.lane); continue; } r -= 8 * J_MDN;
            if (r < J_RKV) { cvt_item64(F.in[7], 3 * D, WSP(bf16_t, WS_WRKV), D, 48, 0, 0, scrh, r, F.lane); continue; } r -= J_RKV;
            if (r < J_OUT) { cvt_item64(F.in[21], D, WSP(bf16_t, WS_WOUT), D, 16, 0, 0, scrh, r, F.lane); continue; } r -= J_OUT;
            if (r < J_FGU) { cvt_item64_q8(F.in[25], 2 * DFF, WSP(unsigned char, WS_WFGU), D, 88, 1, DFF, QW_INV, (LAS unsigned char*)scrh, r, F.lane); continue; } r -= J_FGU;
            if (r < J_FDN) { cvt_item64(F.in[26], D, WSP(bf16_t, WS_WFDN), DFF, 16, 0, 0, scrh, r, F.lane); continue; } r -= J_FDN;
            if (r < J_KV) { cvt_item64(F.in[22], 2 * QW, WSP(bf16_t, WS_WKV), D, 48, 3, 0, scrh, r, F.lane); continue; } r -= J_KV;
            if (r < J_Q) { cvt_item64(F.in[23], QW, WSP(bf16_t, WS_WQ), D, 24, 2, 0, scrh, r, F.lane); continue; } r -= J_Q;
            cvt_item64(F.in[24], D, WSP(bf16_t, WS_WO), AOUT, 16, 0, 0, scrh, r, F.lane);
        }
    }
    {
        constexpr int I_L1 = 16 * 8, I_L2 = 4 * 32;
        for (int it = gw; it < 3 * I_L1 + 3 * I_L2; it += NGW) {
            int r = it;
            if (r < I_L1) { cvt_item(F.in[9], 64, D, 64, WSP(bf16_t, WS_WL1), D, 256, 0, 0, scr, r, F.lane); continue; } r -= I_L1;
            if (r < I_L1) { cvt_item(F.in[12], 64, D, 64, WSP(bf16_t, WS_WL1) + 256 * D, D, 256, 0, 0, scr, r, F.lane); continue; } r -= I_L1;
            if (r < I_L1) { cvt_item(F.in[14], 160, D, 160, WSP(bf16_t, WS_WL1) + 2 * 256 * D, D, 256, 0, 0, scr, r, F.lane); continue; } r -= I_L1;
            if (r < I_L2) { cvt_item(F.in[10], D, 64, D, WSP(bf16_t, WS_WL2), 256, D, 0, 0, scr, r, F.lane); continue; } r -= I_L2;
            if (r < I_L2) { cvt_item(F.in[13], D, 64, D, WSP(bf16_t, WS_WL2) + D * 256, 256, D, 0, 0, scr, r, F.lane); continue; } r -= I_L2;
            cvt_item(F.in[15], D, 160, D, WSP(bf16_t, WS_WL2) + 2 * D * 256, 256, D, 0, 0, scr, r, F.lane);
        }
    }
}

__device__ __forceinline__ void p1_lerp(Frame& F) {
    const int gw = F.vcu * NWAVES + F.wave, NGW = F.G * NWAVES;
    const float* x = F.in[0]; const float* mu = F.in[6]; const float* MOD = WSP(float, WS_MOD); bf16_t* A6 = WSP(bf16_t, WS_A6);
    for (int m = gw; m < T; m += NGW) {
        const int b = m >> 14, t = m & (SEQ - 1);
#pragma unroll
        for (int j = 0; j < 4; ++j) {
            const int c = 4 * F.lane + 256 * j;
            const f32x4 sh = *(const f32x4*)(MOD + b * ADA_W + 0 * D + c), sc = *(const f32x4*)(MOD + b * ADA_W + 1 * D + c);
            const f32x4 xc = *(const f32x4*)(x + (size_t)m * D + c);
            const f32x4 hc = xc * (1.f + sc) + sh;
            f32x4 hp = (f32x4){0.f, 0.f, 0.f, 0.f};
            if (t > 0) { const f32x4 xp = *(const f32x4*)(x + (size_t)(m - 1) * D + c); hp = xp * (1.f + sc) + sh; }
            const f32x4 xx = hp - hc;
#pragma unroll
            for (int p = 0; p < 6; ++p) {
                const f32x4 mv = *(const f32x4*)(mu + p * D + c); const f32x4 o = hc + xx * mv;
                u32x2 w; w.x = cvt_pk_bf16(o[0], o[1]); w.y = cvt_pk_bf16(o[2], o[3]);
                *(u32x2*)(A6 + (size_t)p * T * D + (size_t)m * D + c) = w;
            }
        }
    }
}

template <int CTRL> __device__ __forceinline__ float dpp_mov(float v) { return __int_as_float(__builtin_amdgcn_update_dpp(0, __float_as_int(v), CTRL, 0xF, 0xF, false)); }
__device__ __forceinline__ float sum16(float v) { v += dpp_mov<0xB1>(v); v += dpp_mov<0x4E>(v); v += dpp_mov<0x141>(v); v += dpp_mov<0x140>(v); return v; }
__device__ __forceinline__ float rdl(float v, int l) { return __int_as_float(__builtin_amdgcn_readlane(__float_as_int(v), l)); }
__device__ __forceinline__ float wsum(float v) { v = sum16(v); return (rdl(v, 0) + rdl(v, 16)) + (rdl(v, 32) + rdl(v, 48)); }
__device__ __forceinline__ unsigned short bf1(float x) { return (unsigned short)(cvt_pk_bf16(x, x) & 0xffffu); }
constexpr int CH = 64, NCH = SEQ / CH, NUNIT = BATCH * 16 * NCH;
constexpr int CS = 72;
constexpr int L_AT = 0, L_RT = 9216, L_BT = 18432, L_KT = 27648, L_ATT = 36864, L_BTT = 46080, L_KTT = 55296, L_VT = 64512, L_AAB = 73728, L_AAK = 82944, L_ARB = 92160, L_ARK = 101376;
constexpr int L_XT = L_BT;
constexpr int L_TI = 110592, L_WC = 112640, L_TOT = 112896;
#define FRAG(base, row, ks) (*(const LAS bf16x8*)((base) + (row) * CS + 32 * (ks) + 8 * qd))
#define MF(a, b, c) __builtin_amdgcn_mfma_f32_16x16x32_bf16((a), (b), (c), 0, 0, 0)
__device__ __forceinline__ bf16x8 pack8(const f32x4 a, const f32x4 b) { union { bf16x8 v; unsigned u[4]; } t; t.u[0] = cvt_pk_bf16(a[0], a[1]); t.u[1] = cvt_pk_bf16(a[2], a[3]); t.u[2] = cvt_pk_bf16(b[0], b[1]); t.u[3] = cvt_pk_bf16(b[2], b[3]); return t.v; }
__device__ __forceinline__ f32x4 unpk4(const u32x2 w) { return (f32x4){bflo(w.x), bfhi(w.x), bflo(w.y), bfhi(w.y)}; }

#define LDS_BAR() do { asm volatile("s_waitcnt lgkmcnt(0)" ::: "memory"); __builtin_amdgcn_s_barrier(); asm volatile("" ::: "memory"); } while (0)
struct ChIn { unsigned short r[8], k[8], v[8], a[8]; float wl[8]; };
__device__ __forceinline__ void ch_load(ChIn& I, const bf16_t* RB, const bf16_t* KB, const bf16_t* VB, const bf16_t* AS, const float* WLOG, size_t m0, int col) {
#pragma unroll
    for (int i = 0; i < 8; ++i) { const size_t o = (m0 + i) * D + col; I.r[i] = RB[o]; I.k[i] = KB[o]; I.v[i] = VB[o]; I.a[i] = AS[o]; I.wl[i] = WLOG[o]; }
}
__device__ __forceinline__ void p4a_chunk(Frame& F) {
    LAS unsigned char* L = F.lds;
    LAS bf16_t* At = (LAS bf16_t*)(L + L_AT); LAS bf16_t* Rt = (LAS bf16_t*)(L + L_RT); LAS bf16_t* Bt = (LAS bf16_t*)(L + L_BT); LAS bf16_t* Kt = (LAS bf16_t*)(L + L_KT);
    LAS bf16_t* AtT = (LAS bf16_t*)(L + L_ATT); LAS bf16_t* BtT = (LAS bf16_t*)(L + L_BTT); LAS bf16_t* KtT = (LAS bf16_t*)(L + L_KTT); LAS bf16_t* VT = (LAS bf16_t*)(L + L_VT);
    LAS bf16_t* AAB = (LAS bf16_t*)(L + L_AAB); LAS bf16_t* AAK = (LAS bf16_t*)(L + L_AAK); LAS bf16_t* ARB = (LAS bf16_t*)(L + L_ARB); LAS bf16_t* ARK = (LAS bf16_t*)(L + L_ARK);
    LAS bf16_t* XT = (LAS bf16_t*)(L + L_XT); LAS bf16_t* TI = (LAS bf16_t*)(L + L_TI); LAS float* WC = (LAS float*)(L + L_WC); LAS float* TOT = (LAS float*)(L + L_TOT);
    const bf16_t* RB = WSP(bf16_t, WS_RB); const bf16_t* KB = WSP(bf16_t, WS_KB); const bf16_t* VB = WSP(bf16_t, WS_VB); const bf16_t* AS = WSP(bf16_t, WS_AS); const float* WLOG = F.out;
    u32x4* PF = WSP(u32x4, WS_PF); u32x4* QF = WSP(u32x4, WS_QF); u32x4* RF = WSP(u32x4, WS_RF); u32x4* YF = WSP(u32x4, WS_YF); float* WCF = WSP(float, WS_WCF); float* BON = WSP(float, WS_BON);
    const int lane = F.lane, w = F.wave, q16 = lane & 15, qd = lane >> 4;
    ChIn I;
    int unit = F.vcu;
    if (unit < NUNIT) { const int bh = unit >> 8, ch = unit & 255; ch_load(I, RB, KB, VB, AS, WLOG, (size_t)(bh >> 4) * SEQ + ch * CH + 8 * w, (bh & 15) * 64 + lane); }
    for (; unit < NUNIT; unit += F.G) {
        const int bh = unit >> 8, ch = unit & 255, b = bh >> 4, h = bh & 15;
        const size_t m0 = (size_t)b * SEQ + (size_t)ch * CH;
        const int col = h * 64 + lane;
        float r_[8], kp_[8], kn_[8], a_[8], cwl[8];
        {
            const float kkc = F.in[16][col], kac = F.in[17][col], rkc = F.in[18][col];
            float run = 0.f;
#pragma unroll
            for (int i = 0; i < 8; ++i) {
                const float r = __uint_as_float((unsigned)I.r[i] << 16), k = __uint_as_float((unsigned)I.k[i] << 16), a = __uint_as_float((unsigned)I.a[i] << 16);
                run += I.wl[i]; cwl[i] = run;
                const float kkv = k * kkc; const float ss = wsum(kkv * kkv); const float inv = 1.f / fmaxf(sqrtf(ss), 1e-12f);
                const float kp = k * (1.f + (a - 1.f) * kac); const float bn = wsum(r * kp * rkc);
                if (lane == 0) BON[(m0 + 8 * w + i) * 16 + h] = bn;
                r_[i] = r; kp_[i] = kp; kn_[i] = kkv * inv; a_[i] = a;
            }
            TOT[w * 64 + lane] = run;
        }
        LDS_BAR();
        {
            float off = 0.f, tot = 0.f;
#pragma unroll
            for (int ww = 0; ww < 8; ++ww) { const float tv = TOT[ww * 64 + lane]; tot += tv; off += (ww < w) ? tv : 0.f; }
            if (w == 0) { WC[lane] = __expf(tot); WCF[(size_t)unit * 64 + lane] = __expf(tot); }
            float at[8], bt[8], kt[8];
#pragma unroll
            for (int i = 0; i < 8; ++i) {
                const float cw = off + cwl[i]; const float ein = __expf(cw), eex = __expf(cw - I.wl[i]), einv = __expf(-cw);
                at[i] = -kn_[i] * eex; bt[i] = kn_[i] * a_[i] * einv; kt[i] = kp_[i] * einv; const float rt = r_[i] * ein;
                const int t = 8 * w + i;
                At[t * CS + lane] = bf1(at[i]); Rt[t * CS + lane] = bf1(rt); Bt[t * CS + lane] = bf1(bt[i]); Kt[t * CS + lane] = bf1(kt[i]);
            }
            u32x4 pa, pb, pk, pv;
            pa.x = cvt_pk_bf16(at[0], at[1]); pa.y = cvt_pk_bf16(at[2], at[3]); pa.z = cvt_pk_bf16(at[4], at[5]); pa.w = cvt_pk_bf16(at[6], at[7]);
            pb.x = cvt_pk_bf16(bt[0], bt[1]); pb.y = cvt_pk_bf16(bt[2], bt[3]); pb.z = cvt_pk_bf16(bt[4], bt[5]); pb.w = cvt_pk_bf16(bt[6], bt[7]);
            pk.x = cvt_pk_bf16(kt[0], kt[1]); pk.y = cvt_pk_bf16(kt[2], kt[3]); pk.z = cvt_pk_bf16(kt[4], kt[5]); pk.w = cvt_pk_bf16(kt[6], kt[7]);
            pv.x = (unsigned)I.v[0] | ((unsigned)I.v[1] << 16); pv.y = (unsigned)I.v[2] | ((unsigned)I.v[3] << 16); pv.z = (unsigned)I.v[4] | ((unsigned)I.v[5] << 16); pv.w = (unsigned)I.v[6] | ((unsigned)I.v[7] << 16);
            *(LAS u32x4*)(AtT + lane * CS + 8 * w) = pa; *(LAS u32x4*)(BtT + lane * CS + 8 * w) = pb; *(LAS u32x4*)(KtT + lane * CS + 8 * w) = pk; *(LAS u32x4*)(VT + lane * CS + 8 * w) = pv;
        }
        { const int nu = unit + F.G; if (nu < NUNIT) { const int nbh = nu >> 8, nch = nu & 255; ch_load(I, RB, KB, VB, AS, WLOG, (size_t)(nbh >> 4) * SEQ + nch * CH + 8 * w, (nbh & 15) * 64 + lane); } }
        LDS_BAR();
        {
            const int tt = w >> 1, half = w & 1;
            const LAS bf16_t* src = half ? Rt : At; LAS bf16_t* d0 = half ? ARB : AAB; LAS bf16_t* d1 = half ? ARK : AAK;
            const bf16x8 s0 = FRAG(src, 16 * tt + q16, 0), s1 = FRAG(src, 16 * tt + q16, 1);
#pragma unroll
            for (int jt = 0; jt < 4; ++jt) {
                f32x4 e0 = (f32x4){0.f, 0.f, 0.f, 0.f}, e1 = e0;
                if (jt <= tt) {
                    e0 = MF(FRAG(Bt, 16 * jt + q16, 0), s0, e0); e0 = MF(FRAG(Bt, 16 * jt + q16, 1), s1, e0);
                    e1 = MF(FRAG(Kt, 16 * jt + q16, 0), s0, e1); e1 = MF(FRAG(Kt, 16 * jt + q16, 1), s1, e1);
#pragma unroll
                    for (int r = 0; r < 4; ++r) { const int j = 16 * jt + 4 * qd + r, t = 16 * tt + q16; const bool ok = half ? (j <= t) : (j < t); e0[r] = ok ? e0[r] : 0.f; e1[r] = ok ? e1[r] : 0.f; }
                }
                u32x2 o0, o1; o0.x = cvt_pk_bf16(e0[0], e0[1]); o0.y = cvt_pk_bf16(e0[2], e0[3]); o1.x = cvt_pk_bf16(e1[0], e1[1]); o1.y = cvt_pk_bf16(e1[2], e1[3]);
                *(LAS u32x2*)(d0 + (16 * tt + q16) * CS + 16 * jt + 4 * qd) = o0; *(LAS u32x2*)(d1 + (16 * tt + q16) * CS + 16 * jt + 4 * qd) = o1;
            }
        }
        LDS_BAR();
        f32x4 Z[4];
        if (w < 4) {
            float Tc[16];
#pragma unroll
            for (int r = 0; r < 16; ++r) Tc[r] = (r == q16) ? 1.f : 0.f;
#pragma unroll
            for (int r = 1; r < 16; ++r) {
                const LAS bf16_t* np_ = AAB + (16 * w + r) * CS + 16 * w;
                const u32x4 n0 = *(const LAS u32x4*)np_, n1 = *(const LAS u32x4*)(np_ + 8);
                const float nv[16] = {bflo(n0.x), bfhi(n0.x), bflo(n0.y), bfhi(n0.y), bflo(n0.z), bfhi(n0.z), bflo(n0.w), bfhi(n0.w), bflo(n1.x), bfhi(n1.x), bflo(n1.y), bfhi(n1.y), bflo(n1.z), bfhi(n1.z), bflo(n1.w), bfhi(n1.w)};
                float acc = Tc[r];
#pragma unroll
                for (int s = 0; s < r; ++s) acc += nv[s] * Tc[s];
                Tc[r] = acc;
            }
            if (qd == 0) {
#pragma unroll
                for (int r = 0; r < 16; ++r) TI[(w * 16 + r) * 16 + q16] = bf1(Tc[r]);
            }
#pragma unroll
            for (int i = 0; i < 4; ++i) Z[i] = unpk4(*(const LAS u32x2*)(AtT + (16 * w + q16) * CS + 16 * i + 4 * qd));
        } else {
            const int vt = w - 4;
            const bf16x8 v0 = FRAG(VT, 16 * vt + q16, 0), v1 = FRAG(VT, 16 * vt + q16, 1);
#pragma unroll
            for (int i = 0; i < 4; ++i) {
                f32x4 g = (f32x4){0.f, 0.f, 0.f, 0.f};
                g = MF(FRAG(AAK, 16 * i + q16, 0), v0, g);
                if (i >= 2) g = MF(FRAG(AAK, 16 * i + q16, 1), v1, g);
                Z[i] = g;
            }
        }
        LDS_BAR();
        {
            const f32x4 zz = (f32x4){0.f, 0.f, 0.f, 0.f};
            f32x4 X[4];
#pragma unroll
            for (int i = 0; i < 4; ++i) {
                if (i >= 1) {
                    union { bf16x8 v; u32x2 h[2]; } af;
                    af.h[0] = *(const LAS u32x2*)(AAB + (16 * i + q16) * CS + 0 + 4 * qd);
                    af.h[1] = (i >= 2) ? *(const LAS u32x2*)(AAB + (16 * i + q16) * CS + 16 + 4 * qd) : (u32x2){0u, 0u};
                    Z[i] = MF(af.v, pack8(X[0], (i >= 2) ? X[1] : zz), Z[i]);
                    if (i == 3) { af.h[0] = *(const LAS u32x2*)(AAB + (16 * i + q16) * CS + 32 + 4 * qd); af.h[1] = (u32x2){0u, 0u}; Z[i] = MF(af.v, pack8(X[2], zz), Z[i]); }
                }
                union { bf16x8 v; u32x2 h[2]; } tf; tf.h[0] = *(const LAS u32x2*)(TI + (i * 16 + q16) * 16 + 4 * qd); tf.h[1] = (u32x2){0u, 0u};
                X[i] = MF(tf.v, pack8(Z[i], zz), zz);
                u32x2 o; o.x = cvt_pk_bf16(X[i][0], X[i][1]); o.y = cvt_pk_bf16(X[i][2], X[i][3]);
                *(LAS u32x2*)(XT + (16 * w + q16) * CS + 16 * i + 4 * qd) = o;
            }
        }
        LDS_BAR();
        {
            const int hi = w >> 1, lo = w & 1;
            const size_t fo = ((size_t)unit * 8 + w) * 64 + lane;
            {
                const bf16x8 b0 = FRAG(BtT, 16 * hi + q16, 0), b1 = FRAG(BtT, 16 * hi + q16, 1);
                f32x4 d[2];
#pragma unroll
                for (int e = 0; e < 2; ++e) { const int kt = 2 * lo + e; f32x4 a = (f32x4){0.f, 0.f, 0.f, 0.f}; a = MF(FRAG(XT, 16 * kt + q16, 0), b0, a); a = MF(FRAG(XT, 16 * kt + q16, 1), b1, a); d[e] = a * WC[16 * hi + q16]; }
                const bf16x8 o = pack8(d[0], d[1]); PF[fo] = *(const u32x4*)&o;
            }
            {
                const bf16x8 u0 = FRAG(XT, 64 + 16 * hi + q16, 0), u1 = FRAG(XT, 64 + 16 * hi + q16, 1), v0 = FRAG(VT, 16 * hi + q16, 0), v1 = FRAG(VT, 16 * hi + q16, 1);
                f32x4 d[2];
#pragma unroll
                for (int e = 0; e < 2; ++e) { const int kt = 2 * lo + e; f32x4 a = (f32x4){0.f, 0.f, 0.f, 0.f};
                    a = MF(FRAG(BtT, 16 * kt + q16, 0), u0, a); a = MF(FRAG(BtT, 16 * kt + q16, 1), u1, a); a = MF(FRAG(KtT, 16 * kt + q16, 0), v0, a); a = MF(FRAG(KtT, 16 * kt + q16, 1), v1, a);
                    d[e] = a * *(const LAS f32x4*)(WC + 16 * kt + 4 * qd); }
                const bf16x8 o = pack8(d[0], d[1]); QF[fo] = *(const u32x4*)&o;
            }
            {
                const bf16x8 b0 = FRAG(ARB, 16 * hi + q16, 0), b1 = FRAG(ARB, 16 * hi + q16, 1);
                f32x4 d[2];
#pragma unroll
                for (int e = 0; e < 2; ++e) { const int ct = 2 * lo + e; f32x4 a = unpk4(*(const LAS u32x2*)(Rt + (16 * hi + q16) * CS + 16 * ct + 4 * qd));
                    a = MF(FRAG(XT, 16 * ct + q16, 0), b0, a); if (hi >= 2) a = MF(FRAG(XT, 16 * ct + q16, 1), b1, a); d[e] = a; }
                const bf16x8 o = pack8(d[0], d[1]); RF[fo] = *(const u32x4*)&o;
            }
            {
                const bf16x8 b0 = FRAG(ARB, 16 * hi + q16, 0), b1 = FRAG(ARB, 16 * hi + q16, 1), k0 = FRAG(ARK, 16 * hi + q16, 0), k1 = FRAG(ARK, 16 * hi + q16, 1);
                f32x4 d[2];
#pragma unroll
                for (int e = 0; e < 2; ++e) { const int vt = 2 * lo + e; f32x4 a = (f32x4){0.f, 0.f, 0.f, 0.f};
                    a = MF(FRAG(XT, 64 + 16 * vt + q16, 0), b0, a); a = MF(FRAG(VT, 16 * vt + q16, 0), k0, a);
                    if (hi >= 2) { a = MF(FRAG(XT, 64 + 16 * vt + q16, 1), b1, a); a = MF(FRAG(VT, 16 * vt + q16, 1), k1, a); }
                    d[e] = a; }
                const bf16x8 o = pack8(d[0], d[1]); YF[fo] = *(const u32x4*)&o;
            }
        }
    }
}
__device__ __forceinline__ void p4b_chain(Frame& F) {
    if (F.wave != 0) return;
    const u32x4* PF = WSP(u32x4, WS_PF); const u32x4* QF = WSP(u32x4, WS_QF); const float* WCF = WSP(float, WS_WCF); u32x4* SF = WSP(u32x4, WS_SF);
    const int lane = F.lane, qd = lane >> 4;
    for (int job = F.vcu; job < BATCH * 16 * 4; job += F.G) {
        const int bh = job >> 2, vt = job & 3;
        f32x4 S[4];
#pragma unroll
        for (int kt = 0; kt < 4; ++kt) S[kt] = (f32x4){0.f, 0.f, 0.f, 0.f};
        u32x4 pf[2][8], qf[2][2]; f32x4 wc[2][4];
#define CHAIN_LOAD(buf, u) do { _Pragma("unroll") for (int x = 0; x < 8; ++x) pf[buf][x] = PF[((size_t)(u) * 8 + x) * 64 + lane]; \
        _Pragma("unroll") for (int x = 0; x < 2; ++x) qf[buf][x] = QF[((size_t)(u) * 8 + vt * 2 + x) * 64 + lane]; \
        _Pragma("unroll") for (int kt = 0; kt < 4; ++kt) wc[buf][kt] = *(const f32x4*)(WCF + (size_t)(u) * 64 + 16 * kt + 4 * qd); } while (0)
#define CHAIN_STEP(buf, u) do { \
        const bf16x8 s0 = pack8(S[0], S[1]), s1 = pack8(S[2], S[3]); \
        SF[((size_t)(u) * 8 + vt * 2 + 0) * 64 + lane] = *(const u32x4*)&s0; SF[((size_t)(u) * 8 + vt * 2 + 1) * 64 + lane] = *(const u32x4*)&s1; \
        f32x4 n[4]; \
        n[0] = unpk4((u32x2){qf[buf][0].x, qf[buf][0].y}) + wc[buf][0] * S[0]; n[1] = unpk4((u32x2){qf[buf][0].z, qf[buf][0].w}) + wc[buf][1] * S[1]; \
        n[2] = unpk4((u32x2){qf[buf][1].x, qf[buf][1].y}) + wc[buf][2] * S[2]; n[3] = unpk4((u32x2){qf[buf][1].z, qf[buf][1].w}) + wc[buf][3] * S[3]; \
        _Pragma("unroll") for (int kt = 0; kt < 4; ++kt) { n[kt] = MF(*(const bf16x8*)&pf[buf][kt * 2 + 0], s0, n[kt]); n[kt] = MF(*(const bf16x8*)&pf[buf][kt * 2 + 1], s1, n[kt]); } \
        _Pragma("unroll") for (int kt = 0; kt < 4; ++kt) S[kt] = n[kt]; } while (0)
        const size_t u0 = (size_t)bh * NCH;
        CHAIN_LOAD(0, u0);
        for (int c = 0; c < NCH; c += 2) {
            CHAIN_LOAD(1, u0 + c + 1);
            CHAIN_STEP(0, u0 + c);
            if (c + 2 < NCH) CHAIN_LOAD(0, u0 + c + 2);
            CHAIN_STEP(1, u0 + c + 1);
        }
#undef CHAIN_LOAD
#undef CHAIN_STEP
    }
}
__device__ __forceinline__ void p5_chunk_out(Frame& F) {
    const u32x4* SF = WSP(u32x4, WS_SF); const u32x4* RF = WSP(u32x4, WS_RF); const u32x4* YF = WSP(u32x4, WS_YF); const float* BON = WSP(float, WS_BON);
    const bf16_t* VB = WSP(bf16_t, WS_VB); const bf16_t* GG = WSP(bf16_t, WS_G); bf16_t* YG = WSP(bf16_t, WS_YG);
    const int lane = F.lane, q16 = lane & 15, qd = lane >> 4;
    const int gw = F.vcu * NWAVES + F.wave, NGW = F.G * NWAVES;
    for (int job = gw; job < NUNIT * 4; job += NGW) {
        const int unit = job >> 2, tt = job & 3, bh = unit >> 8, ch = unit & 255, b = bh >> 4, h = bh & 15;
        const size_t m = (size_t)b * SEQ + (size_t)ch * CH + 16 * tt + q16;
        const u32x4 r0 = RF[((size_t)unit * 8 + tt * 2 + 0) * 64 + lane], r1 = RF[((size_t)unit * 8 + tt * 2 + 1) * 64 + lane];
        const u32x4 y0 = YF[((size_t)unit * 8 + tt * 2 + 0) * 64 + lane], y1 = YF[((size_t)unit * 8 + tt * 2 + 1) * 64 + lane];
        u32x4 sf[4][2]; u32x2 vw[4], gw_[4];
#pragma unroll
        for (int vt = 0; vt < 4; ++vt) { sf[vt][0] = SF[((size_t)unit * 8 + vt * 2 + 0) * 64 + lane]; sf[vt][1] = SF[((size_t)unit * 8 + vt * 2 + 1) * 64 + lane];
            const size_t off = m * D + h * 64 + 16 * vt + 4 * qd; vw[vt] = *(const u32x2*)(VB + off); gw_[vt] = *(const u32x2*)(GG + off); }
        const float bn = BON[m * 16 + h];
        f32x4 y[4];
        y[0] = unpk4((u32x2){y0.x, y0.y}); y[1] = unpk4((u32x2){y0.z, y0.w}); y[2] = unpk4((u32x2){y1.x, y1.y}); y[3] = unpk4((u32x2){y1.z, y1.w});
#pragma unroll
        for (int vt = 0; vt < 4; ++vt) { y[vt] = MF(*(const bf16x8*)&sf[vt][0], *(const bf16x8*)&r0, y[vt]); y[vt] = MF(*(const bf16x8*)&sf[vt][1], *(const bf16x8*)&r1, y[vt]); }
        float s = 0.f;
#pragma unroll
        for (int vt = 0; vt < 4; ++vt) s += (y[vt][0] + y[vt][1]) + (y[vt][2] + y[vt][3]);
        s += __shfl_xor(s, 16); s += __shfl_xor(s, 32);
        const float mean = s * (1.f / 64.f); float qv = 0.f;
#pragma unroll
        for (int vt = 0; vt < 4; ++vt) { y[vt] = y[vt] - mean; qv += (y[vt][0] * y[vt][0] + y[vt][1] * y[vt][1]) + (y[vt][2] * y[vt][2] + y[vt][3] * y[vt][3]); }
        qv += __shfl_xor(qv, 16); qv += __shfl_xor(qv, 32);
        const float rstd = 1.f / sqrtf(qv * (1.f / 64.f) + LNX_EPS);
#pragma unroll
        for (int vt = 0; vt < 4; ++vt) {
            const int c = h * 64 + 16 * vt + 4 * qd; const size_t off = m * D + c;
            const f32x4 vv = unpk4(vw[vt]), gg = unpk4(gw_[vt]);
            const f32x4 o = ((y[vt] * rstd) * *(const f32x4*)(F.in[19] + c) + *(const f32x4*)(F.in[20] + c) + bn * vv) * gg;
            u32x2 wv; wv.x = cvt_pk_bf16(o[0], o[1]); wv.y = cvt_pk_bf16(o[2], o[3]);
            *(u32x2*)(YG + off) = wv;
        }
    }
}
#undef FRAG
#undef MF

__device__ __forceinline__ void ln_apply(f32x4 (&v)[4], const float* g, const float* b, int lane) {
    float s = 0.f;
#pragma unroll
    for (int j = 0; j < 4; ++j) s += (v[j][0] + v[j][1]) + (v[j][2] + v[j][3]);
    const float mean = wave_sum(s) * (1.f / D); float s2 = 0.f;
#pragma unroll
    for (int j = 0; j < 4; ++j) { v[j] = v[j] - mean; s2 += (v[j][0] * v[j][0] + v[j][1] * v[j][1]) + (v[j][2] * v[j][2] + v[j][3] * v[j][3]); }
    const float rstd = 1.f / sqrtf(wave_sum(s2) * (1.f / D) + LN_EPS);
#pragma unroll
    for (int j = 0; j < 4; ++j) { const int c = 4 * lane + 256 * j; v[j] = v[j] * rstd * *(const f32x4*)(g + c) + *(const f32x4*)(b + c); }
}
__device__ __forceinline__ void mod_store(const f32x4 (&v)[4], const float* shift, const float* scale, bf16_t* orow, int lane) {
#pragma unroll
    for (int j = 0; j < 4; ++j) { const int c = 4 * lane + 256 * j; const f32x4 o = v[j] * (1.f + *(const f32x4*)(scale + c)) + *(const f32x4*)(shift + c);
        u32x2 w; w.x = cvt_pk_bf16(o[0], o[1]); w.y = cvt_pk_bf16(o[2], o[3]); *(u32x2*)(orow + c) = w; }
}
__device__ __forceinline__ void mod_store_q8(const f32x4 (&v)[4], const float* shift, const float* scale, unsigned char* orow, float* rs, int lane) {
    f32x4 o[4]; float mx = 0.f;
#pragma unroll
    for (int j = 0; j < 4; ++j) { const int c = 4 * lane + 256 * j; o[j] = v[j] * (1.f + *(const f32x4*)(scale + c)) + *(const f32x4*)(shift + c);
        mx = fmaxf(mx, fmaxf(fmaxf(fabsf(o[j][0]), fabsf(o[j][1])), fmaxf(fabsf(o[j][2]), fabsf(o[j][3])))); }
#pragma unroll
    for (int of = 1; of < 64; of <<= 1) mx = fmaxf(mx, __shfl_xor(mx, of));
    mx = fmaxf(mx, 1e-20f); const float inv = 127.f / mx;
    if (lane == 0) *rs = mx * (1.f / 127.f);
#pragma unroll
    for (int j = 0; j < 4; ++j) *(unsigned*)(orow + 4 * lane + 256 * j) = pk4_i8(o[j][0] * inv, o[j][1] * inv, o[j][2] * inv, o[j][3] * inv);
}
__device__ __forceinline__ void p_postnorm(Frame& F, const float* xres, const bf16_t* y, float* xout, int sub, int modA, bf16_t* outA, int modB, bf16_t* outB, int modQ = 0, unsigned char* outQ = nullptr, float* rsQ = nullptr) {
    const int gw = F.vcu * NWAVES + F.wave, NGW = F.G * NWAVES;
    const float* MOD = WSP(float, WS_MOD); const float* g = F.in[4] + sub * D; const float* bb = F.in[5] + sub * D;
    for (int m = gw; m < T; m += NGW) {
        const int b = m >> 14; const float* gate = MOD + b * ADA_W + (sub * 3 + 2) * D;
        f32x4 v[4];
#pragma unroll
        for (int j = 0; j < 4; ++j) { const int c = 4 * F.lane + 256 * j;
            const u32x2 yw = *(const u32x2*)(y + (size_t)m * D + c); const f32x4 yv = (f32x4){bflo(yw.x), bfhi(yw.x), bflo(yw.y), bfhi(yw.y)};
            v[j] = DN_ALPHA * *(const f32x4*)(xres + (size_t)m * D + c) + (1.f + *(const f32x4*)(gate + c)) * yv; }
        ln_apply(v, g, bb, F.lane);
#pragma unroll
        for (int j = 0; j < 4; ++j) *(f32x4*)(xout + (size_t)m * D + 4 * F.lane + 256 * j) = v[j];
        if (outA) mod_store(v, MOD + b * ADA_W + modA, MOD + b * ADA_W + modA + D, outA + (size_t)m * D, F.lane);
        if (outB) mod_store(v, MOD + b * ADA_W + modB, MOD + b * ADA_W + modB + D, outB + (size_t)m * D, F.lane);
        if (outQ) mod_store_q8(v, MOD + b * ADA_W + modQ, MOD + b * ADA_W + modQ + D, outQ + (size_t)m * D, rsQ + m, F.lane);
    }
}

constexpr int KS_STRIDE = 72;
constexpr int VT_STRIDE = 264;
__device__ __forceinline__ void p12_attn(Frame& F) {
    LAS bf16_t* Ks = (LAS bf16_t*)F.lds;
    LAS bf16_t* Vt = Ks + 256 * KS_STRIDE;
    const bf16_t* Q2 = WSP(bf16_t, WS_Q2); const bf16_t* K2 = WSP(bf16_t, WS_K2); const bf16_t* V2 = WSP(bf16_t, WS_V2);
    bf16_t* OG = WSP(bf16_t, WS_OG); float* LSE = WSP(float, WS_LSE);
    const int lane = F.lane, w = F.wave, q16 = lane & 15, qd = lane >> 4;
    for (int unit = F.vcu; unit < BATCH * 3 * 8 * 128; unit += F.G) {
        const int pb = unit & 127, hg = (unit >> 7) & 7, gb = unit >> 10, g = gb % 3, b = gb / 3;
        const int dil = g == 0 ? 1 : (g == 1 ? 4 : 16), nb = 128 / dil, phase = pb / nb, blk = pb % nb;
        const int hcol = (g * 8 + hg) * 64;
#pragma unroll
        for (int i = 0; i < 4; ++i) {
            const int ch = F.tid + 512 * i, key = ch >> 3, c8 = (ch & 7) * 8;
            const int pos = (blk - 1) * 128 + key;
            u32x4 kv = (u32x4){0u, 0u, 0u, 0u}, vv = (u32x4){0u, 0u, 0u, 0u};
            if (pos >= 0) { const size_t row = (size_t)b * SEQ + (size_t)pos * dil + phase;
                kv = *(const u32x4*)(K2 + row * QW + hcol + c8); vv = *(const u32x4*)(V2 + row * QW + hcol + c8); }
            *(LAS u32x4*)(Ks + key * KS_STRIDE + c8) = kv;
            Vt[(c8 + 0) * VT_STRIDE + key] = (bf16_t)(vv.x & 0xffff); Vt[(c8 + 1) * VT_STRIDE + key] = (bf16_t)(vv.x >> 16);
            Vt[(c8 + 2) * VT_STRIDE + key] = (bf16_t)(vv.y & 0xffff); Vt[(c8 + 3) * VT_STRIDE + key] = (bf16_t)(vv.y >> 16);
            Vt[(c8 + 4) * VT_STRIDE + key] = (bf16_t)(vv.z & 0xffff); Vt[(c8 + 5) * VT_STRIDE + key] = (bf16_t)(vv.z >> 16);
            Vt[(c8 + 6) * VT_STRIDE + key] = (bf16_t)(vv.w & 0xffff); Vt[(c8 + 7) * VT_STRIDE + key] = (bf16_t)(vv.w >> 16);
        }
        const int qi = 16 * w + q16;
        const size_t qrow = (size_t)b * SEQ + (size_t)(blk * 128 + qi) * dil + phase;
        const bf16x8 qf0 = *(const bf16x8*)(Q2 + qrow * QW + hcol + 8 * qd), qf1 = *(const bf16x8*)(Q2 + qrow * QW + hcol + 32 + 8 * qd);
        __syncthreads();
        const int kt0 = w < 6 ? w : 6;
        f32x4 s[10];
#pragma unroll
        for (int i = 0; i < 10; ++i) {
            const LAS bf16_t* kp = Ks + (16 * (kt0 + i) + q16) * KS_STRIDE + 8 * qd;
            const bf16x8 k0 = *(const LAS bf16x8*)kp, k1 = *(const LAS bf16x8*)(kp + 32);
            f32x4 a = (f32x4){0.f, 0.f, 0.f, 0.f};
            a = __builtin_amdgcn_mfma_f32_16x16x32_bf16(k0, qf0, a, 0, 0, 0);
            a = __builtin_amdgcn_mfma_f32_16x16x32_bf16(k1, qf1, a, 0, 0, 0);
            s[i] = a;
        }
        float mx = -1e30f;
#pragma unroll
        for (int i = 0; i < 10; ++i)
#pragma unroll
            for (int r = 0; r < 4; ++r) { const int kidx = 16 * (kt0 + i) + 4 * qd + r; const bool ok = (kidx >= qi) && (kidx <= qi + 128) && (blk > 0 || kidx >= 128);
                s[i][r] = ok ? s[i][r] : -1e30f; mx = fmaxf(mx, s[i][r]); }
        mx = fmaxf(mx, __shfl_xor(mx, 16)); mx = fmaxf(mx, __shfl_xor(mx, 32));
        float l = 0.f;
#pragma unroll
        for (int i = 0; i < 10; ++i)
#pragma unroll
            for (int r = 0; r < 4; ++r) { const float p = __expf(s[i][r] - mx); s[i][r] = p; l += p; }
        l += __shfl_xor(l, 16); l += __shfl_xor(l, 32);
        f32x4 o[4];
#pragma unroll
        for (int dt = 0; dt < 4; ++dt) o[dt] = (f32x4){0.f, 0.f, 0.f, 0.f};
#pragma unroll
        for (int i = 0; i < 5; ++i) {
            union { bf16x8 v; unsigned u[4]; } pf;
            pf.u[0] = cvt_pk_bf16(s[2 * i][0], s[2 * i][1]); pf.u[1] = cvt_pk_bf16(s[2 * i][2], s[2 * i][3]);
            pf.u[2] = cvt_pk_bf16(s[2 * i + 1][0], s[2 * i + 1][1]); pf.u[3] = cvt_pk_bf16(s[2 * i + 1][2], s[2 * i + 1][3]);
#pragma unroll
            for (int dt = 0; dt < 4; ++dt) {
                const LAS bf16_t* vp = Vt + (16 * dt + q16) * VT_STRIDE + 16 * (kt0 + 2 * i) + 4 * qd;
                union { bf16x8 v; s16x4 h[2]; } vf; vf.h[0] = *(const LAS s16x4*)vp; vf.h[1] = *(const LAS s16x4*)(vp + 16);
                o[dt] = __builtin_amdgcn_mfma_f32_16x16x32_bf16(vf.v, pf.v, o[dt], 0, 0, 0);
            }
        }
        const float il = 1.f / l;
        bf16_t* op = OG + (size_t)g * T * AOUT + qrow * AOUT + hg * 64 + 4 * qd;
#pragma unroll
        for (int dt = 0; dt < 4; ++dt) { u32x2 wv; wv.x = cvt_pk_bf16(o[dt][0] * il, o[dt][1] * il); wv.y = cvt_pk_bf16(o[dt][2] * il, o[dt][3] * il); *(u32x2*)(op + 16 * dt) = wv; }
        if (qd == 0) LSE[(size_t)g * T * 8 + qrow * 8 + hg] = mx + __logf(l);
        __syncthreads();
    }
}
__device__ __forceinline__ void p13_merge(Frame& F) {
    const bf16_t* OG = WSP(bf16_t, WS_OG); const float* LSE = WSP(float, WS_LSE); bf16_t* OM = WSP(bf16_t, WS_OM);
    for (int idx = F.vcu * 512 + F.tid; idx < T * 64; idx += F.G * 512) {
        const int m = idx >> 6, hg = (idx >> 3) & 7, c8 = (idx & 7) * 8;
        const float l0 = LSE[(size_t)0 * T * 8 + m * 8 + hg], l1 = LSE[(size_t)1 * T * 8 + m * 8 + hg], l2 = LSE[(size_t)2 * T * 8 + m * 8 + hg];
        const float mx = fmaxf(l0, fmaxf(l1, l2)); float w0 = __expf(l0 - mx), w1 = __expf(l1 - mx), w2 = __expf(l2 - mx); const float inv = 1.f / (w0 + w1 + w2); w0 *= inv; w1 *= inv; w2 *= inv;
        const size_t off = (size_t)m * AOUT + hg * 64 + c8;
        const u32x4 a = *(const u32x4*)(OG + off), bq = *(const u32x4*)(OG + (size_t)T * AOUT + off), c = *(const u32x4*)(OG + (size_t)2 * T * AOUT + off);
        u32x4 o;
        o.x = cvt_pk_bf16(w0 * bflo(a.x) + w1 * bflo(bq.x) + w2 * bflo(c.x), w0 * bfhi(a.x) + w1 * bfhi(bq.x) + w2 * bfhi(c.x));
        o.y = cvt_pk_bf16(w0 * bflo(a.y) + w1 * bflo(bq.y) + w2 * bflo(c.y), w0 * bfhi(a.y) + w1 * bfhi(bq.y) + w2 * bfhi(c.y));
        o.z = cvt_pk_bf16(w0 * bflo(a.z) + w1 * bflo(bq.z) + w2 * bflo(c.z), w0 * bfhi(a.z) + w1 * bfhi(bq.z) + w2 * bfhi(c.z));
        o.w = cvt_pk_bf16(w0 * bflo(a.w) + w1 * bflo(bq.w) + w2 * bflo(c.w), w0 * bfhi(a.w) + w1 * bfhi(bq.w) + w2 * bfhi(c.w));
        *(u32x4*)(OM + off) = o;
    }
}

__device__ __forceinline__ void p15_ln_route(Frame& F) {
    LAS float* RT = (LAS float*)F.lds;
    LAS int* lcnt = (LAS int*)(F.lds + 32768);
    LAS int* lbase = lcnt + 8;
    LAS int* lte = lcnt + 16;
    LAS int* ltr = lte + 256;
    LAS float* ltw = (LAS float*)(ltr + 256);
    const float* MOD = WSP(float, WS_MOD); const float* g = F.in[4] + 2 * D; const float* bb = F.in[5] + 2 * D;
    const float* X2 = WSP(float, WS_X2); const bf16_t* Y3 = WSP(bf16_t, WS_Y3); float* X3 = F.out; unsigned char* H4 = WSP(unsigned char, WS_H4); float* RSH4 = (float*)(F.ws + WS_ROUTE + RT_RSH4);
    int* TOKE = (int*)(F.ws + WS_ROUTE + RT_TOKE); int* TOKR = (int*)(F.ws + WS_ROUTE + RT_TOKR); float* TOKW = (float*)(F.ws + WS_ROUTE + RT_TOKW);
    int* ROWTOK = (int*)(F.ws + WS_ROUTE + RT_ROWTOK);
    for (int i = F.tid; i < D * 8; i += 512) RT[i] = F.in[27][i];
    for (int i = F.vcu * 512 + F.tid; i < RMAX; i += F.G * 512) ROWTOK[i] = T;
    if (F.vcu == 0) { for (int i = F.tid; i < D / 4; i += 512) ((unsigned*)(H4 + (size_t)T * D))[i] = 0u; if (F.tid == 0) RSH4[T] = 0.f; }
    __syncthreads();
    for (int chunk = F.vcu; chunk < T / 128; chunk += F.G) {
        if (F.tid < 8) lcnt[F.tid] = 0;
        __syncthreads();
        for (int i = 0; i < 16; ++i) {
            const int lr = F.wave * 16 + i, m = chunk * 128 + lr, b = m >> 14;
            const float* gate = MOD + b * ADA_W + (2 * 3 + 2) * D;
            f32x4 v[4];
#pragma unroll
            for (int j = 0; j < 4; ++j) { const int c = 4 * F.lane + 256 * j;
                const u32x2 yw = *(const u32x2*)(Y3 + (size_t)m * D + c); const f32x4 yv = (f32x4){bflo(yw.x), bfhi(yw.x), bflo(yw.y), bfhi(yw.y)};
                v[j] = DN_ALPHA * *(const f32x4*)(X2 + (size_t)m * D + c) + (1.f + *(const f32x4*)(gate + c)) * yv; }
            ln_apply(v, g, bb, F.lane);
#pragma unroll
            for (int j = 0; j < 4; ++j) *(f32x4*)(X3 + (size_t)m * D + 4 * F.lane + 256 * j) = v[j];
            const float* shift = MOD + b * ADA_W + (3 * 3 + 0) * D; const float* scale = MOD + b * ADA_W + (3 * 3 + 1) * D;
            float lg[8];
#pragma unroll
            for (int e = 0; e < 8; ++e) lg[e] = 0.f;
            f32x4 hq[4]; float mx = 0.f;
#pragma unroll
            for (int j = 0; j < 4; ++j) { const int c = 4 * F.lane + 256 * j; const f32x4 hh = v[j] * (1.f + *(const f32x4*)(scale + c)) + *(const f32x4*)(shift + c);
                hq[j] = hh; mx = fmaxf(mx, fmaxf(fmaxf(fabsf(hh[0]), fabsf(hh[1])), fmaxf(fabsf(hh[2]), fabsf(hh[3]))));
#pragma unroll
                for (int q = 0; q < 4; ++q) { const f32x4 r0 = *(const LAS f32x4*)(RT + (c + q) * 8), r1 = *(const LAS f32x4*)(RT + (c + q) * 8 + 4);
                    lg[0] += hh[q] * r0[0]; lg[1] += hh[q] * r0[1]; lg[2] += hh[q] * r0[2]; lg[3] += hh[q] * r0[3];
                    lg[4] += hh[q] * r1[0]; lg[5] += hh[q] * r1[1]; lg[6] += hh[q] * r1[2]; lg[7] += hh[q] * r1[3]; } }
#pragma unroll
            for (int of = 1; of < 64; of <<= 1) mx = fmaxf(mx, __shfl_xor(mx, of));
            mx = fmaxf(mx, 1e-20f); { const float inv = 127.f / mx;
#pragma unroll
                for (int j = 0; j < 4; ++j) *(unsigned*)(H4 + (size_t)m * D + 4 * F.lane + 256 * j) = pk4_i8(hq[j][0] * inv, hq[j][1] * inv, hq[j][2] * inv, hq[j][3] * inv);
                if (F.lane == 0) RSH4[m] = mx * (1.f / 127.f); }
#pragma unroll
            for (int e = 0; e < 8; ++e) lg[e] = wave_sum(lg[e]);
            int e1 = 0; float m1 = lg[0];
#pragma unroll
            for (int e = 1; e < 8; ++e) if (lg[e] > m1) { m1 = lg[e]; e1 = e; }
            int e2 = -1; float m2 = -3.0e38f;
#pragma unroll
            for (int e = 0; e < 8; ++e) if (e != e1 && lg[e] > m2) { m2 = lg[e]; e2 = e; }
            if (e2 < 0) { e2 = (e1 + 1) & 7; m2 = m1; }
            if (F.lane == 0) {
                const float w1 = 1.f / (1.f + __expf(m2 - m1));
                lte[lr * 2] = e1; lte[lr * 2 + 1] = e2; ltw[lr * 2] = w1; ltw[lr * 2 + 1] = 1.f - w1;
                ltr[lr * 2] = atomicAdd((int*)&lcnt[e1], 1); ltr[lr * 2 + 1] = atomicAdd((int*)&lcnt[e2], 1);
            }
        }
        __syncthreads();
        if (F.tid < 8) lbase[F.tid] = (int)__hip_atomic_fetch_add((unsigned*)(F.ctl + CW_CNT + F.tid), (unsigned)lcnt[F.tid], RLX_AGENT);
        __syncthreads();
        if (F.tid < 256) { const int m = chunk * 128 + (F.tid >> 1), s = F.tid & 1; const int e = lte[F.tid];
            TOKE[m * 2 + s] = e; TOKR[m * 2 + s] = lbase[e] + ltr[F.tid]; TOKW[m * 2 + s] = ltw[F.tid]; }
        __syncthreads();
    }
}
__device__ __forceinline__ void p16_place(Frame& F) {
    int* TOKE = (int*)(F.ws + WS_ROUTE + RT_TOKE); int* TOKR = (int*)(F.ws + WS_ROUTE + RT_TOKR);
    int* ROWTOK = (int*)(F.ws + WS_ROUTE + RT_ROWTOK); int* BLKEXP = (int*)(F.ws + WS_ROUTE + RT_BLKEXP);
    int pstart[8], pend[8]; int acc = 0;
#pragma unroll
    for (int e = 0; e < 8; ++e) { const int c = (int)__hip_atomic_load((unsigned*)(F.ctl + CW_CNT + e), RLX_AGENT); pstart[e] = acc; acc += (c + 255) / 256 * 256; pend[e] = acc; }
    for (int idx = F.vcu * 512 + F.tid; idx < T * 2; idx += F.G * 512) {
        const int e = TOKE[idx]; int ps = 0;
#pragma unroll
        for (int j = 0; j < 8; ++j) ps = (e == j) ? pstart[j] : ps;
        const int dest = ps + TOKR[idx]; ROWTOK[dest] = idx >> 1; TOKR[idx] = dest;
    }
    if (F.vcu == 0) {
        for (int blk = F.tid; blk < NBLKMAX; blk += 512) { int e = 0;
#pragma unroll
            for (int j = 0; j < 8; ++j) e += (pend[j] <= blk * 256) ? 1 : 0;
            BLKEXP[blk] = e < 8 ? e : 7; }
        if (F.tid == 0) __hip_atomic_store((unsigned*)(F.ctl + CW_NBLK), (unsigned)(acc / 256), RLX_AGENT);
    }
}
__device__ __forceinline__ void p19_final(Frame& F) {
    const int gw = F.vcu * NWAVES + F.wave, NGW = F.G * NWAVES;
    const float* MOD = WSP(float, WS_MOD); const float* g = F.in[4] + 3 * D; const float* bb = F.in[5] + 3 * D;
    const bf16_t* YB = WSP(bf16_t, WS_YB); const int* TOKR = (const int*)(F.ws + WS_ROUTE + RT_TOKR); const float* TOKW = (const float*)(F.ws + WS_ROUTE + RT_TOKW);
    float* X = F.out;
    for (int m = gw; m < T; m += NGW) {
        const int b = m >> 14; const float* gate = MOD + b * ADA_W + (3 * 3 + 2) * D;
        const int d0 = TOKR[m * 2], d1 = TOKR[m * 2 + 1]; const float w0 = TOKW[m * 2], w1 = TOKW[m * 2 + 1];
        f32x4 v[4];
#pragma unroll
        for (int j = 0; j < 4; ++j) { const int c = 4 * F.lane + 256 * j;
            const u32x2 a = *(const u32x2*)(YB + (size_t)d0 * D + c), q = *(const u32x2*)(YB + (size_t)d1 * D + c);
            const f32x4 y = (f32x4){w0 * bflo(a.x) + w1 * bflo(q.x), w0 * bfhi(a.x) + w1 * bfhi(q.x), w0 * bflo(a.y) + w1 * bflo(q.y), w0 * bfhi(a.y) + w1 * bfhi(q.y)};
            v[j] = DN_ALPHA * *(const f32x4*)(X + (size_t)m * D + c) + (1.f + *(const f32x4*)(gate + c)) * y; }
        ln_apply(v, g, bb, F.lane);
#pragma unroll
        for (int j = 0; j < 4; ++j) *(f32x4*)(X + (size_t)m * D + 4 * F.lane + 256 * j) = v[j];
    }
}

struct Args { const float* in[30]; float* out; unsigned char* ws; int ph_lo, ph_hi, li, pad; };
__global__ void __launch_bounds__(NWAVES * 64, 2) fwd(Args args) {
    extern __shared__ __attribute__((aligned(16))) unsigned char lds[];
    Frame F;
    F.lds = (LAS unsigned char*)lds;
    F.MISC = (volatile LAS unsigned*)(F.lds + MISC_OFF);
    F.tid = threadIdx.x; F.lane = F.tid & 63; F.wave = __builtin_amdgcn_readfirstlane(F.tid >> 6);
    F.G = gridDim.x; { const int bx = blockIdx.x; F.vcu = (F.G % 8 == 0) ? (bx % 8) * (F.G / 8) + bx / 8 : bx; }
    F.ws = args.ws; F.ctl = (gu32*)(args.ws + WS_CTL); F.out = args.out;
    F.in = args.in;
    for (int u = F.tid; u < (LDS_BYTES - LDSCTL_OFF) / 4; u += NWAVES * 64) ((LAS unsigned*)(F.lds + LDSCTL_OFF))[u] = 0u;
    __syncthreads();
    XcdBarrier bar; bar.bar = (unsigned*)(F.ctl + CW_BAR); bar.x = 0; bar.st = nullptr;
    if (N_LAUNCHES != NPH) bar = xcd_barrier_post((unsigned*)(F.ctl + CW_BAR) + args.li * XCD_BAR_WORDS, F.MISC + 8);
#define GRID_BAR() do { if (N_LAUNCHES != NPH) xcd_barrier(bar); } while (0)
    const int lo = args.ph_lo, hi = args.ph_hi;
#define IN(k) (lo <= (k) && (k) < hi)
#define BOTH(k) (IN(k) && IN((k) + 1))
    using namespace pg8;
    const int cid = (int)blockIdx.x;

    if (IN(0)) { p0_prologue(F); if (BOTH(0)) GRID_BAR(); }
    if (IN(1)) { p1_lerp(F); if (BOTH(1)) GRID_BAR(); }
    if (IN(2)) {
        Gemm g{WSP(bf16_t, WS_A6) + (size_t)3 * T * D, WSP(bf16_t, WS_WL1), D, D, (size_t)T * D * 2, (size_t)256 * D * 2, nullptr, nullptr, 0};
        StaticOrder S; S.init(T / 256, 1, 3, F.G, cid);
        EpiBf16Z<1, 0, 2> E{WSP(bf16_t, WS_L1), 256, (size_t)T * 256};
        gemm_phase<EpiBf16Z<1, 0, 2>, StaticOrder, true>(F.lds, g, S, E);
        if (BOTH(2)) GRID_BAR();
    }
    if (IN(3)) {
        { Gemm g{WSP(bf16_t, WS_A6), WSP(bf16_t, WS_WRKV), D, D, (size_t)T * D * 2, (size_t)D * D * 2, nullptr, nullptr, 0};
          StaticOrder S; S.init(T / 256, D / 256, 3, F.G, cid);
          EpiBf16Z<0, 0, 0> E{WSP(bf16_t, WS_RB), D, (size_t)T * D};
          gemm_phase<EpiBf16Z<0, 0, 0>, StaticOrder, true>(F.lds, g, S, E); }
        { Gemm g{WSP(bf16_t, WS_L1), WSP(bf16_t, WS_WL2), 256, 256, (size_t)T * 256 * 2, (size_t)D * 256 * 2, nullptr, nullptr, 0};
          StaticOrder S; S.init(T / 256, D / 256, 3, F.G, cid);
          EpiLora2 E{F.out, WSP(bf16_t, WS_AS), WSP(bf16_t, WS_G), F.in[8], F.in[11]};
          gemm_phase<EpiLora2, StaticOrder, true>(F.lds, g, S, E); }
        if (BOTH(3)) GRID_BAR();
    }
    if (IN(4)) { p4a_chunk(F); GRID_BAR(); p4b_chain(F); if (BOTH(4)) GRID_BAR(); }
    if (IN(5)) { p5_chunk_out(F); if (BOTH(5)) GRID_BAR(); }
    if (IN(6)) {
        Gemm g{WSP(bf16_t, WS_YG), WSP(bf16_t, WS_WOUT), D, D, 0, 0, nullptr, nullptr, 0};
        StaticOrder S; S.init(T / 256, D / 256, 1, F.G, cid);
        EpiBf16Z<0, 0, 0> E{WSP(bf16_t, WS_Y1), D, 0};
        gemm_phase<EpiBf16Z<0, 0, 0>, StaticOrder, true>(F.lds, g, S, E);
        if (BOTH(6)) GRID_BAR();
    }
    if (IN(7)) { p_postnorm(F, F.in[0], WSP(bf16_t, WS_Y1), WSP(float, WS_X1), 0, 0, nullptr, 0, nullptr, (1 * 3 + 0) * D, WSP(unsigned char, WS_H2), WSP(float, WS_RSH2)); if (BOTH(7)) GRID_BAR(); }
    if (IN(8)) {
        Gemm g{WSP(bf16_t, WS_H2), WSP(bf16_t, WS_WFGU), D / 2, D / 2, 0, 0, nullptr, nullptr, 0};
        StaticOrder S; S.init(T / 256, 2 * DFF / 256, 1, F.G, cid);
        EpiSwigluQ E{WSP(bf16_t, WS_ACT), DFF, WSP(float, WS_RSH2), nullptr, QW_STEP};
        gemm_phase<EpiSwigluQ, StaticOrder, true, 1>(F.lds, g, S, E);
        if (BOTH(8)) GRID_BAR();
    }
    if (IN(9)) {
        Gemm g{WSP(bf16_t, WS_ACT), WSP(bf16_t, WS_WFDN), DFF, DFF, 0, 0, nullptr, nullptr, 0};
        StaticOrder S; S.init(T / 256, D / 256, 1, F.G, cid);
        EpiBf16Z<0, 0, 0> E{WSP(bf16_t, WS_Y2), D, 0};
        gemm_phase<EpiBf16Z<0, 0, 0>, StaticOrder, true>(F.lds, g, S, E);
        if (BOTH(9)) GRID_BAR();
    }
    if (IN(10)) { p_postnorm(F, WSP(float, WS_X1), WSP(bf16_t, WS_Y2), WSP(float, WS_X2), 1, 12 * D, WSP(bf16_t, WS_HKV), (2 * 3 + 0) * D, WSP(bf16_t, WS_H3)); if (BOTH(10)) GRID_BAR(); }
    if (IN(11)) {
        const float* cs = WSP(float, WS_ROPE); const float* sn = cs + SEQ * 32;
        { Gemm g{WSP(bf16_t, WS_HKV), WSP(bf16_t, WS_WKV), D, D, 0, 0, nullptr, nullptr, 0};
          StaticOrder S; S.init(T / 256, 2 * QW / 256, 1, F.G, cid);
          EpiRope E{WSP(bf16_t, WS_K2), WSP(bf16_t, WS_V2), QW, cs, sn, 1.f};
          gemm_phase<EpiRope, StaticOrder, true>(F.lds, g, S, E); }
        { Gemm g{WSP(bf16_t, WS_H3), WSP(bf16_t, WS_WQ), D, D, 0, 0, nullptr, nullptr, 0};
          StaticOrder S; S.init(T / 256, QW / 256, 1, F.G, cid);
          EpiRope E{WSP(bf16_t, WS_Q2), WSP(bf16_t, WS_Q2), QW, cs, sn, 0.125f};
          gemm_phase<EpiRope, StaticOrder, true>(F.lds, g, S, E); }
        if (BOTH(11)) GRID_BAR();
    }
    if (IN(12)) { p12_attn(F); if (BOTH(12)) GRID_BAR(); }
    if (IN(13)) { p13_merge(F); if (BOTH(13)) GRID_BAR(); }
    if (IN(14)) {
        Gemm g{WSP(bf16_t, WS_OM), WSP(bf16_t, WS_WO), AOUT, AOUT, 0, 0, nullptr, nullptr, 0};
        StaticOrder S; S.init(T / 256, D / 256, 1, F.G, cid);
        EpiBf16Z<0, 0, 0> E{WSP(bf16_t, WS_Y3), D, 0};
        gemm_phase<EpiBf16Z<0, 0, 0>, StaticOrder, true>(F.lds, g, S, E);
        if (BOTH(14)) GRID_BAR();
    }
    if (IN(15)) { p15_ln_route(F); if (BOTH(15)) GRID_BAR(); }
    if (IN(16)) { p16_place(F); if (BOTH(16)) GRID_BAR(); }
    if (IN(17)) {
        const int nblk = (int)__hip_atomic_load((unsigned*)(F.ctl + CW_NBLK), RLX_AGENT);
        Gemm g{WSP(bf16_t, WS_H4), WSP(bf16_t, WS_WMGU), D / 2, D / 2, 0, 0, (const int*)(F.ws + WS_ROUTE + RT_ROWTOK), (const int*)(F.ws + WS_ROUTE + RT_BLKEXP), (size_t)2 * DFE * D};
        StaticOrder S; S.init(nblk, 2 * DFE / 256, 1, F.G, cid);
        EpiSwigluQ E{WSP(bf16_t, WS_ACT2), DFE, (const float*)(F.ws + WS_ROUTE + RT_RSH4), (const int*)(F.ws + WS_ROUTE + RT_ROWTOK), QW_STEP};
        gemm_phase<EpiSwigluQ, StaticOrder, true, 1>(F.lds, g, S, E);
        if (BOTH(17)) GRID_BAR();
    }
    if (IN(18)) {
        const int nblk = (int)__hip_atomic_load((unsigned*)(F.ctl + CW_NBLK), RLX_AGENT);
        Gemm g{WSP(bf16_t, WS_ACT2), WSP(bf16_t, WS_WMDN), DFE, DFE, 0, 0, nullptr, (const int*)(F.ws + WS_ROUTE + RT_BLKEXP), (size_t)D * DFE * 2};
        StaticOrder S; S.init(nblk, D / 256, 1, F.G, cid);
        EpiBf16Z<0, 0, 0> E{WSP(bf16_t, WS_YB), D, 0};
        gemm_phase<EpiBf16Z<0, 0, 0>, StaticOrder, true>(F.lds, g, S, E);
        if (BOTH(18)) GRID_BAR();
    }
    if (IN(19)) { p19_final(F); }
#undef IN
#undef BOTH
}

extern "C" void kernel_launch(void* const* d_in, const int* in_sizes, int n_in, void* d_out, int out_size, void* d_ws, size_t ws_size, hipStream_t stream) {
    static int grid = 0;
    if (grid == 0) {
        if (n_in != 30 || in_sizes[0] != T * D || out_size != T * D || ws_size < WS_END) { fprintf(stderr, "kernel_launch: unexpected shapes / workspace (%d inputs, ws %zu)\n", n_in, ws_size); grid = -1; return; }
        int dev = 0, cus = 0, per_cu = 0;
        if (hipGetDevice(&dev) != hipSuccess || hipDeviceGetAttribute(&cus, hipDeviceAttributeMultiprocessorCount, dev) != hipSuccess) { grid = -1; return; }
        if (hipFuncSetAttribute((const void*)fwd, hipFuncAttributeMaxDynamicSharedMemorySize, LDS_BYTES) != hipSuccess) { fprintf(stderr, "kernel_launch: hipFuncSetAttribute failed\n"); grid = -1; return; }
        if (hipOccupancyMaxActiveBlocksPerMultiprocessor(&per_cu, (const void*)fwd, NWAVES * 64, LDS_BYTES) != hipSuccess || per_cu < 1)
            fprintf(stderr, "kernel_launch: occupancy query reports %d workgroups per CU\n", per_cu);
        (void)hipGetLastError();
        grid = cus;
    }
    if (grid < 0) return;
    if (hipMemsetAsync((char*)d_ws + WS_CTL, 0, CTL_ZERO_BYTES, stream) != hipSuccess) return;
    Args a{};
    for (int i = 0; i < 30; ++i) a.in[i] = (const float*)d_in[i];
    a.out = (float*)d_out; a.ws = (unsigned char*)d_ws;
    for (int li = 0; li < N_LAUNCHES; ++li) {
        a.ph_lo = (N_LAUNCHES == NPH) ? li : 0; a.ph_hi = (N_LAUNCHES == NPH) ? li + 1 : NPH; a.li = (N_LAUNCHES == NPH) ? 0 : li;
        hipLaunchKernelGGL(fwd, dim3(grid), dim3(NWAVES * 64), LDS_BYTES, stream, a);
        if (hipPeekAtLastError() != hipSuccess) { fprintf(stderr, "kernel_launch: launch %d failed\n", li); break; }
    }
}
```

```cpp
#include <hip/hip_runtime.h>
#include <cstdio>
#include <cstdint>

#define LAS __attribute__((address_space(3)))
#define GAS __attribute__((address_space(1)))
typedef unsigned short bf16_t;
typedef short bf16x8 __attribute__((ext_vector_type(8)));
typedef short s16x4 __attribute__((ext_vector_type(4)));
typedef float f32x4 __attribute__((ext_vector_type(4)));
typedef float f32x2 __attribute__((ext_vector_type(2)));
typedef unsigned u32x4 __attribute__((ext_vector_type(4)));
typedef unsigned u32x2 __attribute__((ext_vector_type(2)));
typedef GAS unsigned gu32;
#define RLX_AGENT __ATOMIC_RELAXED, __HIP_MEMORY_SCOPE_AGENT

typedef __bf16 bf16x2_t __attribute__((ext_vector_type(2)));
__device__ __forceinline__ unsigned cvt_pk_bf16(float lo, float hi) { const f32x2 v = {lo, hi}; const bf16x2_t b = __builtin_convertvector(v, bf16x2_t); return __builtin_bit_cast(unsigned, b); }
typedef int i32x4 __attribute__((ext_vector_type(4)));
__device__ __forceinline__ unsigned q8u(float x) { return (unsigned)(int)fminf(fmaxf(rintf(x), -127.f), 127.f) & 0xffu; }
__device__ __forceinline__ unsigned pk4_i8(float a, float b, float c, float d) { return q8u(a) | (q8u(b) << 8) | (q8u(c) << 16) | (q8u(d) << 24); }
constexpr float QW_STEP = 4.0f / (32.0f * 127.0f), QW_INV = 1.0f / QW_STEP;
__device__ __forceinline__ float bflo(unsigned w) { return __uint_as_float(w << 16); }
__device__ __forceinline__ float bfhi(unsigned w) { return __uint_as_float(w & 0xffff0000u); }
__device__ __forceinline__ float sigmoidf_(float x) { return 1.f / (1.f + __expf(-x)); }
__device__ __forceinline__ float tanhf_(float x) { return 1.f - 2.f / (1.f + __expf(2.f * x)); }
__device__ __forceinline__ float siluf_(float x) { return x / (1.f + __expf(-x)); }
__device__ __forceinline__ int ld_i32(const int* p) { return (int)__hip_atomic_load((const unsigned*)p, RLX_AGENT); }

constexpr int BATCH = 2, SEQ = 16384, D = 1024, T = BATCH * SEQ;
constexpr int ADA_W = 14336;
constexpr int DFF = 2816, NEXP = 8, DFE = 3584;
constexpr int QW = 1536, AOUT = 512;
constexpr int RMAX = (T * 2 / 256 + NEXP) * 256;
constexpr int NBLKMAX = RMAX / 256;
constexpr float LN_EPS = 1e-5f, LNX_EPS = 64e-5f;
constexpr float DN_ALPHA = 1.4142135623730951f;

namespace pg8 {
constexpr int BM = 256, BK = 64, HALF = 128, HTB = HALF * BK * 2, STAGE_BYTES = 8 * HTB, NXCD = 8, WGM = 8;
__host__ __device__ __forceinline__ int lds_byte(int r, int c) { const int st = (r >> 4) * 2 + (c >> 5), rr = r & 15, cc = c & 31, ob = rr * 64 + cc * 2; return st * 1024 + (ob ^ (((ob >> 9) & 1) << 5)); }
__host__ __device__ __forceinline__ void stage_rc(int b, int& R, int& C) { const int st = b / 1024, sb = b % 1024, swz = sb ^ (((sb >> 9) & 1) << 5); R = (st >> 1) * 16 + swz / 64; C = (st & 1) * 32 + (swz % 64) / 2; }
__host__ __device__ __forceinline__ int perm32(int rho) { const int n = rho >> 4, i = rho & 15; return 8 * (i >> 2) + 4 * n + (i & 3); }

struct Unit { int pm, pn, z; };
struct Gemm { const bf16_t* A; const bf16_t* Bt; int K, lda; size_t azs, bzs; const int* rowmap; const int* blk_exp; size_t bes; };

struct StaticOrder {
    int nM, nN, nZ, nwg, G, c;
    __device__ void init(int nM_, int nN_, int nZ_, int G_, int c_) { nM = nM_; nN = nN_; nZ = nZ_; nwg = nM * nN; G = G_; c = c_; }
    __device__ bool next(int i, Unit& u) const {
        const long L = (long)i * G + c; if (L >= (long)nwg * nZ) return false;
        u.z = (int)(L / nwg); int wgid = (int)(L % nwg);
        { const int q = nwg / NXCD, r = nwg % NXCD, xcd = wgid % NXCD, off = wgid / NXCD; wgid = (xcd < r ? xcd * (q + 1) : r * (q + 1) + (xcd - r) * q) + off; }
        const int nig = WGM * nN, gid = wgid / nig, fm = gid * WGM, gsz = (nM - fm) < WGM ? (nM - fm) : WGM;
        u.pm = fm + ((wgid % nig) % gsz); u.pn = (wgid % nig) / gsz; return true;
    }
};

#define EPI_LOOP_BEGIN \
    const int row0 = u.pm * BM + wr * 64 + fr, col0 = u.pn * BM + wc * 32 + 8 * fq; \
    _Pragma("unroll") for (int ai = 0; ai < 2; ++ai) _Pragma("unroll") for (int m = 0; m < 4; ++m) { const int row = row0 + ai * HALF + m * 16; \
    _Pragma("unroll") for (int bj = 0; bj < 2; ++bj) { const int col = col0 + bj * HALF; f32x4 v0 = acc[ai][bj][m][0], v1 = acc[ai][bj][m][1];
#define EPI_LOOP_END } }

__device__ __forceinline__ float act_apply(int a, float x) { return a == 1 ? tanhf_(x) : (a == 2 ? sigmoidf_(x) : x); }
template <int ACT0, int ACT1, int ACT2> struct EpiBf16Z {
    static constexpr bool PERM = true;
    bf16_t* O; int ldc; size_t ozs;
    __device__ __forceinline__ void operator()(const f32x4 (&acc)[2][2][4][2], const Unit& u, int wr, int wc, int fr, int fq) const {
        const int a = u.z == 0 ? ACT0 : (u.z == 1 ? ACT1 : ACT2); bf16_t* base = O + (size_t)u.z * ozs;
        EPI_LOOP_BEGIN
            if (a) { _Pragma("unroll") for (int e = 0; e < 4; ++e) { v0[e] = act_apply(a, v0[e]); v1[e] = act_apply(a, v1[e]); } }
            u32x4 w; w.x = cvt_pk_bf16(v0[0], v0[1]); w.y = cvt_pk_bf16(v0[2], v0[3]); w.z = cvt_pk_bf16(v1[0], v1[1]); w.w = cvt_pk_bf16(v1[2], v1[3]);
            *(u32x4*)(base + (size_t)row * ldc + col) = w;
        EPI_LOOP_END
    }
};
struct EpiLora2 {
    static constexpr bool PERM = true;
    float* WLOG; bf16_t* AS; bf16_t* G; const float* w0; const float* a0;
    __device__ __forceinline__ void operator()(const f32x4 (&acc)[2][2][4][2], const Unit& u, int wr, int wc, int fr, int fq) const {
        EPI_LOOP_BEGIN
            if (u.z == 0) {
                const f32x4 b0 = *(const f32x4*)(w0 + col), b1 = *(const f32x4*)(w0 + col + 4);
                _Pragma("unroll") for (int e = 0; e < 4; ++e) {
                    float x = -(v0[e] + b0[e]); float sp = fmaxf(x, 0.f) + __logf(1.f + __expf(-fabsf(x))); v0[e] = -__expf(-sp - 0.5f);
                    x = -(v1[e] + b1[e]); sp = fmaxf(x, 0.f) + __logf(1.f + __expf(-fabsf(x))); v1[e] = -__expf(-sp - 0.5f); }
                float* p = WLOG + (size_t)row * D + col; *(f32x4*)p = v0; *(f32x4*)(p + 4) = v1;
            } else {
                if (u.z == 1) { const f32x4 b0 = *(const f32x4*)(a0 + col), b1 = *(const f32x4*)(a0 + col + 4);
                    _Pragma("unroll") for (int e = 0; e < 4; ++e) { v0[e] = sigmoidf_(v0[e] + b0[e]); v1[e] = sigmoidf_(v1[e] + b1[e]); } }
                u32x4 w; w.x = cvt_pk_bf16(v0[0], v0[1]); w.y = cvt_pk_bf16(v0[2], v0[3]); w.z = cvt_pk_bf16(v1[0], v1[1]); w.w = cvt_pk_bf16(v1[2], v1[3]);
                *(u32x4*)((u.z == 1 ? AS : G) + (size_t)row * D + col) = w;
            }
        EPI_LOOP_END
    }
};
struct EpiF32 {
    static constexpr bool PERM = true;
    float* O; int ldc;
    __device__ __forceinline__ void operator()(const f32x4 (&acc)[2][2][4][2], const Unit& u, int wr, int wc, int fr, int fq) const {
        EPI_LOOP_BEGIN
            float* p = O + (size_t)row * ldc + col; *(f32x4*)p = v0; *(f32x4*)(p + 4) = v1;
        EPI_LOOP_END
    }
};
struct EpiSwiglu {
    static constexpr bool PERM = true;
    bf16_t* O; int ldo;
    __device__ __forceinline__ void operator()(const f32x4 (&acc)[2][2][4][2], const Unit& u, int wr, int wc, int fr, int fq) const {
        EPI_LOOP_BEGIN
            u32x2 w; w.x = cvt_pk_bf16(siluf_(v0[0]) * v0[1], siluf_(v0[2]) * v0[3]); w.y = cvt_pk_bf16(siluf_(v1[0]) * v1[1], siluf_(v1[2]) * v1[3]);
            *(u32x2*)(O + (size_t)row * ldo + (col >> 1)) = w;
        EPI_LOOP_END
    }
};
struct EpiBf16Q {
    static constexpr bool PERM = true;
    bf16_t* O; int ldc; size_t ozs; const float* rs; size_t rzs; float ws;
    __device__ __forceinline__ void operator()(const f32x4 (&acc)[2][2][4][2], const Unit& u, int wr, int wc, int fr, int fq) const {
        bf16_t* base = O + (size_t)u.z * ozs; const float* r_ = rs + (size_t)u.z * rzs;
        EPI_LOOP_BEGIN
            const float sc = r_[row] * ws; v0 = v0 * sc; v1 = v1 * sc;
            u32x4 w; w.x = cvt_pk_bf16(v0[0], v0[1]); w.y = cvt_pk_bf16(v0[2], v0[3]); w.z = cvt_pk_bf16(v1[0], v1[1]); w.w = cvt_pk_bf16(v1[2], v1[3]);
            *(u32x4*)(base + (size_t)row * ldc + col) = w;
        EPI_LOOP_END
    }
};
struct EpiSwigluQ {
    static constexpr bool PERM = true;
    bf16_t* O; int ldo; const float* rs; const int* rowmap; float ws;
    __device__ __forceinline__ void operator()(const f32x4 (&acc)[2][2][4][2], const Unit& u, int wr, int wc, int fr, int fq) const {
        const int row0 = u.pm * BM + wr * 64 + fr, col0 = u.pn * BM + wc * 32 + 8 * fq;
#pragma unroll
        for (int ai = 0; ai < 2; ++ai)
#pragma unroll
            for (int m = 0; m < 4; ++m) { const int row = row0 + ai * HALF + m * 16; const float sc = rs[rowmap ? rowmap[row] : row] * ws;
#pragma unroll
                for (int bj = 0; bj < 2; ++bj) { const int col = col0 + bj * HALF; const f32x4 v0 = acc[ai][bj][m][0] * sc, v1 = acc[ai][bj][m][1] * sc;
                    u32x2 w; w.x = cvt_pk_bf16(siluf_(v0[0]) * v0[1], siluf_(v0[2]) * v0[3]); w.y = cvt_pk_bf16(siluf_(v1[0]) * v1[1], siluf_(v1[2]) * v1[3]);
                    *(u32x2*)(O + (size_t)row * ldo + (col >> 1)) = w; } }
    }
};
struct EpiRope {
    static constexpr bool PERM = true;
    bf16_t* O; bf16_t* O2; int ncol_rope; const float* cs; const float* sn; float scale; const float* rs; float ws;
    __device__ __forceinline__ void operator()(const f32x4 (&acc)[2][2][4][2], const Unit& u, int wr, int wc, int fr, int fq) const {
        EPI_LOOP_BEGIN
            if (rs) { const float sc = rs[row] * ws; v0 = v0 * sc; v1 = v1 * sc; }
            bf16_t* dst;
            if (col < ncol_rope) {
                const int t = row & (SEQ - 1), i0 = (col & 63) >> 1;
                const f32x4 c4 = *(const f32x4*)(cs + (size_t)t * 32 + i0), s4 = *(const f32x4*)(sn + (size_t)t * 32 + i0);
                float a, b;
                a = v0[0]; b = v0[1]; v0[0] = (a * c4[0] - b * s4[0]) * scale; v0[1] = (b * c4[0] + a * s4[0]) * scale;
                a = v0[2]; b = v0[3]; v0[2] = (a * c4[1] - b * s4[1]) * scale; v0[3] = (b * c4[1] + a * s4[1]) * scale;
                a = v1[0]; b = v1[1]; v1[0] = (a * c4[2] - b * s4[2]) * scale; v1[1] = (b * c4[2] + a * s4[2]) * scale;
                a = v1[2]; b = v1[3]; v1[2] = (a * c4[3] - b * s4[3]) * scale; v1[3] = (b * c4[3] + a * s4[3]) * scale;
                dst = O + (size_t)row * ncol_rope + col;
            } else dst = O2 + (size_t)row * ncol_rope + (col - ncol_rope);
            u32x4 w; w.x = cvt_pk_bf16(v0[0], v0[1]); w.y = cvt_pk_bf16(v0[2], v0[3]); w.z = cvt_pk_bf16(v1[0], v1[1]); w.w = cvt_pk_bf16(v1[2], v1[3]);
            *(u32x4*)dst = w;
        EPI_LOOP_END
    }
};

template <class Epi, class Sched, bool ALIGN_EPI, int MODE = 0>
__device__ __forceinline__ void gemm_phase(LAS unsigned char* lds, const Gemm g, const Sched& S, const Epi& E) {
    const int tid = threadIdx.x, wid = __builtin_amdgcn_readfirstlane(tid >> 6), lane = tid & 63, wr = wid >> 2, wc = wid & 3, fr = lane & 15, fq = lane >> 4;
    const int K = g.K, nt = K / BK;
    int RA[2], CA[2]; unsigned voffB[2];
#pragma unroll
    for (int i = 0; i < 2; ++i) { int R, C; stage_rc(tid * 16 + i * 8192, R, C); const int Rb = Epi::PERM ? ((R & ~31) + perm32(R & 31)) : R;
        RA[i] = R; CA[i] = C; voffB[i] = (unsigned)(Rb * K + C) * 2u; }
    const size_t kstep = (size_t)(BK * 2);
    const size_t hstepB = (size_t)HALF * K * 2, tstepB = 2 * hstepB;
    const unsigned ldsw = (unsigned)wid * 1024u;
    const int aoff = lds_byte(wr * 64 + fr, fq * 8), boff = lds_byte(wc * 32 + fr, fq * 8);
#define PG8_SA(b, h) (((b) * 2 + (h)) * HTB)
#define PG8_SB(b, h) ((4 + (b) * 2 + (h)) * HTB)
#define PG8_STAGE(bufoff, gbase, voff) do { _Pragma("unroll") for (int _i = 0; _i < 2; ++_i) \
        __builtin_amdgcn_global_load_lds((const unsigned*)((const char*)(gbase) + (voff)[_i]), (LAS unsigned*)(lds + (bufoff) + ldsw + _i * 8192), 16, 0, 0); } while (0)
#define PG8_VOFFA(v, uu) do { _Pragma("unroll") for (int _h = 0; _h < 2; ++_h) _Pragma("unroll") for (int _i = 0; _i < 2; ++_i) { int _row = (uu).pm * BM + _h * HALF + RA[_i]; \
        if (g.rowmap) _row = g.rowmap[_row]; (v)[_h][_i] = (unsigned)((size_t)(uu).z * g.azs) + (unsigned)(_row * g.lda + CA[_i]) * 2u; } } while (0)
#define PG8_BBASE(uu) ((const char*)g.Bt + (size_t)(uu).z * g.bzs + (g.blk_exp ? (size_t)ld_i32(g.blk_exp + (uu).pm) * g.bes : (size_t)0) + (size_t)(uu).pn * tstepB)
#define PG8_LDA(dst, b, h) do { _Pragma("unroll") for (int m = 0; m < 4; ++m) _Pragma("unroll") for (int k = 0; k < 2; ++k) dst[m][k] = *(const LAS bf16x8*)(lds + PG8_SA(b, h) + aoff + m * 2048 + k * 1024); } while (0)
#define PG8_LDB(dst, b, h) do { _Pragma("unroll") for (int n = 0; n < 2; ++n) _Pragma("unroll") for (int k = 0; k < 2; ++k) dst[n][k] = *(const LAS bf16x8*)(lds + PG8_SB(b, h) + boff + n * 2048 + k * 1024); } while (0)
#define PG8_MMA(ai, bj, At, Bt) do { __builtin_amdgcn_s_setprio(1); _Pragma("unroll") for (int m = 0; m < 4; ++m) _Pragma("unroll") for (int n = 0; n < 2; ++n) _Pragma("unroll") for (int k = 0; k < 2; ++k) { \
        if constexpr (MODE == 1) acc[ai][bj][m][n] = __builtin_bit_cast(f32x4, __builtin_amdgcn_mfma_i32_16x16x64_i8(__builtin_bit_cast(i32x4, Bt[n][k]), __builtin_bit_cast(i32x4, At[m][k]), __builtin_bit_cast(i32x4, acc[ai][bj][m][n]), 0, 0, 0)); \
        else acc[ai][bj][m][n] = __builtin_amdgcn_mfma_f32_16x16x32_bf16(Bt[n][k], At[m][k], acc[ai][bj][m][n], 0, 0, 0); } __builtin_amdgcn_s_setprio(0); } while (0)
#define PG8_WAIT_V(n) asm volatile("s_waitcnt vmcnt(" #n ")" ::: "memory")
#define PG8_WAIT_L(n) asm volatile("s_waitcnt lgkmcnt(" #n ")" ::: "memory")
#define PG8_BAR __builtin_amdgcn_s_barrier()
#define PG8_SCHED __builtin_amdgcn_sched_barrier(0)
    Unit cur, nxt; int ui = 0;
    if (!S.next(0, cur)) return;
    f32x4 acc[2][2][4][2];
#pragma unroll
    for (int a = 0; a < 2; ++a)
#pragma unroll
        for (int b = 0; b < 2; ++b)
#pragma unroll
            for (int m = 0; m < 4; ++m)
#pragma unroll
                for (int n = 0; n < 2; ++n) acc[a][b][m][n] = (f32x4){0.f, 0.f, 0.f, 0.f};
    bf16x8 At[4][2], B0[2][2], B1[2][2];
    unsigned vc[2][2], vn[2][2];
    const char* const Ab = (const char*)g.A;
    const char* cB = PG8_BBASE(cur);
    PG8_VOFFA(vc, cur);
    PG8_STAGE(PG8_SB(0, 0), cB, voffB); PG8_STAGE(PG8_SB(0, 1), cB + hstepB, voffB); PG8_STAGE(PG8_SA(0, 0), Ab, vc[0]); PG8_STAGE(PG8_SA(0, 1), Ab, vc[1]);
    if (wr == 1) PG8_BAR;
    PG8_WAIT_V(2); PG8_BAR;
    PG8_STAGE(PG8_SB(1, 0), cB + kstep, voffB); PG8_STAGE(PG8_SA(1, 0), Ab + kstep, vc[0]); PG8_STAGE(PG8_SB(1, 1), cB + hstepB + kstep, voffB);
    PG8_WAIT_V(6); PG8_BAR;
    for (;;) {
        const bool has_next = S.next(ui + 1, nxt);
        const char* nB = cB;
        if (has_next) { nB = PG8_BBASE(nxt); PG8_VOFFA(vn, nxt); }
        else {
#pragma unroll
            for (int h = 0; h < 2; ++h)
#pragma unroll
                for (int i = 0; i < 2; ++i) vn[h][i] = vc[h][i];
        }
        for (int t = 0; t < nt; t += 2) {
            const bool last = (t == nt - 2);
            const char* a1 = Ab + (size_t)(t + 1) * kstep;
            const char* a2 = last ? Ab : Ab + (size_t)(t + 2) * kstep; const char* b2 = last ? nB : cB + (size_t)(t + 2) * kstep;
            const char* a3 = a2 + kstep; const char* b3 = b2 + kstep;
            unsigned v2[2][2];
#pragma unroll
            for (int h = 0; h < 2; ++h)
#pragma unroll
                for (int i = 0; i < 2; ++i) v2[h][i] = last ? vn[h][i] : vc[h][i];
            PG8_LDB(B0, 0, 0); PG8_LDB(B1, 0, 1); PG8_SCHED; PG8_LDA(At, 0, 0); PG8_STAGE(PG8_SA(1, 1), a1, vc[1]);
            PG8_WAIT_V(8); PG8_WAIT_L(0); PG8_BAR; PG8_MMA(0, 0, At, B0); PG8_MMA(0, 1, At, B1); PG8_BAR; PG8_SCHED;
            PG8_LDA(At, 0, 1); PG8_STAGE(PG8_SB(0, 0), b2, voffB); PG8_STAGE(PG8_SB(0, 1), b2 + hstepB, voffB); PG8_STAGE(PG8_SA(0, 0), a2, v2[0]);
            PG8_WAIT_V(8); PG8_WAIT_L(0); PG8_BAR; PG8_MMA(1, 0, At, B0); PG8_MMA(1, 1, At, B1); PG8_BAR; PG8_SCHED;
            PG8_LDB(B0, 1, 0); PG8_LDB(B1, 1, 1); PG8_SCHED; PG8_LDA(At, 1, 0); PG8_STAGE(PG8_SA(0, 1), a2, v2[1]);
            PG8_WAIT_V(8); PG8_WAIT_L(0); PG8_BAR; PG8_MMA(0, 0, At, B0); PG8_MMA(0, 1, At, B1); PG8_BAR; PG8_SCHED;
            PG8_LDA(At, 1, 1); PG8_STAGE(PG8_SB(1, 0), b3, voffB); PG8_STAGE(PG8_SB(1, 1), b3 + hstepB, voffB); PG8_STAGE(PG8_SA(1, 0), a3, v2[0]);
            PG8_WAIT_V(8); PG8_WAIT_L(0); PG8_BAR; PG8_MMA(1, 0, At, B0); PG8_MMA(1, 1, At, B1); PG8_BAR; PG8_SCHED;
        }
        if constexpr (ALIGN_EPI) { if (wr == 0) PG8_BAR; }
        if constexpr (MODE == 1) {
#pragma unroll
            for (int a = 0; a < 2; ++a)
#pragma unroll
                for (int b = 0; b < 2; ++b)
#pragma unroll
                    for (int m = 0; m < 4; ++m)
#pragma unroll
                        for (int n = 0; n < 2; ++n) acc[a][b][m][n] = __builtin_convertvector(__builtin_bit_cast(i32x4, acc[a][b][m][n]), f32x4);
        }
        E(acc, cur, wr, wc, fr, fq);
        if (!has_next) break;
#pragma unroll
        for (int a = 0; a < 2; ++a)
#pragma unroll
            for (int b = 0; b < 2; ++b)
#pragma unroll
                for (int m = 0; m < 4; ++m)
#pragma unroll
                    for (int n = 0; n < 2; ++n) acc[a][b][m][n] = (f32x4){0.f, 0.f, 0.f, 0.f};
        cur = nxt; cB = nB; ++ui;
#pragma unroll
        for (int h = 0; h < 2; ++h)
#pragma unroll
            for (int i = 0; i < 2; ++i) vc[h][i] = vn[h][i];
        if constexpr (ALIGN_EPI) { if (wr == 1) PG8_BAR; }
    }
    PG8_WAIT_V(0);
    if constexpr (!ALIGN_EPI) { if (wr == 0) PG8_BAR; }
    PG8_BAR;
#undef PG8_SA
#undef PG8_SB
#undef PG8_STAGE
#undef PG8_VOFFA
#undef PG8_BBASE
#undef PG8_LDA
#undef PG8_LDB
#undef PG8_MMA
#undef PG8_WAIT_V
#undef PG8_WAIT_L
#undef PG8_BAR
#undef PG8_SCHED
}
}

constexpr int NWAVES = 8;
constexpr int NPH = 20;
#ifndef MK_N_LAUNCHES
#define MK_N_LAUNCHES 1
#endif
constexpr int N_LAUNCHES = MK_N_LAUNCHES;

constexpr size_t MiB = 1u << 20;
constexpr size_t WS_CTL = 0, CTL_ZERO_BYTES = 1 * MiB;
constexpr size_t WS_MOD = 1 * MiB;
constexpr size_t WS_ROPE = 2 * MiB;
constexpr size_t WS_WRKV = 6 * MiB;
constexpr size_t WS_WL1 = 12 * MiB;
constexpr size_t WS_WL2 = 14 * MiB;
constexpr size_t WS_WOUT = 16 * MiB;
constexpr size_t WS_WFGU = 18 * MiB;
constexpr size_t WS_WFDN = 29 * MiB;
constexpr size_t WS_WKV = 35 * MiB;
constexpr size_t WS_WQ = 41 * MiB;
constexpr size_t WS_WO = 44 * MiB;
constexpr size_t WS_WMGU = 46 * MiB;
constexpr size_t WS_WMDN = 158 * MiB;
constexpr size_t WS_AR = 216 * MiB;
constexpr size_t AR(size_t mib) { return WS_AR + mib * MiB; }
constexpr size_t WS_A6 = AR(0);
constexpr size_t WS_A6Q = AR(0);
constexpr size_t WS_RSA = AR(100);
constexpr size_t WS_L1 = AR(384);
constexpr size_t WS_RB = AR(432), WS_KB = AR(496), WS_VB = AR(560);
constexpr size_t WS_AS = AR(192), WS_G = AR(256);
constexpr size_t WS_YS = AR(0);
constexpr size_t WS_YG = AR(128);
constexpr size_t WS_RF = AR(0), WS_YF = AR(64), WS_QF = AR(128), WS_PF = AR(320);
constexpr size_t WS_SF = AR(192);
constexpr size_t WS_WCF = AR(384);
constexpr size_t WS_BON = AR(386);
constexpr size_t WS_Y1 = AR(320);
constexpr size_t WS_X1 = AR(448);
constexpr size_t WS_H2 = AR(576);
constexpr size_t WS_RSH2 = AR(616);
constexpr size_t WS_ACT = AR(0);
constexpr size_t WS_Y2 = AR(176);
constexpr size_t WS_X2 = AR(304);
constexpr size_t WS_HKV = AR(0), WS_H3 = AR(64);
constexpr size_t WS_RSKV = AR(100);
constexpr size_t WS_K2 = AR(128), WS_V2 = AR(432), WS_Q2 = AR(528);
constexpr size_t WS_OG = AR(0);
constexpr size_t WS_LSE = AR(96);
constexpr size_t WS_OM = AR(224);
constexpr size_t WS_Y3 = AR(432);
constexpr size_t WS_H4 = AR(0);
constexpr size_t WS_ROUTE = AR(66);
constexpr size_t WS_ACT2 = AR(70);
constexpr size_t WS_YB = AR(532);
constexpr size_t WS_END = AR(664);
static_assert(WS_END <= 896 * MiB, "workspace");
static_assert((size_t)RMAX * DFE * 2 <= 462 * MiB && (size_t)RMAX * D * 2 <= 132 * MiB, "moe buffers");
constexpr size_t RT_TOKE = 0;
constexpr size_t RT_TOKR = 256 * 1024;
constexpr size_t RT_TOKW = 512 * 1024;
constexpr size_t RT_ROWTOK = 768 * 1024;
constexpr size_t RT_BLKEXP = 1280 * 1024;
constexpr size_t RT_RSH4 = 1536 * 1024;
constexpr int CW_BAR = 4096;
constexpr int CW_CNT = 16384;
constexpr int CW_NBLK = 16448;

constexpr int RING_BYTES = 131072;
constexpr int LDSCTL_OFF = RING_BYTES, MISC_OFF = LDSCTL_OFF + 320;
constexpr int LDS_BYTES = 147456;

#define LDS_WAIT() asm volatile("s_waitcnt lgkmcnt(0)" ::: "memory")
#define VM_WAIT() asm volatile("s_waitcnt vmcnt(0)" ::: "memory")

#define XB_TMO      128
#define XB_XCNT(j)  (256  + 64 * (j))
#define XB_XSUB(j)  (1280 + 64 * (j))
#define XB_XGEN(j)  (2304 + 64 * (j))
#define XB_TOP      3328
#define XB_TOPGEN   3392
#define XCD_BAR_WORDS 3456
#define XB_SPIN_CAP (1u << 22)

__device__ __forceinline__ unsigned xb_ld(unsigned* p)              { return __hip_atomic_load(p, __ATOMIC_RELAXED, __HIP_MEMORY_SCOPE_AGENT); }
__device__ __forceinline__ unsigned xb_add(unsigned* p, unsigned v) { return __hip_atomic_fetch_add(p, v, __ATOMIC_RELAXED, __HIP_MEMORY_SCOPE_AGENT); }
__device__ __forceinline__ unsigned xb_xcc_id() { return (unsigned)__builtin_amdgcn_s_getreg((3 << 11) | 20) & 0xFu; }
#define XB_SPIN(cond, bar) do { unsigned _sp = 0; while (cond) { __builtin_amdgcn_s_sleep(1); \
    if ((++_sp & 255u) == 0u) { if (xb_ld(&(bar)[XB_TMO])) break; if (_sp > XB_SPIN_CAP) { atomicAdd(&(bar)[XB_TMO], 1u); break; } } } } while (0)

struct XcdBarrier { unsigned* bar; unsigned x; volatile LAS unsigned* st; };
__device__ __forceinline__ XcdBarrier xcd_barrier_post(unsigned* bar, volatile LAS unsigned* st) {
    XcdBarrier b; b.bar = bar; b.x = xb_xcc_id(); b.st = st;
    if (threadIdx.x == 0) (void)xb_add(&bar[XB_XCNT(b.x)], 1u);
    return b;
}
__device__ __forceinline__ void xcd_barrier_complete(unsigned* bar, unsigned x, unsigned& nloc, unsigned& nx) {
    const unsigned G = gridDim.x * gridDim.y * gridDim.z;
    unsigned sum, cnt, mine, sp = 0u;
    for (;;) {
        sum = 0u; cnt = 0u; mine = 0u;
#pragma unroll
        for (unsigned j = 0; j < 16; ++j) { const unsigned c = xb_ld(&bar[XB_XCNT(j)]); sum += c; cnt += (c > 0u) ? 1u : 0u; mine = (j == x) ? c : mine; }
        if (sum == G) break;
        __builtin_amdgcn_s_sleep(1);
        if ((++sp & 255u) == 0u) { if (xb_ld(&bar[XB_TMO])) break; if (sp > XB_SPIN_CAP) { atomicAdd(&bar[XB_TMO], 1u); break; } }
    }
    nloc = mine > 0u ? mine : 1u; nx = cnt > 0u ? cnt : 1u;
}
__device__ __forceinline__ void xcd_barrier(const XcdBarrier& b) {
    asm volatile("s_waitcnt vmcnt(0)" ::: "memory");
    __syncthreads();
    if (threadIdx.x == 0) {
        unsigned* bar = b.bar;
        __builtin_amdgcn_s_waitcnt(0);
        unsigned nloc = b.st[0], nx = b.st[1];
        if (nloc == 0u) { xcd_barrier_complete(bar, b.x, nloc, nx); b.st[0] = nloc; b.st[1] = nx; }
        const unsigned old = xb_add(&bar[XB_XSUB(b.x)], 1u);
        const unsigned gen = old / nloc;
        if (old + 1u == (gen + 1u) * nloc) {
            __builtin_amdgcn_fence(__ATOMIC_RELEASE, "agent");
            asm volatile("s_waitcnt vmcnt(0)" ::: "memory");
            const unsigned og = xb_add(&bar[XB_TOP], 1u);
            const unsigned tg = og / nx;
            if (og + 1u == (tg + 1u) * nx) xb_add(&bar[XB_TOPGEN], 1u);
            else XB_SPIN(xb_ld(&bar[XB_TOPGEN]) == tg, bar);
            __builtin_amdgcn_fence(__ATOMIC_ACQUIRE, "agent");
            xb_add(&bar[XB_XGEN(b.x)], 1u);
            asm volatile("s_waitcnt vmcnt(0)" ::: "memory");
        } else {
            XB_SPIN(xb_ld(&bar[XB_XGEN(b.x)]) == gen, bar);
            __builtin_amdgcn_fence(__ATOMIC_ACQUIRE, "agent");
            asm volatile("s_waitcnt vmcnt(0)" ::: "memory");
        }
    }
    __syncthreads();
}

struct Frame {
    LAS unsigned char* lds;
    volatile LAS unsigned* MISC;
    gu32* ctl;
    int tid, lane, wave;
    int vcu, G;
    const float* const* in;
    float* out;
    unsigned char* ws;
};
#define WSP(type, off) ((type*)(F.ws + (off)))

__device__ __forceinline__ float wave_sum(float v) {
#pragma unroll
    for (int o = 1; o < 64; o <<= 1) v += __shfl_xor(v, o);
    return v;
}

__device__ __forceinline__ int colmap(int kind, int half, int n) {
    if (kind == 1) return (n & 1) ? half + (n >> 1) : (n >> 1);
    if (kind == 2 || (kind == 3 && n < QW)) { const int hd = n >> 6, p = n & 63; return hd * 64 + ((p & 1) * 32 + (p >> 1)); }
    return n;
}
__device__ __forceinline__ void cvt_item(const float* W, int ldw, int Kv, int Nv, bf16_t* WT, int Kout, int Nout, int kind, int half, LAS float* scr, int item, int lane) {
    const int nblk = Nout / 32, kb = item / nblk, nb = item % nblk, k0 = 64 * kb, n0 = 32 * nb;
    const int nn = n0 + (lane & 31); const int sc = colmap(kind, half, nn); const bool nok = nn < Nv;
#pragma unroll 8
    for (int i = 0; i < 32; ++i) { const int kk = 2 * i + (lane >> 5); float v = 0.f; if (nok && (k0 + kk) < Kv) v = W[(size_t)(k0 + kk) * ldw + sc]; scr[kk * 33 + (lane & 31)] = v; }
    LDS_WAIT(); asm volatile("" ::: "memory");
    const int c = lane & 7;
#pragma unroll
    for (int j = 0; j < 4; ++j) { const int n = (lane >> 3) + 8 * j; const LAS float* s = scr + (8 * c) * 33 + n;
        u32x4 o; o.x = cvt_pk_bf16(s[0 * 33], s[1 * 33]); o.y = cvt_pk_bf16(s[2 * 33], s[3 * 33]); o.z = cvt_pk_bf16(s[4 * 33], s[5 * 33]); o.w = cvt_pk_bf16(s[6 * 33], s[7 * 33]);
        *(u32x4*)(WT + (size_t)(n0 + n) * Kout + k0 + 8 * c) = o; }
    LDS_WAIT(); asm volatile("" ::: "memory");
}
__device__ __forceinline__ int invmap(int kind, int half, int sc) {
    if (kind == 1) return sc < half ? 2 * sc : 2 * (sc - half) + 1;
    if (kind == 2 || (kind == 3 && sc < QW)) { const int hd = sc >> 6, d = sc & 63; return hd * 64 + (d < 32 ? 2 * d : 2 * (d - 32) + 1); }
    return sc;
}
constexpr int CV_STRIDE = 68;
__device__ __forceinline__ void cvt_item64(const float* W, int ldw, bf16_t* WT, int Kout, int nblk, int kind, int half, LAS bf16_t* scr, int item, int lane) {
    const int kb = item / nblk, nb = item % nblk, k0 = 64 * kb, n0 = 64 * nb;
    const int c4 = lane & 15, kr = lane >> 4;
    f32x4 v[8][2];
#pragma unroll
    for (int i = 0; i < 8; ++i)
#pragma unroll
        for (int e = 0; e < 2; ++e) v[i][e] = __builtin_nontemporal_load((const f32x4*)(W + (size_t)(k0 + 8 * i + 2 * kr + e) * ldw + n0 + 4 * c4));
#pragma unroll
    for (int i = 0; i < 8; ++i)
#pragma unroll
        for (int e = 0; e < 4; ++e) *(LAS unsigned*)(scr + (4 * c4 + e) * CV_STRIDE + 8 * i + 2 * kr) = cvt_pk_bf16(v[i][0][e], v[i][1][e]);
    LDS_WAIT(); asm volatile("" ::: "memory");
    const int c = lane & 7;
#pragma unroll
    for (int j = 0; j < 8; ++j) { const int n = (lane >> 3) + 8 * j; const LAS bf16_t* sp = scr + n * CV_STRIDE + 8 * c;
        const u32x2 a = *(const LAS u32x2*)sp, b = *(const LAS u32x2*)(sp + 4);
        *(u32x4*)(WT + (size_t)invmap(kind, half, n0 + n) * Kout + k0 + 8 * c) = (u32x4){a.x, a.y, b.x, b.y}; }
    LDS_WAIT(); asm volatile("" ::: "memory");
}
constexpr int CV8_STRIDE = 80;
__device__ __forceinline__ void cvt_item64_q8(const float* W, int ldw, unsigned char* WT, int Kout, int nblk, int kind, int half, float scale, LAS unsigned char* scr, int item, int lane) {
    const int kb = item / nblk, nb = item % nblk, k0 = 64 * kb, n0 = 64 * nb;
    const int c4 = lane & 15, kr = lane >> 4;
    f32x4 v[4][4];
#pragma unroll
    for (int i = 0; i < 4; ++i)
#pragma unroll
        for (int e = 0; e < 4; ++e) v[i][e] = __builtin_nontemporal_load((const f32x4*)(W + (size_t)(k0 + 16 * i + 4 * kr + e) * ldw + n0 + 4 * c4));
#pragma unroll
    for (int i = 0; i < 4; ++i)
#pragma unroll
        for (int e = 0; e < 4; ++e) *(LAS unsigned*)(scr + (4 * c4 + e) * CV8_STRIDE + 16 * i + 4 * kr) = pk4_i8(v[i][0][e] * scale, v[i][1][e] * scale, v[i][2][e] * scale, v[i][3][e] * scale);
    LDS_WAIT(); asm volatile("" ::: "memory");
    const int c = lane & 3;
#pragma unroll
    for (int j = 0; j < 4; ++j) { const int n = (lane >> 2) + 16 * j;
        *(u32x4*)(WT + (size_t)invmap(kind, half, n0 + n) * Kout + k0 + 16 * c) = *(const LAS u32x4*)(scr + n * CV8_STRIDE + 16 * c); }
    LDS_WAIT(); asm volatile("" ::: "memory");
}
__device__ __forceinline__ void p0_prologue(Frame& F) {
    {
        LAS float* part = (LAS float*)F.lds;
        const float* c = F.in[1]; const float* aw = F.in[2]; const float* ab = F.in[3]; float* MOD = WSP(float, WS_MOD);
        for (int it = F.vcu; it < ADA_W / 64; it += F.G) {
            const int j = it * 64 + F.lane; float s0 = 0.f, s1 = 0.f;
#pragma unroll 8
            for (int k = F.wave * 128; k < F.wave * 128 + 128; ++k) { const float w = aw[(size_t)k * ADA_W + j]; s0 += siluf_(c[k]) * w; s1 += siluf_(c[D + k]) * w; }
            part[(F.wave * 2 + 0) * 64 + F.lane] = s0; part[(F.wave * 2 + 1) * 64 + F.lane] = s1;
            __syncthreads();
            if (F.wave < 2) { float s = ab[j];
#pragma unroll
                for (int w = 0; w < 8; ++w) s += part[(w * 2 + F.wave) * 64 + F.lane];
                MOD[F.wave * ADA_W + j] = s; }
            __syncthreads();
        }
    }
    {
        float* cs = WSP(float, WS_ROPE); float* sn = cs + SEQ * 32;
        for (int idx = F.vcu * 512 + F.tid; idx < SEQ * 32; idx += F.G * 512) {
            const int t = idx >> 5, i = idx & 31;
            const float inv = powf(10000.0f, -(float)i / 32.0f); const float ang = (float)t * inv;
            cs[idx] = cosf(ang); sn[idx] = sinf(ang);
        }
    }
    LAS float* scr = (LAS float*)(F.lds + F.wave * 16384);
    LAS bf16_t* scrh = (LAS bf16_t*)(F.lds + F.wave * 16384);
    const int gw = F.vcu * NWAVES + F.wave, NGW = F.G * NWAVES;
    {
        constexpr int J_MGU = 16 * 112, J_MDN = 56 * 16, J_RKV = 16 * 48, J_OUT = 16 * 16, J_FGU = 16 * 88, J_FDN = 44 * 16, J_KV = 16 * 48, J_Q = 16 * 24, J_O = 8 * 16;
        constexpr int NJ = 8 * J_MGU + 8 * J_MDN + J_RKV + J_OUT + J_FGU + J_FDN + J_KV + J_Q + J_O;
        for (int it = gw; it < NJ; it += NGW) {
            int r = it;
            if (r < 8 * J_MGU) { const int e = r / J_MGU; cvt_item64_q8(F.in[28] + (size_t)e * D * 2 * DFE, 2 * DFE, WSP(unsigned char, WS_WMGU) + (size_t)e * 2 * DFE * D, D, 112, 1, DFE, QW_INV, (LAS unsigned char*)scrh, r % J_MGU, F.lane); continue; } r -= 8 * J_MGU;
            if (r < 8 * J_MDN) { const int e = r / J_MDN; cvt_item64(F.in[29] + (size_t)e * DFE * D, D, WSP(bf16_t, WS_WMDN) + (size_t)e * D * DFE, DFE, 16, 0, 0, scrh, r % J_MDN, F.lane); continue; } r -= 8 * J_MDN;
            if (r < J_RKV) { cvt_item64_q8(F.in[7], 3 * D, WSP(unsigned char, WS_WRKV), D, 48, 0, 0, QW_INV, (LAS unsigned char*)scrh, r, F.lane); continue; } r -= J_RKV;
            if (r < J_OUT) { cvt_item64(F.in[21], D, WSP(bf16_t, WS_WOUT), D, 16, 0, 0, scrh, r, F.lane); continue; } r -= J_OUT;
            if (r < J_FGU) { cvt_item64_q8(F.in[25], 2 * DFF, WSP(unsigned char, WS_WFGU), D, 88, 1, DFF, QW_INV, (LAS unsigned char*)scrh, r, F.lane); continue; } r -= J_FGU;
            if (r < J_FDN) { cvt_item64(F.in[26], D, WSP(bf16_t, WS_WFDN), DFF, 16, 0, 0, scrh, r, F.lane); continue; } r -= J_FDN;
            if (r < J_KV) { cvt_item64_q8(F.in[22], 2 * QW, WSP(unsigned char, WS_WKV), D, 48, 3, 0, QW_INV, (LAS unsigned char*)scrh, r, F.lane); continue; } r -= J_KV;
            if (r < J_Q) { cvt_item64_q8(F.in[23], QW, WSP(unsigned char, WS_WQ), D, 24, 2, 0, QW_INV, (LAS unsigned char*)scrh, r, F.lane); continue; } r -= J_Q;
            cvt_item64(F.in[24], D, WSP(bf16_t, WS_WO), AOUT, 16, 0, 0, scrh, r, F.lane);
        }
    }
    {
        constexpr int I_L1 = 16 * 8, I_L2 = 4 * 32;
        for (int it = gw; it < 3 * I_L1 + 3 * I_L2; it += NGW) {
            int r = it;
            if (r < I_L1) { cvt_item(F.in[9], 64, D, 64, WSP(bf16_t, WS_WL1), D, 256, 0, 0, scr, r, F.lane); continue; } r -= I_L1;
            if (r < I_L1) { cvt_item(F.in[12], 64, D, 64, WSP(bf16_t, WS_WL1) + 256 * D, D, 256, 0, 0, scr, r, F.lane); continue; } r -= I_L1;
            if (r < I_L1) { cvt_item(F.in[14], 160, D, 160, WSP(bf16_t, WS_WL1) + 2 * 256 * D, D, 256, 0, 0, scr, r, F.lane); continue; } r -= I_L1;
            if (r < I_L2) { cvt_item(F.in[10], D, 64, D, WSP(bf16_t, WS_WL2), 256, D, 0, 0, scr, r, F.lane); continue; } r -= I_L2;
            if (r < I_L2) { cvt_item(F.in[13], D, 64, D, WSP(bf16_t, WS_WL2) + D * 256, 256, D, 0, 0, scr, r, F.lane); continue; } r -= I_L2;
            cvt_item(F.in[15], D, 160, D, WSP(bf16_t, WS_WL2) + 2 * D * 256, 256, D, 0, 0, scr, r, F.lane);
        }
    }
}

__device__ __forceinline__ void p1_lerp(Frame& F) {
    const int gw = F.vcu * NWAVES + F.wave, NGW = F.G * NWAVES;
    const float* x = F.in[0]; const float* mu = F.in[6]; const float* MOD = WSP(float, WS_MOD); bf16_t* A6 = WSP(bf16_t, WS_A6);
    unsigned char* A6Q = WSP(unsigned char, WS_A6Q); float* RSA = WSP(float, WS_RSA);
    for (int m = gw; m < T; m += NGW) {
        const int b = m >> 14, t = m & (SEQ - 1);
        f32x4 q[3][4]; float mx[3] = {0.f, 0.f, 0.f};
#pragma unroll
        for (int j = 0; j < 4; ++j) {
            const int c = 4 * F.lane + 256 * j;
            const f32x4 sh = *(const f32x4*)(MOD + b * ADA_W + 0 * D + c), sc = *(const f32x4*)(MOD + b * ADA_W + 1 * D + c);
            const f32x4 xc = *(const f32x4*)(x + (size_t)m * D + c);
            const f32x4 hc = xc * (1.f + sc) + sh;
            f32x4 hp = (f32x4){0.f, 0.f, 0.f, 0.f};
            if (t > 0) { const f32x4 xp = *(const f32x4*)(x + (size_t)(m - 1) * D + c); hp = xp * (1.f + sc) + sh; }
            const f32x4 xx = hp - hc;
#pragma unroll
            for (int p = 0; p < 6; ++p) {
                const f32x4 mv = *(const f32x4*)(mu + p * D + c); const f32x4 o = hc + xx * mv;
                if (p < 3) { q[p][j] = o; mx[p] = fmaxf(mx[p], fmaxf(fmaxf(fabsf(o[0]), fabsf(o[1])), fmaxf(fabsf(o[2]), fabsf(o[3])))); }
                else { u32x2 w; w.x = cvt_pk_bf16(o[0], o[1]); w.y = cvt_pk_bf16(o[2], o[3]); *(u32x2*)(A6 + (size_t)p * T * D + (size_t)m * D + c) = w; }
            }
        }
#pragma unroll
        for (int p = 0; p < 3; ++p) {
            float v = mx[p];
#pragma unroll
            for (int of = 1; of < 64; of <<= 1) v = fmaxf(v, __shfl_xor(v, of));
            v = fmaxf(v, 1e-20f); const float inv = 127.f / v;
            if (F.lane == 0) RSA[p * T + m] = v * (1.f / 127.f);
#pragma unroll
            for (int j = 0; j < 4; ++j) *(unsigned*)(A6Q + (size_t)p * T * D + (size_t)m * D + 4 * F.lane + 256 * j) = pk4_i8(q[p][j][0] * inv, q[p][j][1] * inv, q[p][j][2] * inv, q[p][j][3] * inv);
        }
    }
}

template <int CTRL> __device__ __forceinline__ float dpp_mov(float v) { return __int_as_float(__builtin_amdgcn_update_dpp(0, __float_as_int(v), CTRL, 0xF, 0xF, false)); }
__device__ __forceinline__ float sum16(float v) { v += dpp_mov<0xB1>(v); v += dpp_mov<0x4E>(v); v += dpp_mov<0x141>(v); v += dpp_mov<0x140>(v); return v; }
__device__ __forceinline__ float rdl(float v, int l) { return __int_as_float(__builtin_amdgcn_readlane(__float_as_int(v), l)); }
__device__ __forceinline__ float wsum(float v) { v = sum16(v); return (rdl(v, 0) + rdl(v, 16)) + (rdl(v, 32) + rdl(v, 48)); }
__device__ __forceinline__ unsigned short bf1(float x) { return (unsigned short)(cvt_pk_bf16(x, x) & 0xffffu); }
constexpr int CH = 64, NCH = SEQ / CH, NUNIT = BATCH * 16 * NCH;
constexpr int CS = 72;
constexpr int L_AT = 0, L_RT = 9216, L_BT = 18432, L_KT = 27648, L_ATT = 36864, L_BTT = 46080, L_KTT = 55296, L_VT = 64512, L_AAB = 73728, L_AAK = 82944, L_ARB = 92160, L_ARK = 101376;
constexpr int L_XT = L_BT;
constexpr int L_TI = 110592, L_WC = 112640, L_TOT = 112896;
#define FRAG(base, row, ks) (*(const LAS bf16x8*)((base) + (row) * CS + 32 * (ks) + 8 * qd))
#define MF(a, b, c) __builtin_amdgcn_mfma_f32_16x16x32_bf16((a), (b), (c), 0, 0, 0)
__device__ __forceinline__ bf16x8 pack8(const f32x4 a, const f32x4 b) { union { bf16x8 v; unsigned u[4]; } t; t.u[0] = cvt_pk_bf16(a[0], a[1]); t.u[1] = cvt_pk_bf16(a[2], a[3]); t.u[2] = cvt_pk_bf16(b[0], b[1]); t.u[3] = cvt_pk_bf16(b[2], b[3]); return t.v; }
__device__ __forceinline__ f32x4 unpk4(const u32x2 w) { return (f32x4){bflo(w.x), bfhi(w.x), bflo(w.y), bfhi(w.y)}; }

#define LDS_BAR() do { asm volatile("s_waitcnt lgkmcnt(0)" ::: "memory"); __builtin_amdgcn_s_barrier(); asm volatile("" ::: "memory"); } while (0)
struct ChIn { unsigned short r[8], k[8], v[8], a[8]; float wl[8]; };
__device__ __forceinline__ void ch_load(ChIn& I, const bf16_t* RB, const bf16_t* KB, const bf16_t* VB, const bf16_t* AS, const float* WLOG, size_t m0, int col) {
#pragma unroll
    for (int i = 0; i < 8; ++i) { const size_t o = (m0 + i) * D + col; I.r[i] = RB[o]; I.k[i] = KB[o]; I.v[i] = VB[o]; I.a[i] = AS[o]; I.wl[i] = WLOG[o]; }
}
__device__ __forceinline__ void p4a_chunk(Frame& F) {
    LAS unsigned char* L = F.lds;
    LAS bf16_t* At = (LAS bf16_t*)(L + L_AT); LAS bf16_t* Rt = (LAS bf16_t*)(L + L_RT); LAS bf16_t* Bt = (LAS bf16_t*)(L + L_BT); LAS bf16_t* Kt = (LAS bf16_t*)(L + L_KT);
    LAS bf16_t* AtT = (LAS bf16_t*)(L + L_ATT); LAS bf16_t* BtT = (LAS bf16_t*)(L + L_BTT); LAS bf16_t* KtT = (LAS bf16_t*)(L + L_KTT); LAS bf16_t* VT = (LAS bf16_t*)(L + L_VT);
    LAS bf16_t* AAB = (LAS bf16_t*)(L + L_AAB); LAS bf16_t* AAK = (LAS bf16_t*)(L + L_AAK); LAS bf16_t* ARB = (LAS bf16_t*)(L + L_ARB); LAS bf16_t* ARK = (LAS bf16_t*)(L + L_ARK);
    LAS bf16_t* XT = (LAS bf16_t*)(L + L_XT); LAS bf16_t* TI = (LAS bf16_t*)(L + L_TI); LAS float* WC = (LAS float*)(L + L_WC); LAS float* TOT = (LAS float*)(L + L_TOT);
    const bf16_t* RB = WSP(bf16_t, WS_RB); const bf16_t* KB = WSP(bf16_t, WS_KB); const bf16_t* VB = WSP(bf16_t, WS_VB); const bf16_t* AS = WSP(bf16_t, WS_AS); const float* WLOG = F.out;
    u32x4* PF = WSP(u32x4, WS_PF); u32x4* QF = WSP(u32x4, WS_QF); u32x4* RF = WSP(u32x4, WS_RF); u32x4* YF = WSP(u32x4, WS_YF); float* WCF = WSP(float, WS_WCF); float* BON = WSP(float, WS_BON);
    const int lane = F.lane, w = F.wave, q16 = lane & 15, qd = lane >> 4;
    ChIn I;
    int unit = F.vcu;
    if (unit < NUNIT) { const int bh = unit >> 8, ch = unit & 255; ch_load(I, RB, KB, VB, AS, WLOG, (size_t)(bh >> 4) * SEQ + ch * CH + 8 * w, (bh & 15) * 64 + lane); }
    for (; unit < NUNIT; unit += F.G) {
        const int bh = unit >> 8, ch = unit & 255, b = bh >> 4, h = bh & 15;
        const size_t m0 = (size_t)b * SEQ + (size_t)ch * CH;
        const int col = h * 64 + lane;
        float r_[8], kp_[8], kn_[8], a_[8], cwl[8];
        {
            const float kkc = F.in[16][col], kac = F.in[17][col], rkc = F.in[18][col];
            float run = 0.f;
#pragma unroll
            for (int i = 0; i < 8; ++i) {
                const float r = __uint_as_float((unsigned)I.r[i] << 16), k = __uint_as_float((unsigned)I.k[i] << 16), a = __uint_as_float((unsigned)I.a[i] << 16);
                run += I.wl[i]; cwl[i] = run;
                const float kkv = k * kkc; const float ss = wsum(kkv * kkv); const float inv = 1.f / fmaxf(sqrtf(ss), 1e-12f);
                const float kp = k * (1.f + (a - 1.f) * kac); const float bn = wsum(r * kp * rkc);
                if (lane == 0) BON[(m0 + 8 * w + i) * 16 + h] = bn;
                r_[i] = r; kp_[i] = kp; kn_[i] = kkv * inv; a_[i] = a;
            }
            TOT[w * 64 + lane] = run;
        }
        LDS_BAR();
        {
            float off = 0.f, tot = 0.f;
#pragma unroll
            for (int ww = 0; ww < 8; ++ww) { const float tv = TOT[ww * 64 + lane]; tot += tv; off += (ww < w) ? tv : 0.f; }
            if (w == 0) { WC[lane] = __expf(tot); WCF[(size_t)unit * 64 + lane] = __expf(tot); }
            float at[8], bt[8], kt[8];
#pragma unroll
            for (int i = 0; i < 8; ++i) {
                const float cw = off + cwl[i]; const float ein = __expf(cw), eex = __expf(cw - I.wl[i]), einv = __expf(-cw);
                at[i] = -kn_[i] * eex; bt[i] = kn_[i] * a_[i] * einv; kt[i] = kp_[i] * einv; const float rt = r_[i] * ein;
                const int t = 8 * w + i;
                At[t * CS + lane] = bf1(at[i]); Rt[t * CS + lane] = bf1(rt); Bt[t * CS + lane] = bf1(bt[i]); Kt[t * CS + lane] = bf1(kt[i]);
            }
            u32x4 pa, pb, pk, pv;
            pa.x = cvt_pk_bf16(at[0], at[1]); pa.y = cvt_pk_bf16(at[2], at[3]); pa.z = cvt_pk_bf16(at[4], at[5]); pa.w = cvt_pk_bf16(at[6], at[7]);
            pb.x = cvt_pk_bf16(bt[0], bt[1]); pb.y = cvt_pk_bf16(bt[2], bt[3]); pb.z = cvt_pk_bf16(bt[4], bt[5]); pb.w = cvt_pk_bf16(bt[6], bt[7]);
            pk.x = cvt_pk_bf16(kt[0], kt[1]); pk.y = cvt_pk_bf16(kt[2], kt[3]); pk.z = cvt_pk_bf16(kt[4], kt[5]); pk.w = cvt_pk_bf16(kt[6], kt[7]);
            pv.x = (unsigned)I.v[0] | ((unsigned)I.v[1] << 16); pv.y = (unsigned)I.v[2] | ((unsigned)I.v[3] << 16); pv.z = (unsigned)I.v[4] | ((unsigned)I.v[5] << 16); pv.w = (unsigned)I.v[6] | ((unsigned)I.v[7] << 16);
            *(LAS u32x4*)(AtT + lane * CS + 8 * w) = pa; *(LAS u32x4*)(BtT + lane * CS + 8 * w) = pb; *(LAS u32x4*)(KtT + lane * CS + 8 * w) = pk; *(LAS u32x4*)(VT + lane * CS + 8 * w) = pv;
        }
        { const int nu = unit + F.G; if (nu < NUNIT) { const int nbh = nu >> 8, nch = nu & 255; ch_load(I, RB, KB, VB, AS, WLOG, (size_t)(nbh >> 4) * SEQ + nch * CH + 8 * w, (nbh & 15) * 64 + lane); } }
        LDS_BAR();
        {
            const int tt = w >> 1, half = w & 1;
            const LAS bf16_t* src = half ? Rt : At; LAS bf16_t* d0 = half ? ARB : AAB; LAS bf16_t* d1 = half ? ARK : AAK;
            const bf16x8 s0 = FRAG(src, 16 * tt + q16, 0), s1 = FRAG(src, 16 * tt + q16, 1);
#pragma unroll
            for (int jt = 0; jt < 4; ++jt) {
                f32x4 e0 = (f32x4){0.f, 0.f, 0.f, 0.f}, e1 = e0;
                if (jt <= tt) {
                    e0 = MF(FRAG(Bt, 16 * jt + q16, 0), s0, e0); e0 = MF(FRAG(Bt, 16 * jt + q16, 1), s1, e0);
                    e1 = MF(FRAG(Kt, 16 * jt + q16, 0), s0, e1); e1 = MF(FRAG(Kt, 16 * jt + q16, 1), s1, e1);
#pragma unroll
                    for (int r = 0; r < 4; ++r) { const int j = 16 * jt + 4 * qd + r, t = 16 * tt + q16; const bool ok = half ? (j <= t) : (j < t); e0[r] = ok ? e0[r] : 0.f; e1[r] = ok ? e1[r] : 0.f; }
                }
                u32x2 o0, o1; o0.x = cvt_pk_bf16(e0[0], e0[1]); o0.y = cvt_pk_bf16(e0[2], e0[3]); o1.x = cvt_pk_bf16(e1[0], e1[1]); o1.y = cvt_pk_bf16(e1[2], e1[3]);
                *(LAS u32x2*)(d0 + (16 * tt + q16) * CS + 16 * jt + 4 * qd) = o0; *(LAS u32x2*)(d1 + (16 * tt + q16) * CS + 16 * jt + 4 * qd) = o1;
            }
        }
        LDS_BAR();
        f32x4 Z[4];
        if (w < 4) {
            float Tc[16];
#pragma unroll
            for (int r = 0; r < 16; ++r) Tc[r] = (r == q16) ? 1.f : 0.f;
#pragma unroll
            for (int r = 1; r < 16; ++r) {
                const LAS bf16_t* np_ = AAB + (16 * w + r) * CS + 16 * w;
                const u32x4 n0 = *(const LAS u32x4*)np_, n1 = *(const LAS u32x4*)(np_ + 8);
                const float nv[16] = {bflo(n0.x), bfhi(n0.x), bflo(n0.y), bfhi(n0.y), bflo(n0.z), bfhi(n0.z), bflo(n0.w), bfhi(n0.w), bflo(n1.x), bfhi(n1.x), bflo(n1.y), bfhi(n1.y), bflo(n1.z), bfhi(n1.z), bflo(n1.w), bfhi(n1.w)};
                float acc = Tc[r];
#pragma unroll
                for (int s = 0; s < r; ++s) acc += nv[s] * Tc[s];
                Tc[r] = acc;
            }
            if (qd == 0) {
#pragma unroll
                for (int r = 0; r < 16; ++r) TI[(w * 16 + r) * 16 + q16] = bf1(Tc[r]);
            }
#pragma unroll
            for (int i = 0; i < 4; ++i) Z[i] = unpk4(*(const LAS u32x2*)(AtT + (16 * w + q16) * CS + 16 * i + 4 * qd));
        } else {
            const int vt = w - 4;
            const bf16x8 v0 = FRAG(VT, 16 * vt + q16, 0), v1 = FRAG(VT, 16 * vt + q16, 1);
#pragma unroll
            for (int i = 0; i < 4; ++i) {
                f32x4 g = (f32x4){0.f, 0.f, 0.f, 0.f};
                g = MF(FRAG(AAK, 16 * i + q16, 0), v0, g);
                if (i >= 2) g = MF(FRAG(AAK, 16 * i + q16, 1), v1, g);
                Z[i] = g;
            }
        }
        LDS_BAR();
        {
            const f32x4 zz = (f32x4){0.f, 0.f, 0.f, 0.f};
            f32x4 X[4];
#pragma unroll
            for (int i = 0; i < 4; ++i) {
                if (i >= 1) {
                    union { bf16x8 v; u32x2 h[2]; } af;
                    af.h[0] = *(const LAS u32x2*)(AAB + (16 * i + q16) * CS + 0 + 4 * qd);
                    af.h[1] = (i >= 2) ? *(const LAS u32x2*)(AAB + (16 * i + q16) * CS + 16 + 4 * qd) : (u32x2){0u, 0u};
                    Z[i] = MF(af.v, pack8(X[0], (i >= 2) ? X[1] : zz), Z[i]);
                    if (i == 3) { af.h[0] = *(const LAS u32x2*)(AAB + (16 * i + q16) * CS + 32 + 4 * qd); af.h[1] = (u32x2){0u, 0u}; Z[i] = MF(af.v, pack8(X[2], zz), Z[i]); }
                }
                union { bf16x8 v; u32x2 h[2]; } tf; tf.h[0] = *(const LAS u32x2*)(TI + (i * 16 + q16) * 16 + 4 * qd); tf.h[1] = (u32x2){0u, 0u};
                X[i] = MF(tf.v, pack8(Z[i], zz), zz);
                u32x2 o; o.x = cvt_pk_bf16(X[i][0], X[i][1]); o.y = cvt_pk_bf16(X[i][2], X[i][3]);
                *(LAS u32x2*)(XT + (16 * w + q16) * CS + 16 * i + 4 * qd) = o;
            }
        }
        LDS_BAR();
        {
            const int hi = w >> 1, lo = w & 1;
            const size_t fo = ((size_t)unit * 8 + w) * 64 + lane;
            {
                const bf16x8 b0 = FRAG(BtT, 16 * hi + q16, 0), b1 = FRAG(BtT, 16 * hi + q16, 1);
                f32x4 d[2];
#pragma unroll
                for (int e = 0; e < 2; ++e) { const int kt = 2 * lo + e; f32x4 a = (f32x4){0.f, 0.f, 0.f, 0.f}; a = MF(FRAG(XT, 16 * kt + q16, 0), b0, a); a = MF(FRAG(XT, 16 * kt + q16, 1), b1, a); d[e] = a * WC[16 * hi + q16]; }
                const bf16x8 o = pack8(d[0], d[1]); PF[fo] = *(const u32x4*)&o;
            }
            {
                const bf16x8 u0 = FRAG(XT, 64 + 16 * hi + q16, 0), u1 = FRAG(XT, 64 + 16 * hi + q16, 1), v0 = FRAG(VT, 16 * hi + q16, 0), v1 = FRAG(VT, 16 * hi + q16, 1);
                f32x4 d[2];
#pragma unroll
                for (int e = 0; e < 2; ++e) { const int kt = 2 * lo + e; f32x4 a = (f32x4){0.f, 0.f, 0.f, 0.f};
                    a = MF(FRAG(BtT, 16 * kt + q16, 0), u0, a); a = MF(FRAG(BtT, 16 * kt + q16, 1), u1, a); a = MF(FRAG(KtT, 16 * kt + q16, 0), v0, a); a = MF(FRAG(KtT, 16 * kt + q16, 1), v1, a);
                    d[e] = a * *(const LAS f32x4*)(WC + 16 * kt + 4 * qd); }
                const bf16x8 o = pack8(d[0], d[1]); QF[fo] = *(const u32x4*)&o;
            }
            {
                const bf16x8 b0 = FRAG(ARB, 16 * hi + q16, 0), b1 = FRAG(ARB, 16 * hi + q16, 1);
                f32x4 d[2];
#pragma unroll
                for (int e = 0; e < 2; ++e) { const int ct = 2 * lo + e; f32x4 a = unpk4(*(const LAS u32x2*)(Rt + (16 * hi + q16) * CS + 16 * ct + 4 * qd));
                    a = MF(FRAG(XT, 16 * ct + q16, 0), b0, a); if (hi >= 2) a = MF(FRAG(XT, 16 * ct + q16, 1), b1, a); d[e] = a; }
                const bf16x8 o = pack8(d[0], d[1]); RF[fo] = *(const u32x4*)&o;
            }
            {
                const bf16x8 b0 = FRAG(ARB, 16 * hi + q16, 0), b1 = FRAG(ARB, 16 * hi + q16, 1), k0 = FRAG(ARK, 16 * hi + q16, 0), k1 = FRAG(ARK, 16 * hi + q16, 1);
                f32x4 d[2];
#pragma unroll
                for (int e = 0; e < 2; ++e) { const int vt = 2 * lo + e; f32x4 a = (f32x4){0.f, 0.f, 0.f, 0.f};
                    a = MF(FRAG(XT, 64 + 16 * vt + q16, 0), b0, a); a = MF(FRAG(VT, 16 * vt + q16, 0), k0, a);
                    if (hi >= 2) { a = MF(FRAG(XT, 64 + 16 * vt + q16, 1), b1, a); a = MF(FRAG(VT, 16 * vt + q16, 1), k1, a); }
                    d[e] = a; }
                const bf16x8 o = pack8(d[0], d[1]); YF[fo] = *(const u32x4*)&o;
            }
        }
    }
}
__device__ __forceinline__ void p4b_chain(Frame& F) {
    if (F.wave != 0) return;
    const u32x4* PF = WSP(u32x4, WS_PF); const u32x4* QF = WSP(u32x4, WS_QF); const float* WCF = WSP(float, WS_WCF); u32x4* SF = WSP(u32x4, WS_SF);
    const int lane = F.lane, qd = lane >> 4;
    for (int job = F.vcu; job < BATCH * 16 * 4; job += F.G) {
        const int bh = job >> 2, vt = job & 3;
        f32x4 S[4];
#pragma unroll
        for (int kt = 0; kt < 4; ++kt) S[kt] = (f32x4){0.f, 0.f, 0.f, 0.f};
        u32x4 pf[2][8], qf[2][2]; f32x4 wc[2][4];
#define CHAIN_LOAD(buf, u) do { _Pragma("unroll") for (int x = 0; x < 8; ++x) pf[buf][x] = PF[((size_t)(u) * 8 + x) * 64 + lane]; \
        _Pragma("unroll") for (int x = 0; x < 2; ++x) qf[buf][x] = QF[((size_t)(u) * 8 + vt * 2 + x) * 64 + lane]; \
        _Pragma("unroll") for (int kt = 0; kt < 4; ++kt) wc[buf][kt] = *(const f32x4*)(WCF + (size_t)(u) * 64 + 16 * kt + 4 * qd); } while (0)
#define CHAIN_STEP(buf, u) do { \
        const bf16x8 s0 = pack8(S[0], S[1]), s1 = pack8(S[2], S[3]); \
        SF[((size_t)(u) * 8 + vt * 2 + 0) * 64 + lane] = *(const u32x4*)&s0; SF[((size_t)(u) * 8 + vt * 2 + 1) * 64 + lane] = *(const u32x4*)&s1; \
        f32x4 n[4]; \
        n[0] = unpk4((u32x2){qf[buf][0].x, qf[buf][0].y}) + wc[buf][0] * S[0]; n[1] = unpk4((u32x2){qf[buf][0].z, qf[buf][0].w}) + wc[buf][1] * S[1]; \
        n[2] = unpk4((u32x2){qf[buf][1].x, qf[buf][1].y}) + wc[buf][2] * S[2]; n[3] = unpk4((u32x2){qf[buf][1].z, qf[buf][1].w}) + wc[buf][3] * S[3]; \
        _Pragma("unroll") for (int kt = 0; kt < 4; ++kt) { n[kt] = MF(*(const bf16x8*)&pf[buf][kt * 2 + 0], s0, n[kt]); n[kt] = MF(*(const bf16x8*)&pf[buf][kt * 2 + 1], s1, n[kt]); } \
        _Pragma("unroll") for (int kt = 0; kt < 4; ++kt) S[kt] = n[kt]; } while (0)
        const size_t u0 = (size_t)bh * NCH;
        CHAIN_LOAD(0, u0);
        for (int c = 0; c < NCH; c += 2) {
            CHAIN_LOAD(1, u0 + c + 1);
            CHAIN_STEP(0, u0 + c);
            if (c + 2 < NCH) CHAIN_LOAD(0, u0 + c + 2);
            CHAIN_STEP(1, u0 + c + 1);
        }
#undef CHAIN_LOAD
#undef CHAIN_STEP
    }
}
__device__ __forceinline__ void p5_chunk_out(Frame& F) {
    const u32x4* SF = WSP(u32x4, WS_SF); const u32x4* RF = WSP(u32x4, WS_RF); const u32x4* YF = WSP(u32x4, WS_YF); const float* BON = WSP(float, WS_BON);
    const bf16_t* VB = WSP(bf16_t, WS_VB); const bf16_t* GG = WSP(bf16_t, WS_G); bf16_t* YG = WSP(bf16_t, WS_YG);
    const int lane = F.lane, q16 = lane & 15, qd = lane >> 4;
    const int gw = F.vcu * NWAVES + F.wave, NGW = F.G * NWAVES;
    for (int job = gw; job < NUNIT * 4; job += NGW) {
        const int unit = job >> 2, tt = job & 3, bh = unit >> 8, ch = unit & 255, b = bh >> 4, h = bh & 15;
        const size_t m = (size_t)b * SEQ + (size_t)ch * CH + 16 * tt + q16;
        const u32x4 r0 = RF[((size_t)unit * 8 + tt * 2 + 0) * 64 + lane], r1 = RF[((size_t)unit * 8 + tt * 2 + 1) * 64 + lane];
        const u32x4 y0 = YF[((size_t)unit * 8 + tt * 2 + 0) * 64 + lane], y1 = YF[((size_t)unit * 8 + tt * 2 + 1) * 64 + lane];
        u32x4 sf[4][2]; u32x2 vw[4], gw_[4];
#pragma unroll
        for (int vt = 0; vt < 4; ++vt) { sf[vt][0] = SF[((size_t)unit * 8 + vt * 2 + 0) * 64 + lane]; sf[vt][1] = SF[((size_t)unit * 8 + vt * 2 + 1) * 64 + lane];
            const size_t off = m * D + h * 64 + 16 * vt + 4 * qd; vw[vt] = *(const u32x2*)(VB + off); gw_[vt] = *(const u32x2*)(GG + off); }
        const float bn = BON[m * 16 + h];
        f32x4 y[4];
        y[0] = unpk4((u32x2){y0.x, y0.y}); y[1] = unpk4((u32x2){y0.z, y0.w}); y[2] = unpk4((u32x2){y1.x, y1.y}); y[3] = unpk4((u32x2){y1.z, y1.w});
#pragma unroll
        for (int vt = 0; vt < 4; ++vt) { y[vt] = MF(*(const bf16x8*)&sf[vt][0], *(const bf16x8*)&r0, y[vt]); y[vt] = MF(*(const bf16x8*)&sf[vt][1], *(const bf16x8*)&r1, y[vt]); }
        float s = 0.f;
#pragma unroll
        for (int vt = 0; vt < 4; ++vt) s += (y[vt][0] + y[vt][1]) + (y[vt][2] + y[vt][3]);
        s += __shfl_xor(s, 16); s += __shfl_xor(s, 32);
        const float mean = s * (1.f / 64.f); float qv = 0.f;
#pragma unroll
        for (int vt = 0; vt < 4; ++vt) { y[vt] = y[vt] - mean; qv += (y[vt][0] * y[vt][0] + y[vt][1] * y[vt][1]) + (y[vt][2] * y[vt][2] + y[vt][3] * y[vt][3]); }
        qv += __shfl_xor(qv, 16); qv += __shfl_xor(qv, 32);
        const float rstd = 1.f / sqrtf(qv * (1.f / 64.f) + LNX_EPS);
#pragma unroll
        for (int vt = 0; vt < 4; ++vt) {
            const int c = h * 64 + 16 * vt + 4 * qd; const size_t off = m * D + c;
            const f32x4 vv = unpk4(vw[vt]), gg = unpk4(gw_[vt]);
            const f32x4 o = ((y[vt] * rstd) * *(const f32x4*)(F.in[19] + c) + *(const f32x4*)(F.in[20] + c) + bn * vv) * gg;
            u32x2 wv; wv.x = cvt_pk_bf16(o[0], o[1]); wv.y = cvt_pk_bf16(o[2], o[3]);
            *(u32x2*)(YG + off) = wv;
        }
    }
}
#undef FRAG
#undef MF

__device__ __forceinline__ void ln_apply(f32x4 (&v)[4], const float* g, const float* b, int lane) {
    float s = 0.f;
#pragma unroll
    for (int j = 0; j < 4; ++j) s += (v[j][0] + v[j][1]) + (v[j][2] + v[j][3]);
    const float mean = wave_sum(s) * (1.f / D); float s2 = 0.f;
#pragma unroll
    for (int j = 0; j < 4; ++j) { v[j] = v[j] - mean; s2 += (v[j][0] * v[j][0] + v[j][1] * v[j][1]) + (v[j][2] * v[j][2] + v[j][3] * v[j][3]); }
    const float rstd = 1.f / sqrtf(wave_sum(s2) * (1.f / D) + LN_EPS);
#pragma unroll
    for (int j = 0; j < 4; ++j) { const int c = 4 * lane + 256 * j; v[j] = v[j] * rstd * *(const f32x4*)(g + c) + *(const f32x4*)(b + c); }
}
__device__ __forceinline__ void mod_store(const f32x4 (&v)[4], const float* shift, const float* scale, bf16_t* orow, int lane) {
#pragma unroll
    for (int j = 0; j < 4; ++j) { const int c = 4 * lane + 256 * j; const f32x4 o = v[j] * (1.f + *(const f32x4*)(scale + c)) + *(const f32x4*)(shift + c);
        u32x2 w; w.x = cvt_pk_bf16(o[0], o[1]); w.y = cvt_pk_bf16(o[2], o[3]); *(u32x2*)(orow + c) = w; }
}
__device__ __forceinline__ void mod_store_q8(const f32x4 (&v)[4], const float* shift, const float* scale, unsigned char* orow, float* rs, int lane) {
    f32x4 o[4]; float mx = 0.f;
#pragma unroll
    for (int j = 0; j < 4; ++j) { const int c = 4 * lane + 256 * j; o[j] = v[j] * (1.f + *(const f32x4*)(scale + c)) + *(const f32x4*)(shift + c);
        mx = fmaxf(mx, fmaxf(fmaxf(fabsf(o[j][0]), fabsf(o[j][1])), fmaxf(fabsf(o[j][2]), fabsf(o[j][3])))); }
#pragma unroll
    for (int of = 1; of < 64; of <<= 1) mx = fmaxf(mx, __shfl_xor(mx, of));
    mx = fmaxf(mx, 1e-20f); const float inv = 127.f / mx;
    if (lane == 0) *rs = mx * (1.f / 127.f);
#pragma unroll
    for (int j = 0; j < 4; ++j) *(unsigned*)(orow + 4 * lane + 256 * j) = pk4_i8(o[j][0] * inv, o[j][1] * inv, o[j][2] * inv, o[j][3] * inv);
}
__device__ __forceinline__ void p_postnorm(Frame& F, const float* xres, const bf16_t* y, float* xout, int sub, int modA, bf16_t* outA, int modB, bf16_t* outB, int modQ = 0, unsigned char* outQ = nullptr, float* rsQ = nullptr, int modQ2 = 0, unsigned char* outQ2 = nullptr, float* rsQ2 = nullptr) {
    const int gw = F.vcu * NWAVES + F.wave, NGW = F.G * NWAVES;
    const float* MOD = WSP(float, WS_MOD); const float* g = F.in[4] + sub * D; const float* bb = F.in[5] + sub * D;
    for (int m = gw; m < T; m += NGW) {
        const int b = m >> 14; const float* gate = MOD + b * ADA_W + (sub * 3 + 2) * D;
        f32x4 v[4];
#pragma unroll
        for (int j = 0; j < 4; ++j) { const int c = 4 * F.lane + 256 * j;
            const u32x2 yw = *(const u32x2*)(y + (size_t)m * D + c); const f32x4 yv = (f32x4){bflo(yw.x), bfhi(yw.x), bflo(yw.y), bfhi(yw.y)};
            v[j] = DN_ALPHA * *(const f32x4*)(xres + (size_t)m * D + c) + (1.f + *(const f32x4*)(gate + c)) * yv; }
        ln_apply(v, g, bb, F.lane);
#pragma unroll
        for (int j = 0; j < 4; ++j) *(f32x4*)(xout + (size_t)m * D + 4 * F.lane + 256 * j) = v[j];
        if (outA) mod_store(v, MOD + b * ADA_W + modA, MOD + b * ADA_W + modA + D, outA + (size_t)m * D, F.lane);
        if (outB) mod_store(v, MOD + b * ADA_W + modB, MOD + b * ADA_W + modB + D, outB + (size_t)m * D, F.lane);
        if (outQ) mod_store_q8(v, MOD + b * ADA_W + modQ, MOD + b * ADA_W + modQ + D, outQ + (size_t)m * D, rsQ + m, F.lane);
        if (outQ2) mod_store_q8(v, MOD + b * ADA_W + modQ2, MOD + b * ADA_W + modQ2 + D, outQ2 + (size_t)m * D, rsQ2 + m, F.lane);
    }
}

constexpr int KS_STRIDE = 72;
constexpr int VT_STRIDE = 264;
__device__ __forceinline__ void p12_attn(Frame& F) {
    LAS bf16_t* Ks = (LAS bf16_t*)F.lds;
    LAS bf16_t* Vt = Ks + 256 * KS_STRIDE;
    const bf16_t* Q2 = WSP(bf16_t, WS_Q2); const bf16_t* K2 = WSP(bf16_t, WS_K2); const bf16_t* V2 = WSP(bf16_t, WS_V2);
    bf16_t* OG = WSP(bf16_t, WS_OG); float* LSE = WSP(float, WS_LSE);
    const int lane = F.lane, w = F.wave, q16 = lane & 15, qd = lane >> 4;
    for (int unit = F.vcu; unit < BATCH * 3 * 8 * 128; unit += F.G) {
        const int pb = unit & 127, hg = (unit >> 7) & 7, gb = unit >> 10, g = gb % 3, b = gb / 3;
        const int dil = g == 0 ? 1 : (g == 1 ? 4 : 16), nb = 128 / dil, phase = pb / nb, blk = pb % nb;
        const int hcol = (g * 8 + hg) * 64;
#pragma unroll
        for (int i = 0; i < 4; ++i) {
            const int ch = F.tid + 512 * i, key = ch >> 3, c8 = (ch & 7) * 8;
            const int pos = (blk - 1) * 128 + key;
            u32x4 kv = (u32x4){0u, 0u, 0u, 0u}, vv = (u32x4){0u, 0u, 0u, 0u};
            if (pos >= 0) { const size_t row = (size_t)b * SEQ + (size_t)pos * dil + phase;
                kv = *(const u32x4*)(K2 + row * QW + hcol + c8); vv = *(const u32x4*)(V2 + row * QW + hcol + c8); }
            *(LAS u32x4*)(Ks + key * KS_STRIDE + c8) = kv;
            Vt[(c8 + 0) * VT_STRIDE + key] = (bf16_t)(vv.x & 0xffff); Vt[(c8 + 1) * VT_STRIDE + key] = (bf16_t)(vv.x >> 16);
            Vt[(c8 + 2) * VT_STRIDE + key] = (bf16_t)(vv.y & 0xffff); Vt[(c8 + 3) * VT_STRIDE + key] = (bf16_t)(vv.y >> 16);
            Vt[(c8 + 4) * VT_STRIDE + key] = (bf16_t)(vv.z & 0xffff); Vt[(c8 + 5) * VT_STRIDE + key] = (bf16_t)(vv.z >> 16);
            Vt[(c8 + 6) * VT_STRIDE + key] = (bf16_t)(vv.w & 0xffff); Vt[(c8 + 7) * VT_STRIDE + key] = (bf16_t)(vv.w >> 16);
        }
        const int qi = 16 * w + q16;
        const size_t qrow = (size_t)b * SEQ + (size_t)(blk * 128 + qi) * dil + phase;
        const bf16x8 qf0 = *(const bf16x8*)(Q2 + qrow * QW + hcol + 8 * qd), qf1 = *(const bf16x8*)(Q2 + qrow * QW + hcol + 32 + 8 * qd);
        __syncthreads();
        const int kt0 = w < 6 ? w : 6;
        f32x4 s[10];
#pragma unroll
        for (int i = 0; i < 10; ++i) {
            const LAS bf16_t* kp = Ks + (16 * (kt0 + i) + q16) * KS_STRIDE + 8 * qd;
            const bf16x8 k0 = *(const LAS bf16x8*)kp, k1 = *(const LAS bf16x8*)(kp + 32);
            f32x4 a = (f32x4){0.f, 0.f, 0.f, 0.f};
            a = __builtin_amdgcn_mfma_f32_16x16x32_bf16(k0, qf0, a, 0, 0, 0);
            a = __builtin_amdgcn_mfma_f32_16x16x32_bf16(k1, qf1, a, 0, 0, 0);
            s[i] = a;
        }
        float mx = -1e30f;
#pragma unroll
        for (int i = 0; i < 10; ++i)
#pragma unroll
            for (int r = 0; r < 4; ++r) { const int kidx = 16 * (kt0 + i) + 4 * qd + r; const bool ok = (kidx >= qi) && (kidx <= qi + 128) && (blk > 0 || kidx >= 128);
                s[i][r] = ok ? s[i][r] : -1e30f; mx = fmaxf(mx, s[i][r]); }
        mx = fmaxf(mx, __shfl_xor(mx, 16)); mx = fmaxf(mx, __shfl_xor(mx, 32));
        float l = 0.f;
#pragma unroll
        for (int i = 0; i < 10; ++i)
#pragma unroll
            for (int r = 0; r < 4; ++r) { const float p = __expf(s[i][r] - mx); s[i][r] = p; l += p; }
        l += __shfl_xor(l, 16); l += __shfl_xor(l, 32);
        f32x4 o[4];
#pragma unroll
        for (int dt = 0; dt < 4; ++dt) o[dt] = (f32x4){0.f, 0.f, 0.f, 0.f};
#pragma unroll
        for (int i = 0; i < 5; ++i) {
            union { bf16x8 v; unsigned u[4]; } pf;
            pf.u[0] = cvt_pk_bf16(s[2 * i][0], s[2 * i][1]); pf.u[1] = cvt_pk_bf16(s[2 * i][2], s[2 * i][3]);
            pf.u[2] = cvt_pk_bf16(s[2 * i + 1][0], s[2 * i + 1][1]); pf.u[3] = cvt_pk_bf16(s[2 * i + 1][2], s[2 * i + 1][3]);
#pragma unroll
            for (int dt = 0; dt < 4; ++dt) {
                const LAS bf16_t* vp = Vt + (16 * dt + q16) * VT_STRIDE + 16 * (kt0 + 2 * i) + 4 * qd;
                union { bf16x8 v; s16x4 h[2]; } vf; vf.h[0] = *(const LAS s16x4*)vp; vf.h[1] = *(const LAS s16x4*)(vp + 16);
                o[dt] = __builtin_amdgcn_mfma_f32_16x16x32_bf16(vf.v, pf.v, o[dt], 0, 0, 0);
            }
        }
        const float il = 1.f / l;
        bf16_t* op = OG + (size_t)g * T * AOUT + qrow * AOUT + hg * 64 + 4 * qd;
#pragma unroll
        for (int dt = 0; dt < 4; ++dt) { u32x2 wv; wv.x = cvt_pk_bf16(o[dt][0] * il, o[dt][1] * il); wv.y = cvt_pk_bf16(o[dt][2] * il, o[dt][3] * il); *(u32x2*)(op + 16 * dt) = wv; }
        if (qd == 0) LSE[(size_t)g * T * 8 + qrow * 8 + hg] = mx + __logf(l);
        __syncthreads();
    }
}
__device__ __forceinline__ void p13_merge(Frame& F) {
    const bf16_t* OG = WSP(bf16_t, WS_OG); const float* LSE = WSP(float, WS_LSE); bf16_t* OM = WSP(bf16_t, WS_OM);
    for (int idx = F.vcu * 512 + F.tid; idx < T * 64; idx += F.G * 512) {
        const int m = idx >> 6, hg = (idx >> 3) & 7, c8 = (idx & 7) * 8;
        const float l0 = LSE[(size_t)0 * T * 8 + m * 8 + hg], l1 = LSE[(size_t)1 * T * 8 + m * 8 + hg], l2 = LSE[(size_t)2 * T * 8 + m * 8 + hg];
        const float mx = fmaxf(l0, fmaxf(l1, l2)); float w0 = __expf(l0 - mx), w1 = __expf(l1 - mx), w2 = __expf(l2 - mx); const float inv = 1.f / (w0 + w1 + w2); w0 *= inv; w1 *= inv; w2 *= inv;
        const size_t off = (size_t)m * AOUT + hg * 64 + c8;
        const u32x4 a = *(const u32x4*)(OG + off), bq = *(const u32x4*)(OG + (size_t)T * AOUT + off), c = *(const u32x4*)(OG + (size_t)2 * T * AOUT + off);
        u32x4 o;
        o.x = cvt_pk_bf16(w0 * bflo(a.x) + w1 * bflo(bq.x) + w2 * bflo(c.x), w0 * bfhi(a.x) + w1 * bfhi(bq.x) + w2 * bfhi(c.x));
        o.y = cvt_pk_bf16(w0 * bflo(a.y) + w1 * bflo(bq.y) + w2 * bflo(c.y), w0 * bfhi(a.y) + w1 * bfhi(bq.y) + w2 * bfhi(c.y));
        o.z = cvt_pk_bf16(w0 * bflo(a.z) + w1 * bflo(bq.z) + w2 * bflo(c.z), w0 * bfhi(a.z) + w1 * bfhi(bq.z) + w2 * bfhi(c.z));
        o.w = cvt_pk_bf16(w0 * bflo(a.w) + w1 * bflo(bq.w) + w2 * bflo(c.w), w0 * bfhi(a.w) + w1 * bfhi(bq.w) + w2 * bfhi(c.w));
        *(u32x4*)(OM + off) = o;
    }
}

__device__ __forceinline__ void p15_ln_route(Frame& F) {
    LAS float* RT = (LAS float*)F.lds;
    LAS int* lcnt = (LAS int*)(F.lds + 32768);
    LAS int* lbase = lcnt + 8;
    LAS int* lte = lcnt + 16;
    LAS int* ltr = lte + 256;
    LAS float* ltw = (LAS float*)(ltr + 256);
    const float* MOD = WSP(float, WS_MOD); const float* g = F.in[4] + 2 * D; const float* bb = F.in[5] + 2 * D;
    const float* X2 = WSP(float, WS_X2); const bf16_t* Y3 = WSP(bf16_t, WS_Y3); float* X3 = F.out; unsigned char* H4 = WSP(unsigned char, WS_H4); float* RSH4 = (float*)(F.ws + WS_ROUTE + RT_RSH4);
    int* TOKE = (int*)(F.ws + WS_ROUTE + RT_TOKE); int* TOKR = (int*)(F.ws + WS_ROUTE + RT_TOKR); float* TOKW = (float*)(F.ws + WS_ROUTE + RT_TOKW);
    int* ROWTOK = (int*)(F.ws + WS_ROUTE + RT_ROWTOK);
    for (int i = F.tid; i < D * 8; i += 512) RT[i] = F.in[27][i];
    for (int i = F.vcu * 512 + F.tid; i < RMAX; i += F.G * 512) ROWTOK[i] = T;
    if (F.vcu == 0) { for (int i = F.tid; i < D / 4; i += 512) ((unsigned*)(H4 + (size_t)T * D))[i] = 0u; if (F.tid == 0) RSH4[T] = 0.f; }
    __syncthreads();
    for (int chunk = F.vcu; chunk < T / 128; chunk += F.G) {
        if (F.tid < 8) lcnt[F.tid] = 0;
        __syncthreads();
        for (int i = 0; i < 16; ++i) {
            const int lr = F.wave * 16 + i, m = chunk * 128 + lr, b = m >> 14;
            const float* gate = MOD + b * ADA_W + (2 * 3 + 2) * D;
            f32x4 v[4];
#pragma unroll
            for (int j = 0; j < 4; ++j) { const int c = 4 * F.lane + 256 * j;
                const u32x2 yw = *(const u32x2*)(Y3 + (size_t)m * D + c); const f32x4 yv = (f32x4){bflo(yw.x), bfhi(yw.x), bflo(yw.y), bfhi(yw.y)};
                v[j] = DN_ALPHA * *(const f32x4*)(X2 + (size_t)m * D + c) + (1.f + *(const f32x4*)(gate + c)) * yv; }
            ln_apply(v, g, bb, F.lane);
#pragma unroll
            for (int j = 0; j < 4; ++j) *(f32x4*)(X3 + (size_t)m * D + 4 * F.lane + 256 * j) = v[j];
            const float* shift = MOD + b * ADA_W + (3 * 3 + 0) * D; const float* scale = MOD + b * ADA_W + (3 * 3 + 1) * D;
            float lg[8];
#pragma unroll
            for (int e = 0; e < 8; ++e) lg[e] = 0.f;
            f32x4 hq[4]; float mx = 0.f;
#pragma unroll
            for (int j = 0; j < 4; ++j) { const int c = 4 * F.lane + 256 * j; const f32x4 hh = v[j] * (1.f + *(const f32x4*)(scale + c)) + *(const f32x4*)(shift + c);
                hq[j] = hh; mx = fmaxf(mx, fmaxf(fmaxf(fabsf(hh[0]), fabsf(hh[1])), fmaxf(fabsf(hh[2]), fabsf(hh[3]))));
#pragma unroll
                for (int q = 0; q < 4; ++q) { const f32x4 r0 = *(const LAS f32x4*)(RT + (c + q) * 8), r1 = *(const LAS f32x4*)(RT + (c + q) * 8 + 4);
                    lg[0] += hh[q] * r0[0]; lg[1] += hh[q] * r0[1]; lg[2] += hh[q] * r0[2]; lg[3] += hh[q] * r0[3];
                    lg[4] += hh[q] * r1[0]; lg[5] += hh[q] * r1[1]; lg[6] += hh[q] * r1[2]; lg[7] += hh[q] * r1[3]; } }
#pragma unroll
            for (int of = 1; of < 64; of <<= 1) mx = fmaxf(mx, __shfl_xor(mx, of));
            mx = fmaxf(mx, 1e-20f); { const float inv = 127.f / mx;
#pragma unroll
                for (int j = 0; j < 4; ++j) *(unsigned*)(H4 + (size_t)m * D + 4 * F.lane + 256 * j) = pk4_i8(hq[j][0] * inv, hq[j][1] * inv, hq[j][2] * inv, hq[j][3] * inv);
                if (F.lane == 0) RSH4[m] = mx * (1.f / 127.f); }
#pragma unroll
            for (int e = 0; e < 8; ++e) lg[e] = wave_sum(lg[e]);
            int e1 = 0; float m1 = lg[0];
#pragma unroll
            for (int e = 1; e < 8; ++e) if (lg[e] > m1) { m1 = lg[e]; e1 = e; }
            int e2 = -1; float m2 = -3.0e38f;
#pragma unroll
            for (int e = 0; e < 8; ++e) if (e != e1 && lg[e] > m2) { m2 = lg[e]; e2 = e; }
            if (e2 < 0) { e2 = (e1 + 1) & 7; m2 = m1; }
            if (F.lane == 0) {
                const float w1 = 1.f / (1.f + __expf(m2 - m1));
                lte[lr * 2] = e1; lte[lr * 2 + 1] = e2; ltw[lr * 2] = w1; ltw[lr * 2 + 1] = 1.f - w1;
                ltr[lr * 2] = atomicAdd((int*)&lcnt[e1], 1); ltr[lr * 2 + 1] = atomicAdd((int*)&lcnt[e2], 1);
            }
        }
        __syncthreads();
        if (F.tid < 8) lbase[F.tid] = (int)__hip_atomic_fetch_add((unsigned*)(F.ctl + CW_CNT + F.tid), (unsigned)lcnt[F.tid], RLX_AGENT);
        __syncthreads();
        if (F.tid < 256) { const int m = chunk * 128 + (F.tid >> 1), s = F.tid & 1; const int e = lte[F.tid];
            TOKE[m * 2 + s] = e; TOKR[m * 2 + s] = lbase[e] + ltr[F.tid]; TOKW[m * 2 + s] = ltw[F.tid]; }
        __syncthreads();
    }
}
__device__ __forceinline__ void p16_place(Frame& F) {
    int* TOKE = (int*)(F.ws + WS_ROUTE + RT_TOKE); int* TOKR = (int*)(F.ws + WS_ROUTE + RT_TOKR);
    int* ROWTOK = (int*)(F.ws + WS_ROUTE + RT_ROWTOK); int* BLKEXP = (int*)(F.ws + WS_ROUTE + RT_BLKEXP);
    int pstart[8], pend[8]; int acc = 0;
#pragma unroll
    for (int e = 0; e < 8; ++e) { const int c = (int)__hip_atomic_load((unsigned*)(F.ctl + CW_CNT + e), RLX_AGENT); pstart[e] = acc; acc += (c + 255) / 256 * 256; pend[e] = acc; }
    for (int idx = F.vcu * 512 + F.tid; idx < T * 2; idx += F.G * 512) {
        const int e = TOKE[idx]; int ps = 0;
#pragma unroll
        for (int j = 0; j < 8; ++j) ps = (e == j) ? pstart[j] : ps;
        const int dest = ps + TOKR[idx]; ROWTOK[dest] = idx >> 1; TOKR[idx] = dest;
    }
    if (F.vcu == 0) {
        for (int blk = F.tid; blk < NBLKMAX; blk += 512) { int e = 0;
#pragma unroll
            for (int j = 0; j < 8; ++j) e += (pend[j] <= blk * 256) ? 1 : 0;
            BLKEXP[blk] = e < 8 ? e : 7; }
        if (F.tid == 0) __hip_atomic_store((unsigned*)(F.ctl + CW_NBLK), (unsigned)(acc / 256), RLX_AGENT);
    }
}
__device__ __forceinline__ void p19_final(Frame& F) {
    const int gw = F.vcu * NWAVES + F.wave, NGW = F.G * NWAVES;
    const float* MOD = WSP(float, WS_MOD); const float* g = F.in[4] + 3 * D; const float* bb = F.in[5] + 3 * D;
    const bf16_t* YB = WSP(bf16_t, WS_YB); const int* TOKR = (const int*)(F.ws + WS_ROUTE + RT_TOKR); const float* TOKW = (const float*)(F.ws + WS_ROUTE + RT_TOKW);
    float* X = F.out;
    for (int m = gw; m < T; m += NGW) {
        const int b = m >> 14; const float* gate = MOD + b * ADA_W + (3 * 3 + 2) * D;
        const int d0 = TOKR[m * 2], d1 = TOKR[m * 2 + 1]; const float w0 = TOKW[m * 2], w1 = TOKW[m * 2 + 1];
        f32x4 v[4];
#pragma unroll
        for (int j = 0; j < 4; ++j) { const int c = 4 * F.lane + 256 * j;
            const u32x2 a = *(const u32x2*)(YB + (size_t)d0 * D + c), q = *(const u32x2*)(YB + (size_t)d1 * D + c);
            const f32x4 y = (f32x4){w0 * bflo(a.x) + w1 * bflo(q.x), w0 * bfhi(a.x) + w1 * bfhi(q.x), w0 * bflo(a.y) + w1 * bflo(q.y), w0 * bfhi(a.y) + w1 * bfhi(q.y)};
            v[j] = DN_ALPHA * *(const f32x4*)(X + (size_t)m * D + c) + (1.f + *(const f32x4*)(gate + c)) * y; }
        ln_apply(v, g, bb, F.lane);
#pragma unroll
        for (int j = 0; j < 4; ++j) *(f32x4*)(X + (size_t)m * D + 4 * F.lane + 256 * j) = v[j];
    }
}

struct Args { const float* in[30]; float* out; unsigned char* ws; int ph_lo, ph_hi, li, pad; };
__global__ void __launch_bounds__(NWAVES * 64, 2) fwd(Args args) {
    extern __shared__ __attribute__((aligned(16))) unsigned char lds[];
    Frame F;
    F.lds = (LAS unsigned char*)lds;
    F.MISC = (volatile LAS unsigned*)(F.lds + MISC_OFF);
    F.tid = threadIdx.x; F.lane = F.tid & 63; F.wave = __builtin_amdgcn_readfirstlane(F.tid >> 6);
    F.G = gridDim.x; { const int bx = blockIdx.x; F.vcu = (F.G % 8 == 0) ? (bx % 8) * (F.G / 8) + bx / 8 : bx; }
    F.ws = args.ws; F.ctl = (gu32*)(args.ws + WS_CTL); F.out = args.out;
    F.in = args.in;
    for (int u = F.tid; u < (LDS_BYTES - LDSCTL_OFF) / 4; u += NWAVES * 64) ((LAS unsigned*)(F.lds + LDSCTL_OFF))[u] = 0u;
    __syncthreads();
    XcdBarrier bar; bar.bar = (unsigned*)(F.ctl + CW_BAR); bar.x = 0; bar.st = nullptr;
    if (N_LAUNCHES != NPH) bar = xcd_barrier_post((unsigned*)(F.ctl + CW_BAR) + args.li * XCD_BAR_WORDS, F.MISC + 8);
#define GRID_BAR() do { if (N_LAUNCHES != NPH) xcd_barrier(bar); } while (0)
    const int lo = args.ph_lo, hi = args.ph_hi;
#define IN(k) (lo <= (k) && (k) < hi)
#define BOTH(k) (IN(k) && IN((k) + 1))
    using namespace pg8;
    const int cid = (int)blockIdx.x;

    if (IN(0)) { p0_prologue(F); if (BOTH(0)) GRID_BAR(); }
    if (IN(1)) { p1_lerp(F); if (BOTH(1)) GRID_BAR(); }
    if (IN(2)) {
        Gemm g{WSP(bf16_t, WS_A6) + (size_t)3 * T * D, WSP(bf16_t, WS_WL1), D, D, (size_t)T * D * 2, (size_t)256 * D * 2, nullptr, nullptr, 0};
        StaticOrder S; S.init(T / 256, 1, 3, F.G, cid);
        EpiBf16Z<1, 0, 2> E{WSP(bf16_t, WS_L1), 256, (size_t)T * 256};
        gemm_phase<EpiBf16Z<1, 0, 2>, StaticOrder, true>(F.lds, g, S, E);
        if (BOTH(2)) GRID_BAR();
    }
    if (IN(3)) {
        { Gemm g{WSP(bf16_t, WS_A6Q), WSP(bf16_t, WS_WRKV), D / 2, D / 2, (size_t)T * D, (size_t)D * D, nullptr, nullptr, 0};
          StaticOrder S; S.init(T / 256, D / 256, 3, F.G, cid);
          EpiBf16Q E{WSP(bf16_t, WS_RB), D, (size_t)T * D, WSP(float, WS_RSA), (size_t)T, QW_STEP};
          gemm_phase<EpiBf16Q, StaticOrder, true, 1>(F.lds, g, S, E); }
        { Gemm g{WSP(bf16_t, WS_L1), WSP(bf16_t, WS_WL2), 256, 256, (size_t)T * 256 * 2, (size_t)D * 256 * 2, nullptr, nullptr, 0};
          StaticOrder S; S.init(T / 256, D / 256, 3, F.G, cid);
          EpiLora2 E{F.out, WSP(bf16_t, WS_AS), WSP(bf16_t, WS_G), F.in[8], F.in[11]};
          gemm_phase<EpiLora2, StaticOrder, true>(F.lds, g, S, E); }
        if (BOTH(3)) GRID_BAR();
    }
    if (IN(4)) { p4a_chunk(F); GRID_BAR(); p4b_chain(F); if (BOTH(4)) GRID_BAR(); }
    if (IN(5)) { p5_chunk_out(F); if (BOTH(5)) GRID_BAR(); }
    if (IN(6)) {
        Gemm g{WSP(bf16_t, WS_YG), WSP(bf16_t, WS_WOUT), D, D, 0, 0, nullptr, nullptr, 0};
        StaticOrder S; S.init(T / 256, D / 256, 1, F.G, cid);
        EpiBf16Z<0, 0, 0> E{WSP(bf16_t, WS_Y1), D, 0};
        gemm_phase<EpiBf16Z<0, 0, 0>, StaticOrder, true>(F.lds, g, S, E);
        if (BOTH(6)) GRID_BAR();
    }
    if (IN(7)) { p_postnorm(F, F.in[0], WSP(bf16_t, WS_Y1), WSP(float, WS_X1), 0, 0, nullptr, 0, nullptr, (1 * 3 + 0) * D, WSP(unsigned char, WS_H2), WSP(float, WS_RSH2)); if (BOTH(7)) GRID_BAR(); }
    if (IN(8)) {
        Gemm g{WSP(bf16_t, WS_H2), WSP(bf16_t, WS_WFGU), D / 2, D / 2, 0, 0, nullptr, nullptr, 0};
        StaticOrder S; S.init(T / 256, 2 * DFF / 256, 1, F.G, cid);
        EpiSwigluQ E{WSP(bf16_t, WS_ACT), DFF, WSP(float, WS_RSH2), nullptr, QW_STEP};
        gemm_phase<EpiSwigluQ, StaticOrder, true, 1>(F.lds, g, S, E);
        if (BOTH(8)) GRID_BAR();
    }
    if (IN(9)) {
        Gemm g{WSP(bf16_t, WS_ACT), WSP(bf16_t, WS_WFDN), DFF, DFF, 0, 0, nullptr, nullptr, 0};
        StaticOrder S; S.init(T / 256, D / 256, 1, F.G, cid);
        EpiBf16Z<0, 0, 0> E{WSP(bf16_t, WS_Y2), D, 0};
        gemm_phase<EpiBf16Z<0, 0, 0>, StaticOrder, true>(F.lds, g, S, E);
        if (BOTH(9)) GRID_BAR();
    }
    if (IN(10)) { p_postnorm(F, WSP(float, WS_X1), WSP(bf16_t, WS_Y2), WSP(float, WS_X2), 1, 0, nullptr, 0, nullptr, 12 * D, WSP(unsigned char, WS_HKV), WSP(float, WS_RSKV), (2 * 3 + 0) * D, WSP(unsigned char, WS_H3), WSP(float, WS_RSKV) + T); if (BOTH(10)) GRID_BAR(); }
    if (IN(11)) {
        const float* cs = WSP(float, WS_ROPE); const float* sn = cs + SEQ * 32;
        { Gemm g{WSP(bf16_t, WS_HKV), WSP(bf16_t, WS_WKV), D / 2, D / 2, 0, 0, nullptr, nullptr, 0};
          StaticOrder S; S.init(T / 256, 2 * QW / 256, 1, F.G, cid);
          EpiRope E{WSP(bf16_t, WS_K2), WSP(bf16_t, WS_V2), QW, cs, sn, 1.f, WSP(float, WS_RSKV), QW_STEP};
          gemm_phase<EpiRope, StaticOrder, true, 1>(F.lds, g, S, E); }
        { Gemm g{WSP(bf16_t, WS_H3), WSP(bf16_t, WS_WQ), D / 2, D / 2, 0, 0, nullptr, nullptr, 0};
          StaticOrder S; S.init(T / 256, QW / 256, 1, F.G, cid);
          EpiRope E{WSP(bf16_t, WS_Q2), WSP(bf16_t, WS_Q2), QW, cs, sn, 0.125f, WSP(float, WS_RSKV) + T, QW_STEP};
          gemm_phase<EpiRope, StaticOrder, true, 1>(F.lds, g, S, E); }
        if (BOTH(11)) GRID_BAR();
    }
    if (IN(12)) { p12_attn(F); if (BOTH(12)) GRID_BAR(); }
    if (IN(13)) { p13_merge(F); if (BOTH(13)) GRID_BAR(); }
    if (IN(14)) {
        Gemm g{WSP(bf16_t, WS_OM), WSP(bf16_t, WS_WO), AOUT, AOUT, 0, 0, nullptr, nullptr, 0};
        StaticOrder S; S.init(T / 256, D / 256, 1, F.G, cid);
        EpiBf16Z<0, 0, 0> E{WSP(bf16_t, WS_Y3), D, 0};
        gemm_phase<EpiBf16Z<0, 0, 0>, StaticOrder, true>(F.lds, g, S, E);
        if (BOTH(14)) GRID_BAR();
    }
    if (IN(15)) { p15_ln_route(F); if (BOTH(15)) GRID_BAR(); }
    if (IN(16)) { p16_place(F); if (BOTH(16)) GRID_BAR(); }
    if (IN(17)) {
        const int nblk = (int)__hip_atomic_load((unsigned*)(F.ctl + CW_NBLK), RLX_AGENT);
        Gemm g{WSP(bf16_t, WS_H4), WSP(bf16_t, WS_WMGU), D / 2, D / 2, 0, 0, (const int*)(F.ws + WS_ROUTE + RT_ROWTOK), (const int*)(F.ws + WS_ROUTE + RT_BLKEXP), (size_t)2 * DFE * D};
        StaticOrder S; S.init(nblk, 2 * DFE / 256, 1, F.G, cid);
        EpiSwigluQ E{WSP(bf16_t, WS_ACT2), DFE, (const float*)(F.ws + WS_ROUTE + RT_RSH4), (const int*)(F.ws + WS_ROUTE + RT_ROWTOK), QW_STEP};
        gemm_phase<EpiSwigluQ, StaticOrder, true, 1>(F.lds, g, S, E);
        if (BOTH(17)) GRID_BAR();
    }
    if (IN(18)) {
        const int nblk = (int)__hip_atomic_load((unsigned*)(F.ctl + CW_NBLK), RLX_AGENT);
        Gemm g{WSP(bf16_t, WS_ACT2), WSP(bf16_t, WS_WMDN), DFE, DFE, 0, 0, nullptr, (const int*)(F.ws + WS_ROUTE + RT_BLKEXP), (size_t)D * DFE * 2};
        StaticOrder S; S.init(nblk, D / 256, 1, F.G, cid);
        EpiBf16Z<0, 0, 0> E{WSP(bf16_t, WS_YB), D, 0};
        gemm_phase<EpiBf16Z<0, 0, 0>, StaticOrder, true>(F.lds, g, S, E);
        if (BOTH(18)) GRID_BAR();
    }
    if (IN(19)) { p19_final(F); }
#undef IN
#undef BOTH
}

extern "C" void kernel_launch(void* const* d_in, const int* in_sizes, int n_in, void* d_out, int out_size, void* d_ws, size_t ws_size, hipStream_t stream) {
    static int grid = 0;
    if (grid == 0) {
        if (n_in != 30 || in_sizes[0] != T * D || out_size != T * D || ws_size < WS_END) { fprintf(stderr, "kernel_launch: unexpected shapes / workspace (%d inputs, ws %zu)\n", n_in, ws_size); grid = -1; return; }
        int dev = 0, cus = 0, per_cu = 0;
        if (hipGetDevice(&dev) != hipSuccess || hipDeviceGetAttribute(&cus, hipDeviceAttributeMultiprocessorCount, dev) != hipSuccess) { grid = -1; return; }
        if (hipFuncSetAttribute((const void*)fwd, hipFuncAttributeMaxDynamicSharedMemorySize, LDS_BYTES) != hipSuccess) { fprintf(stderr, "kernel_launch: hipFuncSetAttribute failed\n"); grid = -1; return; }
        if (hipOccupancyMaxActiveBlocksPerMultiprocessor(&per_cu, (const void*)fwd, NWAVES * 64, LDS_BYTES) != hipSuccess || per_cu < 1)
            fprintf(stderr, "kernel_launch: occupancy query reports %d workgroups per CU\n", per_cu);
        (void)hipGetLastError();
        grid = cus;
    }
    if (grid < 0) return;
    if (hipMemsetAsync((char*)d_ws + WS_CTL, 0, CTL_ZERO_BYTES, stream) != hipSuccess) return;
    Args a{};
    for (int i = 0; i < 30; ++i) a.in[i] = (const float*)d_in[i];
    a.out = (float*)d_out; a.ws = (unsigned char*)d_ws;
    for (int li = 0; li < N_LAUNCHES; ++li) {
        a.ph_lo = (N_LAUNCHES == NPH) ? li : 0; a.ph_hi = (N_LAUNCHES == NPH) ? li + 1 : NPH; a.li = (N_LAUNCHES == NPH) ? 0 : li;
        hipLaunchKernelGGL(fwd, dim3(grid), dim3(NWAVES * 64), LDS_BYTES, stream, a);
        if (hipPeekAtLastError() != hipSuccess) { fprintf(stderr, "kernel_launch: launch %d failed\n", li); break; }
    }
}
```

```cpp
#include <hip/hip_runtime.h>
#include <cstdio>
#include <cstdint>

#define LAS __attribute__((address_space(3)))
#define GAS __attribute__((address_space(1)))
typedef unsigned short bf16_t;
typedef short bf16x8 __attribute__((ext_vector_type(8)));
typedef short s16x4 __attribute__((ext_vector_type(4)));
typedef float f32x4 __attribute__((ext_vector_type(4)));
typedef float f32x2 __attribute__((ext_vector_type(2)));
typedef unsigned u32x4 __attribute__((ext_vector_type(4)));
typedef unsigned u32x2 __attribute__((ext_vector_type(2)));
typedef GAS unsigned gu32;
#define RLX_AGENT __ATOMIC_RELAXED, __HIP_MEMORY_SCOPE_AGENT

typedef __bf16 bf16x2_t __attribute__((ext_vector_type(2)));
__device__ __forceinline__ unsigned cvt_pk_bf16(float lo, float hi) { const f32x2 v = {lo, hi}; const bf16x2_t b = __builtin_convertvector(v, bf16x2_t); return __builtin_bit_cast(unsigned, b); }
typedef int i32x4 __attribute__((ext_vector_type(4)));
__device__ __forceinline__ unsigned q8u(float x) { return (unsigned)(int)fminf(fmaxf(rintf(x), -127.f), 127.f) & 0xffu; }
__device__ __forceinline__ unsigned pk4_i8(float a, float b, float c, float d) { return q8u(a) | (q8u(b) << 8) | (q8u(c) << 16) | (q8u(d) << 24); }
constexpr float QW_STEP = 4.0f / (32.0f * 127.0f), QW_INV = 1.0f / QW_STEP;
__device__ __forceinline__ float bflo(unsigned w) { return __uint_as_float(w << 16); }
__device__ __forceinline__ float bfhi(unsigned w) { return __uint_as_float(w & 0xffff0000u); }
__device__ __forceinline__ float sigmoidf_(float x) { return __builtin_amdgcn_rcpf(1.f + __expf(-x)); }
__device__ __forceinline__ float tanhf_(float x) { return 1.f - 2.f * __builtin_amdgcn_rcpf(1.f + __expf(2.f * x)); }
__device__ __forceinline__ float siluf_(float x) { return x * __builtin_amdgcn_rcpf(1.f + __expf(-x)); }
__device__ __forceinline__ int ld_i32(const int* p) { return (int)__hip_atomic_load((const unsigned*)p, RLX_AGENT); }

constexpr int BATCH = 2, SEQ = 16384, D = 1024, T = BATCH * SEQ;
constexpr int ADA_W = 14336;
constexpr int DFF = 2816, NEXP = 8, DFE = 3584;
constexpr int QW = 1536, AOUT = 512;
constexpr int RMAX = (T * 2 / 256 + NEXP) * 256;
constexpr int NBLKMAX = RMAX / 256;
constexpr float LN_EPS = 1e-5f, LNX_EPS = 64e-5f;
constexpr float DN_ALPHA = 1.4142135623730951f;

namespace pg8 {
constexpr int BM = 256, BK = 64, HALF = 128, HTB = HALF * BK * 2, STAGE_BYTES = 8 * HTB, NXCD = 8, WGM = 8;
__host__ __device__ __forceinline__ int lds_byte(int r, int c) { const int st = (r >> 4) * 2 + (c >> 5), rr = r & 15, cc = c & 31, ob = rr * 64 + cc * 2; return st * 1024 + (ob ^ (((ob >> 9) & 1) << 5)); }
__host__ __device__ __forceinline__ void stage_rc(int b, int& R, int& C) { const int st = b / 1024, sb = b % 1024, swz = sb ^ (((sb >> 9) & 1) << 5); R = (st >> 1) * 16 + swz / 64; C = (st & 1) * 32 + (swz % 64) / 2; }
__host__ __device__ __forceinline__ int perm32(int rho) { const int n = rho >> 4, i = rho & 15; return 8 * (i >> 2) + 4 * n + (i & 3); }

struct Unit { int pm, pn, z; };
struct Gemm { const bf16_t* A; const bf16_t* Bt; int K, lda; size_t azs, bzs; const int* rowmap; const int* blk_exp; size_t bes; };

struct StaticOrder {
    int nM, nN, nZ, nwg, G, c;
    __device__ void init(int nM_, int nN_, int nZ_, int G_, int c_) { nM = nM_; nN = nN_; nZ = nZ_; nwg = nM * nN; G = G_; c = c_; }
    __device__ bool next(int i, Unit& u) const {
        const long L = (long)i * G + c; if (L >= (long)nwg * nZ) return false;
        u.z = (int)(L / nwg); int wgid = (int)(L % nwg);
        { const int q = nwg / NXCD, r = nwg % NXCD, xcd = wgid % NXCD, off = wgid / NXCD; wgid = (xcd < r ? xcd * (q + 1) : r * (q + 1) + (xcd - r) * q) + off; }
        const int nig = WGM * nN, gid = wgid / nig, fm = gid * WGM, gsz = (nM - fm) < WGM ? (nM - fm) : WGM;
        u.pm = fm + ((wgid % nig) % gsz); u.pn = (wgid % nig) / gsz; return true;
    }
};

#define EPI_LOOP_BEGIN \
    const int row0 = u.pm * BM + wr * 64 + fr, col0 = u.pn * BM + wc * 32 + 8 * fq; \
    _Pragma("unroll") for (int ai = 0; ai < 2; ++ai) _Pragma("unroll") for (int m = 0; m < 4; ++m) { const int row = row0 + ai * HALF + m * 16; \
    _Pragma("unroll") for (int bj = 0; bj < 2; ++bj) { const int col = col0 + bj * HALF; f32x4 v0 = acc[ai][bj][m][0], v1 = acc[ai][bj][m][1];
#define EPI_LOOP_END } }

__device__ __forceinline__ float act_apply(int a, float x) { return a == 1 ? tanhf_(x) : (a == 2 ? sigmoidf_(x) : x); }
template <int ACT0, int ACT1, int ACT2> struct EpiBf16Z {
    static constexpr bool PERM = true;
    bf16_t* O; int ldc; size_t ozs;
    __device__ __forceinline__ void operator()(const f32x4 (&acc)[2][2][4][2], const Unit& u, int wr, int wc, int fr, int fq) const {
        const int a = u.z == 0 ? ACT0 : (u.z == 1 ? ACT1 : ACT2); bf16_t* base = O + (size_t)u.z * ozs;
        EPI_LOOP_BEGIN
            if (a) { _Pragma("unroll") for (int e = 0; e < 4; ++e) { v0[e] = act_apply(a, v0[e]); v1[e] = act_apply(a, v1[e]); } }
            u32x4 w; w.x = cvt_pk_bf16(v0[0], v0[1]); w.y = cvt_pk_bf16(v0[2], v0[3]); w.z = cvt_pk_bf16(v1[0], v1[1]); w.w = cvt_pk_bf16(v1[2], v1[3]);
            *(u32x4*)(base + (size_t)row * ldc + col) = w;
        EPI_LOOP_END
    }
};
struct EpiLora2 {
    static constexpr bool PERM = true;
    float* WLOG; bf16_t* AS; bf16_t* G; const float* w0; const float* a0;
    __device__ __forceinline__ void operator()(const f32x4 (&acc)[2][2][4][2], const Unit& u, int wr, int wc, int fr, int fq) const {
        EPI_LOOP_BEGIN
            if (u.z == 0) {
                const f32x4 b0 = *(const f32x4*)(w0 + col), b1 = *(const f32x4*)(w0 + col + 4);
                _Pragma("unroll") for (int e = 0; e < 4; ++e) {
                    float x = -(v0[e] + b0[e]); float sp = fmaxf(x, 0.f) + __logf(1.f + __expf(-fabsf(x))); v0[e] = -__expf(-sp - 0.5f);
                    x = -(v1[e] + b1[e]); sp = fmaxf(x, 0.f) + __logf(1.f + __expf(-fabsf(x))); v1[e] = -__expf(-sp - 0.5f); }
                float* p = WLOG + (size_t)row * D + col; *(f32x4*)p = v0; *(f32x4*)(p + 4) = v1;
            } else {
                if (u.z == 1) { const f32x4 b0 = *(const f32x4*)(a0 + col), b1 = *(const f32x4*)(a0 + col + 4);
                    _Pragma("unroll") for (int e = 0; e < 4; ++e) { v0[e] = sigmoidf_(v0[e] + b0[e]); v1[e] = sigmoidf_(v1[e] + b1[e]); } }
                u32x4 w; w.x = cvt_pk_bf16(v0[0], v0[1]); w.y = cvt_pk_bf16(v0[2], v0[3]); w.z = cvt_pk_bf16(v1[0], v1[1]); w.w = cvt_pk_bf16(v1[2], v1[3]);
                *(u32x4*)((u.z == 1 ? AS : G) + (size_t)row * D + col) = w;
            }
        EPI_LOOP_END
    }
};
struct EpiF32 {
    static constexpr bool PERM = true;
    float* O; int ldc;
    __device__ __forceinline__ void operator()(const f32x4 (&acc)[2][2][4][2], const Unit& u, int wr, int wc, int fr, int fq) const {
        EPI_LOOP_BEGIN
            float* p = O + (size_t)row * ldc + col; *(f32x4*)p = v0; *(f32x4*)(p + 4) = v1;
        EPI_LOOP_END
    }
};
struct EpiSwiglu {
    static constexpr bool PERM = true;
    bf16_t* O; int ldo;
    __device__ __forceinline__ void operator()(const f32x4 (&acc)[2][2][4][2], const Unit& u, int wr, int wc, int fr, int fq) const {
        EPI_LOOP_BEGIN
            u32x2 w; w.x = cvt_pk_bf16(siluf_(v0[0]) * v0[1], siluf_(v0[2]) * v0[3]); w.y = cvt_pk_bf16(siluf_(v1[0]) * v1[1], siluf_(v1[2]) * v1[3]);
            *(u32x2*)(O + (size_t)row * ldo + (col >> 1)) = w;
        EPI_LOOP_END
    }
};
template <int ACT0, int ACT1, int ACT2> struct EpiActQ {
    static constexpr bool PERM = true;
    bf16_t* O; int ldc; size_t ozs; const float* rs; size_t rzs; float ws;
    __device__ __forceinline__ void operator()(const f32x4 (&acc)[2][2][4][2], const Unit& u, int wr, int wc, int fr, int fq) const {
        const int a = u.z == 0 ? ACT0 : (u.z == 1 ? ACT1 : ACT2); bf16_t* base = O + (size_t)u.z * ozs; const float* r_ = rs + (size_t)u.z * rzs;
        EPI_LOOP_BEGIN
            const float sc = r_[row] * ws; v0 = v0 * sc; v1 = v1 * sc;
            if (a) { _Pragma("unroll") for (int e = 0; e < 4; ++e) { v0[e] = act_apply(a, v0[e]); v1[e] = act_apply(a, v1[e]); } }
            u32x4 w; w.x = cvt_pk_bf16(v0[0], v0[1]); w.y = cvt_pk_bf16(v0[2], v0[3]); w.z = cvt_pk_bf16(v1[0], v1[1]); w.w = cvt_pk_bf16(v1[2], v1[3]);
            *(u32x4*)(base + (size_t)row * ldc + col) = w;
        EPI_LOOP_END
    }
};
struct EpiBf16Q {
    static constexpr bool PERM = true;
    bf16_t* O; int ldc; size_t ozs; const float* rs; size_t rzs; float ws;
    __device__ __forceinline__ void operator()(const f32x4 (&acc)[2][2][4][2], const Unit& u, int wr, int wc, int fr, int fq) const {
        bf16_t* base = O + (size_t)u.z * ozs; const float* r_ = rs + (size_t)u.z * rzs;
        EPI_LOOP_BEGIN
            const float sc = r_[row] * ws; v0 = v0 * sc; v1 = v1 * sc;
            u32x4 w; w.x = cvt_pk_bf16(v0[0], v0[1]); w.y = cvt_pk_bf16(v0[2], v0[3]); w.z = cvt_pk_bf16(v1[0], v1[1]); w.w = cvt_pk_bf16(v1[2], v1[3]);
            *(u32x4*)(base + (size_t)row * ldc + col) = w;
        EPI_LOOP_END
    }
};
struct EpiSwigluQ {
    static constexpr bool PERM = true, PRE = true;
    bf16_t* O; int ldo; const float* rs; const int* rowmap; float ws;
    __device__ __forceinline__ void pre(const Unit& u, int wr, int fr, float (&p)[8]) const {
        const int row0 = u.pm * BM + wr * 64 + fr;
#pragma unroll
        for (int i = 0; i < 8; ++i) { const int row = row0 + (i >> 2) * HALF + (i & 3) * 16; p[i] = rs[rowmap ? rowmap[row] : row]; }
    }
    __device__ __forceinline__ void operator()(const f32x4 (&acc)[2][2][4][2], const Unit& u, int wr, int wc, int fr, int fq, const float (&p)[8]) const {
        const int row0 = u.pm * BM + wr * 64 + fr, col0 = u.pn * BM + wc * 32 + 8 * fq;
#pragma unroll
        for (int ai = 0; ai < 2; ++ai)
#pragma unroll
            for (int m = 0; m < 4; ++m) { const int row = row0 + ai * HALF + m * 16; const float sc = p[ai * 4 + m] * ws;
#pragma unroll
                for (int bj = 0; bj < 2; ++bj) { const int col = col0 + bj * HALF; const f32x4 v0 = acc[ai][bj][m][0] * sc, v1 = acc[ai][bj][m][1] * sc;
                    u32x2 w; w.x = cvt_pk_bf16(siluf_(v0[0]) * v0[1], siluf_(v0[2]) * v0[3]); w.y = cvt_pk_bf16(siluf_(v1[0]) * v1[1], siluf_(v1[2]) * v1[3]);
                    *(u32x2*)(O + (size_t)row * ldo + (col >> 1)) = w; } }
    }
};
struct EpiRope {
    static constexpr bool PERM = true;
    bf16_t* O; bf16_t* O2; int ncol_rope; const float* cs; const float* sn; float scale; const float* rs; float ws;
    __device__ __forceinline__ void operator()(const f32x4 (&acc)[2][2][4][2], const Unit& u, int wr, int wc, int fr, int fq) const {
        EPI_LOOP_BEGIN
            if (rs) { const float sc = rs[row] * ws; v0 = v0 * sc; v1 = v1 * sc; }
            bf16_t* dst;
            if (col < ncol_rope) {
                const int t = row & (SEQ - 1), i0 = (col & 63) >> 1;
                const f32x4 c4 = *(const f32x4*)(cs + (size_t)t * 32 + i0), s4 = *(const f32x4*)(sn + (size_t)t * 32 + i0);
                float a, b;
                a = v0[0]; b = v0[1]; v0[0] = (a * c4[0] - b * s4[0]) * scale; v0[1] = (b * c4[0] + a * s4[0]) * scale;
                a = v0[2]; b = v0[3]; v0[2] = (a * c4[1] - b * s4[1]) * scale; v0[3] = (b * c4[1] + a * s4[1]) * scale;
                a = v1[0]; b = v1[1]; v1[0] = (a * c4[2] - b * s4[2]) * scale; v1[1] = (b * c4[2] + a * s4[2]) * scale;
                a = v1[2]; b = v1[3]; v1[2] = (a * c4[3] - b * s4[3]) * scale; v1[3] = (b * c4[3] + a * s4[3]) * scale;
                dst = O + (size_t)row * ncol_rope + col;
            } else dst = O2 + (size_t)row * ncol_rope + (col - ncol_rope);
            u32x4 w; w.x = cvt_pk_bf16(v0[0], v0[1]); w.y = cvt_pk_bf16(v0[2], v0[3]); w.z = cvt_pk_bf16(v1[0], v1[1]); w.w = cvt_pk_bf16(v1[2], v1[3]);
            *(u32x4*)dst = w;
        EPI_LOOP_END
    }
};

template <class E_, class = void> struct epi_has_pre { static constexpr bool value = false; };
template <class E_> struct epi_has_pre<E_, decltype((void)E_::PRE)> { static constexpr bool value = E_::PRE; };
template <class Epi, class Sched, bool ALIGN_EPI, int MODE = 0>
__device__ __forceinline__ void gemm_phase(LAS unsigned char* lds, const Gemm g, const Sched& S, const Epi& E) {
    const int tid = threadIdx.x, wid = __builtin_amdgcn_readfirstlane(tid >> 6), lane = tid & 63, wr = wid >> 2, wc = wid & 3, fr = lane & 15, fq = lane >> 4;
    const int K = g.K, nt = K / BK;
    int RA[2], CA[2]; unsigned voffB[2];
#pragma unroll
    for (int i = 0; i < 2; ++i) { int R, C; stage_rc(tid * 16 + i * 8192, R, C); const int Rb = Epi::PERM ? ((R & ~31) + perm32(R & 31)) : R;
        RA[i] = R; CA[i] = C; voffB[i] = (unsigned)(Rb * K + C) * 2u; }
    const size_t kstep = (size_t)(BK * 2);
    const size_t hstepB = (size_t)HALF * K * 2, tstepB = 2 * hstepB;
    const unsigned ldsw = (unsigned)wid * 1024u;
    const int aoff = lds_byte(wr * 64 + fr, fq * 8), boff = lds_byte(wc * 32 + fr, fq * 8);
#define PG8_SA(b, h) (((b) * 2 + (h)) * HTB)
#define PG8_SB(b, h) ((4 + (b) * 2 + (h)) * HTB)
#define PG8_STAGE(bufoff, gbase, voff) do { _Pragma("unroll") for (int _i = 0; _i < 2; ++_i) \
        __builtin_amdgcn_global_load_lds((const unsigned*)((const char*)(gbase) + (voff)[_i]), (LAS unsigned*)(lds + (bufoff) + ldsw + _i * 8192), 16, 0, 0); } while (0)
#define PG8_VOFFA(v, uu) do { _Pragma("unroll") for (int _h = 0; _h < 2; ++_h) _Pragma("unroll") for (int _i = 0; _i < 2; ++_i) { int _row = (uu).pm * BM + _h * HALF + RA[_i]; \
        if (g.rowmap) _row = g.rowmap[_row]; (v)[_h][_i] = (unsigned)((size_t)(uu).z * g.azs) + (unsigned)(_row * g.lda + CA[_i]) * 2u; } } while (0)
#define PG8_BBASE(uu) ((const char*)g.Bt + (size_t)(uu).z * g.bzs + (g.blk_exp ? (size_t)ld_i32(g.blk_exp + (uu).pm) * g.bes : (size_t)0) + (size_t)(uu).pn * tstepB)
#define PG8_LDA(dst, b, h) do { _Pragma("unroll") for (int m = 0; m < 4; ++m) _Pragma("unroll") for (int k = 0; k < 2; ++k) dst[m][k] = *(const LAS bf16x8*)(lds + PG8_SA(b, h) + aoff + m * 2048 + k * 1024); } while (0)
#define PG8_LDB(dst, b, h) do { _Pragma("unroll") for (int n = 0; n < 2; ++n) _Pragma("unroll") for (int k = 0; k < 2; ++k) dst[n][k] = *(const LAS bf16x8*)(lds + PG8_SB(b, h) + boff + n * 2048 + k * 1024); } while (0)
#define PG8_MMA(ai, bj, At, Bt) do { __builtin_amdgcn_s_setprio(1); _Pragma("unroll") for (int m = 0; m < 4; ++m) _Pragma("unroll") for (int n = 0; n < 2; ++n) _Pragma("unroll") for (int k = 0; k < 2; ++k) { \
        if constexpr (MODE == 1) acc[ai][bj][m][n] = __builtin_bit_cast(f32x4, __builtin_amdgcn_mfma_i32_16x16x64_i8(__builtin_bit_cast(i32x4, Bt[n][k]), __builtin_bit_cast(i32x4, At[m][k]), __builtin_bit_cast(i32x4, acc[ai][bj][m][n]), 0, 0, 0)); \
        else acc[ai][bj][m][n] = __builtin_amdgcn_mfma_f32_16x16x32_bf16(Bt[n][k], At[m][k], acc[ai][bj][m][n], 0, 0, 0); } __builtin_amdgcn_s_setprio(0); } while (0)
#define PG8_WAIT_V(n) asm volatile("s_waitcnt vmcnt(" #n ")" ::: "memory")
#define PG8_WAIT_L(n) asm volatile("s_waitcnt lgkmcnt(" #n ")" ::: "memory")
#define PG8_BAR __builtin_amdgcn_s_barrier()
#define PG8_SCHED __builtin_amdgcn_sched_barrier(0)
    Unit cur, nxt; int ui = 0;
    if (!S.next(0, cur)) return;
    f32x4 acc[2][2][4][2];
#pragma unroll
    for (int a = 0; a < 2; ++a)
#pragma unroll
        for (int b = 0; b < 2; ++b)
#pragma unroll
            for (int m = 0; m < 4; ++m)
#pragma unroll
                for (int n = 0; n < 2; ++n) acc[a][b][m][n] = (f32x4){0.f, 0.f, 0.f, 0.f};
    bf16x8 At[4][2], B0[2][2], B1[2][2];
    unsigned vc[2][2], vn[2][2];
    float prs[8];
    if constexpr (epi_has_pre<Epi>::value) E.pre(cur, wr, fr, prs);
    const char* const Ab = (const char*)g.A;
    const char* cB = PG8_BBASE(cur);
    PG8_VOFFA(vc, cur);
    PG8_STAGE(PG8_SB(0, 0), cB, voffB); PG8_STAGE(PG8_SB(0, 1), cB + hstepB, voffB); PG8_STAGE(PG8_SA(0, 0), Ab, vc[0]); PG8_STAGE(PG8_SA(0, 1), Ab, vc[1]);
    if (wr == 1) PG8_BAR;
    PG8_WAIT_V(2); PG8_BAR;
    PG8_STAGE(PG8_SB(1, 0), cB + kstep, voffB); PG8_STAGE(PG8_SA(1, 0), Ab + kstep, vc[0]); PG8_STAGE(PG8_SB(1, 1), cB + hstepB + kstep, voffB);
    PG8_WAIT_V(6); PG8_BAR;
    for (;;) {
        const bool has_next = S.next(ui + 1, nxt);
        const char* nB = cB;
        if (has_next) { nB = PG8_BBASE(nxt); PG8_VOFFA(vn, nxt); }
        else {
#pragma unroll
            for (int h = 0; h < 2; ++h)
#pragma unroll
                for (int i = 0; i < 2; ++i) vn[h][i] = vc[h][i];
        }
        for (int t = 0; t < nt; t += 2) {
            const bool last = (t == nt - 2);
            const char* a1 = Ab + (size_t)(t + 1) * kstep;
            const char* a2 = last ? Ab : Ab + (size_t)(t + 2) * kstep; const char* b2 = last ? nB : cB + (size_t)(t + 2) * kstep;
            const char* a3 = a2 + kstep; const char* b3 = b2 + kstep;
            unsigned v2[2][2];
#pragma unroll
            for (int h = 0; h < 2; ++h)
#pragma unroll
                for (int i = 0; i < 2; ++i) v2[h][i] = last ? vn[h][i] : vc[h][i];
            PG8_LDB(B0, 0, 0); PG8_LDB(B1, 0, 1); PG8_SCHED; PG8_LDA(At, 0, 0); PG8_STAGE(PG8_SA(1, 1), a1, vc[1]);
            PG8_WAIT_V(8); PG8_WAIT_L(0); PG8_BAR; PG8_MMA(0, 0, At, B0); PG8_MMA(0, 1, At, B1); PG8_BAR; PG8_SCHED;
            PG8_LDA(At, 0, 1); PG8_STAGE(PG8_SB(0, 0), b2, voffB); PG8_STAGE(PG8_SB(0, 1), b2 + hstepB, voffB); PG8_STAGE(PG8_SA(0, 0), a2, v2[0]);
            PG8_WAIT_V(8); PG8_WAIT_L(0); PG8_BAR; PG8_MMA(1, 0, At, B0); PG8_MMA(1, 1, At, B1); PG8_BAR; PG8_SCHED;
            PG8_LDB(B0, 1, 0); PG8_LDB(B1, 1, 1); PG8_SCHED; PG8_LDA(At, 1, 0); PG8_STAGE(PG8_SA(0, 1), a2, v2[1]);
            PG8_WAIT_V(8); PG8_WAIT_L(0); PG8_BAR; PG8_MMA(0, 0, At, B0); PG8_MMA(0, 1, At, B1); PG8_BAR; PG8_SCHED;
            PG8_LDA(At, 1, 1); PG8_STAGE(PG8_SB(1, 0), b3, voffB); PG8_STAGE(PG8_SB(1, 1), b3 + hstepB, voffB); PG8_STAGE(PG8_SA(1, 0), a3, v2[0]);
            PG8_WAIT_V(8); PG8_WAIT_L(0); PG8_BAR; PG8_MMA(1, 0, At, B0); PG8_MMA(1, 1, At, B1); PG8_BAR; PG8_SCHED;
        }
        if constexpr (ALIGN_EPI) { if (wr == 0) PG8_BAR; }
        if constexpr (MODE == 1) {
#pragma unroll
            for (int a = 0; a < 2; ++a)
#pragma unroll
                for (int b = 0; b < 2; ++b)
#pragma unroll
                    for (int m = 0; m < 4; ++m)
#pragma unroll
                        for (int n = 0; n < 2; ++n) acc[a][b][m][n] = __builtin_convertvector(__builtin_bit_cast(i32x4, acc[a][b][m][n]), f32x4);
        }
        if constexpr (epi_has_pre<Epi>::value) E(acc, cur, wr, wc, fr, fq, prs); else E(acc, cur, wr, wc, fr, fq);
        if (!has_next) break;
#pragma unroll
        for (int a = 0; a < 2; ++a)
#pragma unroll
            for (int b = 0; b < 2; ++b)
#pragma unroll
                for (int m = 0; m < 4; ++m)
#pragma unroll
                    for (int n = 0; n < 2; ++n) acc[a][b][m][n] = (f32x4){0.f, 0.f, 0.f, 0.f};
        cur = nxt; cB = nB; ++ui;
        if constexpr (epi_has_pre<Epi>::value) E.pre(cur, wr, fr, prs);
#pragma unroll
        for (int h = 0; h < 2; ++h)
#pragma unroll
            for (int i = 0; i < 2; ++i) vc[h][i] = vn[h][i];
        if constexpr (ALIGN_EPI) { if (wr == 1) PG8_BAR; }
    }
    PG8_WAIT_V(0);
    if constexpr (!ALIGN_EPI) { if (wr == 0) PG8_BAR; }
    PG8_BAR;
#undef PG8_SA
#undef PG8_SB
#undef PG8_STAGE
#undef PG8_VOFFA
#undef PG8_BBASE
#undef PG8_LDA
#undef PG8_LDB
#undef PG8_MMA
#undef PG8_WAIT_V
#undef PG8_WAIT_L
#undef PG8_BAR
#undef PG8_SCHED
}
}

constexpr int NWAVES = 8;
constexpr int NPH = 20;
#ifndef MK_N_LAUNCHES
#define MK_N_LAUNCHES 1
#endif
constexpr int N_LAUNCHES = MK_N_LAUNCHES;

constexpr size_t MiB = 1u << 20;
constexpr size_t WS_CTL = 0, CTL_ZERO_BYTES = 1 * MiB;
constexpr size_t WS_MOD = 1 * MiB;
constexpr size_t WS_ROPE = 2 * MiB;
constexpr size_t WS_WRKV = 6 * MiB;
constexpr size_t WS_WL1 = 12 * MiB;
constexpr size_t WS_WL2 = 14 * MiB;
constexpr size_t WS_WOUT = 16 * MiB;
constexpr size_t WS_WFGU = 18 * MiB;
constexpr size_t WS_WFDN = 29 * MiB;
constexpr size_t WS_WKV = 35 * MiB;
constexpr size_t WS_WQ = 41 * MiB;
constexpr size_t WS_WO = 44 * MiB;
constexpr size_t WS_WMGU = 46 * MiB;
constexpr size_t WS_WMDN = 158 * MiB;
constexpr size_t WS_AR = 216 * MiB;
constexpr size_t AR(size_t mib) { return WS_AR + mib * MiB; }
constexpr size_t WS_A6 = AR(0);
constexpr size_t WS_A6Q = AR(0);
constexpr size_t WS_RSA = AR(320);
constexpr size_t WS_L1 = AR(384);
constexpr size_t WS_RB = AR(432), WS_KB = AR(496), WS_VB = AR(560);
constexpr size_t WS_AS = AR(192), WS_G = AR(256);
constexpr size_t WS_YS = AR(0);
constexpr size_t WS_YG = AR(128);
constexpr size_t WS_RF = AR(0), WS_YF = AR(64), WS_QF = AR(128), WS_PF = AR(320);
constexpr size_t WS_SF = AR(192);
constexpr size_t WS_WCF = AR(384);
constexpr size_t WS_BON = AR(386);
constexpr size_t WS_Y1 = AR(320);
constexpr size_t WS_X1 = AR(448);
constexpr size_t WS_H2 = AR(576);
constexpr size_t WS_RSH2 = AR(616);
constexpr size_t WS_ACT = AR(0);
constexpr size_t WS_Y2 = AR(176);
constexpr size_t WS_X2 = AR(304);
constexpr size_t WS_HKV = AR(0), WS_H3 = AR(64);
constexpr size_t WS_RSKV = AR(100);
constexpr size_t WS_K2 = AR(128), WS_V2 = AR(432), WS_Q2 = AR(528);
constexpr size_t WS_OG = AR(0);
constexpr size_t WS_LSE = AR(96);
constexpr size_t WS_OM = AR(224);
constexpr size_t WS_Y3 = AR(432);
constexpr size_t WS_H4 = AR(0);
constexpr size_t WS_ROUTE = AR(66);
constexpr size_t WS_ACT2 = AR(70);
constexpr size_t WS_YB = AR(532);
constexpr size_t WS_END = AR(664);
static_assert(WS_END <= 896 * MiB, "workspace");
static_assert((size_t)RMAX * DFE * 2 <= 462 * MiB && (size_t)RMAX * D * 2 <= 132 * MiB, "moe buffers");
constexpr size_t RT_TOKE = 0;
constexpr size_t RT_TOKR = 256 * 1024;
constexpr size_t RT_TOKW = 512 * 1024;
constexpr size_t RT_ROWTOK = 768 * 1024;
constexpr size_t RT_BLKEXP = 1280 * 1024;
constexpr size_t RT_RSH4 = 1536 * 1024;
constexpr int CW_BAR = 4096;
constexpr int CW_CNT = 16384;
constexpr int CW_NBLK = 16448;

constexpr int RING_BYTES = 131072;
constexpr int LDSCTL_OFF = RING_BYTES, MISC_OFF = LDSCTL_OFF + 320;
constexpr int LDS_BYTES = 147456;

#define LDS_WAIT() asm volatile("s_waitcnt lgkmcnt(0)" ::: "memory")
#define VM_WAIT() asm volatile("s_waitcnt vmcnt(0)" ::: "memory")

#define XB_TMO      128
#define XB_XCNT(j)  (256  + 64 * (j))
#define XB_XSUB(j)  (1280 + 64 * (j))
#define XB_XGEN(j)  (2304 + 64 * (j))
#define XB_TOP      3328
#define XB_TOPGEN   3392
#define XCD_BAR_WORDS 3456
#define XB_SPIN_CAP (1u << 22)

__device__ __forceinline__ unsigned xb_ld(unsigned* p)              { return __hip_atomic_load(p, __ATOMIC_RELAXED, __HIP_MEMORY_SCOPE_AGENT); }
__device__ __forceinline__ unsigned xb_add(unsigned* p, unsigned v) { return __hip_atomic_fetch_add(p, v, __ATOMIC_RELAXED, __HIP_MEMORY_SCOPE_AGENT); }
__device__ __forceinline__ unsigned xb_xcc_id() { return (unsigned)__builtin_amdgcn_s_getreg((3 << 11) | 20) & 0xFu; }
#define XB_SPIN(cond, bar) do { unsigned _sp = 0; while (cond) { __builtin_amdgcn_s_sleep(1); \
    if ((++_sp & 255u) == 0u) { if (xb_ld(&(bar)[XB_TMO])) break; if (_sp > XB_SPIN_CAP) { atomicAdd(&(bar)[XB_TMO], 1u); break; } } } } while (0)

struct XcdBarrier { unsigned* bar; unsigned x; volatile LAS unsigned* st; };
__device__ __forceinline__ XcdBarrier xcd_barrier_post(unsigned* bar, volatile LAS unsigned* st) {
    XcdBarrier b; b.bar = bar; b.x = xb_xcc_id(); b.st = st;
    if (threadIdx.x == 0) (void)xb_add(&bar[XB_XCNT(b.x)], 1u);
    return b;
}
__device__ __forceinline__ void xcd_barrier_complete(unsigned* bar, unsigned x, unsigned& nloc, unsigned& nx) {
    const unsigned G = gridDim.x * gridDim.y * gridDim.z;
    unsigned sum, cnt, mine, sp = 0u;
    for (;;) {
        sum = 0u; cnt = 0u; mine = 0u;
#pragma unroll
        for (unsigned j = 0; j < 16; ++j) { const unsigned c = xb_ld(&bar[XB_XCNT(j)]); sum += c; cnt += (c > 0u) ? 1u : 0u; mine = (j == x) ? c : mine; }
        if (sum == G) break;
        __builtin_amdgcn_s_sleep(1);
        if ((++sp & 255u) == 0u) { if (xb_ld(&bar[XB_TMO])) break; if (sp > XB_SPIN_CAP) { atomicAdd(&bar[XB_TMO], 1u); break; } }
    }
    nloc = mine > 0u ? mine : 1u; nx = cnt > 0u ? cnt : 1u;
}
__device__ __forceinline__ void xcd_barrier(const XcdBarrier& b) {
    asm volatile("s_waitcnt vmcnt(0)" ::: "memory");
    __syncthreads();
    if (threadIdx.x == 0) {
        unsigned* bar = b.bar;
        __builtin_amdgcn_s_waitcnt(0);
        unsigned nloc = b.st[0], nx = b.st[1];
        if (nloc == 0u) { xcd_barrier_complete(bar, b.x, nloc, nx); b.st[0] = nloc; b.st[1] = nx; }
        const unsigned old = xb_add(&bar[XB_XSUB(b.x)], 1u);
        const unsigned gen = old / nloc;
        if (old + 1u == (gen + 1u) * nloc) {
            __builtin_amdgcn_fence(__ATOMIC_RELEASE, "agent");
            asm volatile("s_waitcnt vmcnt(0)" ::: "memory");
            const unsigned og = xb_add(&bar[XB_TOP], 1u);
            const unsigned tg = og / nx;
            if (og + 1u == (tg + 1u) * nx) xb_add(&bar[XB_TOPGEN], 1u);
            else XB_SPIN(xb_ld(&bar[XB_TOPGEN]) == tg, bar);
            __builtin_amdgcn_fence(__ATOMIC_ACQUIRE, "agent");
            xb_add(&bar[XB_XGEN(b.x)], 1u);
            asm volatile("s_waitcnt vmcnt(0)" ::: "memory");
        } else {
            XB_SPIN(xb_ld(&bar[XB_XGEN(b.x)]) == gen, bar);
            __builtin_amdgcn_fence(__ATOMIC_ACQUIRE, "agent");
            asm volatile("s_waitcnt vmcnt(0)" ::: "memory");
        }
    }
    __syncthreads();
}

struct Frame {
    LAS unsigned char* lds;
    volatile LAS unsigned* MISC;
    gu32* ctl;
    int tid, lane, wave;
    int vcu, G;
    const float* const* in;
    float* out;
    unsigned char* ws;
};
#define WSP(type, off) ((type*)(F.ws + (off)))

__device__ __forceinline__ float wave_sum(float v) {
#pragma unroll
    for (int o = 1; o < 64; o <<= 1) v += __shfl_xor(v, o);
    return v;
}

__device__ __forceinline__ int colmap(int kind, int half, int n) {
    if (kind == 1) return (n & 1) ? half + (n >> 1) : (n >> 1);
    if (kind == 2 || (kind == 3 && n < QW)) { const int hd = n >> 6, p = n & 63; return hd * 64 + ((p & 1) * 32 + (p >> 1)); }
    return n;
}
__device__ __forceinline__ void cvt_item(const float* W, int ldw, int Kv, int Nv, bf16_t* WT, int Kout, int Nout, int kind, int half, LAS float* scr, int item, int lane) {
    const int nblk = Nout / 32, kb = item / nblk, nb = item % nblk, k0 = 64 * kb, n0 = 32 * nb;
    const int nn = n0 + (lane & 31); const int sc = colmap(kind, half, nn); const bool nok = nn < Nv;
#pragma unroll 8
    for (int i = 0; i < 32; ++i) { const int kk = 2 * i + (lane >> 5); float v = 0.f; if (nok && (k0 + kk) < Kv) v = W[(size_t)(k0 + kk) * ldw + sc]; scr[kk * 33 + (lane & 31)] = v; }
    LDS_WAIT(); asm volatile("" ::: "memory");
    const int c = lane & 7;
#pragma unroll
    for (int j = 0; j < 4; ++j) { const int n = (lane >> 3) + 8 * j; const LAS float* s = scr + (8 * c) * 33 + n;
        u32x4 o; o.x = cvt_pk_bf16(s[0 * 33], s[1 * 33]); o.y = cvt_pk_bf16(s[2 * 33], s[3 * 33]); o.z = cvt_pk_bf16(s[4 * 33], s[5 * 33]); o.w = cvt_pk_bf16(s[6 * 33], s[7 * 33]);
        *(u32x4*)(WT + (size_t)(n0 + n) * Kout + k0 + 8 * c) = o; }
    LDS_WAIT(); asm volatile("" ::: "memory");
}
__device__ __forceinline__ void cvt_item_q8(const float* W, int ldw, int Kv, int Nv, unsigned char* WT, int Kout, int Nout, float scale, LAS float* scr, int item, int lane) {
    const int nblk = Nout / 32, kb = item / nblk, nb = item % nblk, k0 = 64 * kb, n0 = 32 * nb;
    const int nn = n0 + (lane & 31); const bool nok = nn < Nv;
#pragma unroll 8
    for (int i = 0; i < 32; ++i) { const int kk = 2 * i + (lane >> 5); float v = 0.f; if (nok && (k0 + kk) < Kv) v = W[(size_t)(k0 + kk) * ldw + nn]; scr[kk * 33 + (lane & 31)] = v * scale; }
    LDS_WAIT(); asm volatile("" ::: "memory");
    const int c = lane & 3;
#pragma unroll
    for (int j = 0; j < 2; ++j) { const int n = (lane >> 2) + 16 * j; const LAS float* sp = scr + (16 * c) * 33 + n;
        u32x4 o; o.x = pk4_i8(sp[0 * 33], sp[1 * 33], sp[2 * 33], sp[3 * 33]); o.y = pk4_i8(sp[4 * 33], sp[5 * 33], sp[6 * 33], sp[7 * 33]);
        o.z = pk4_i8(sp[8 * 33], sp[9 * 33], sp[10 * 33], sp[11 * 33]); o.w = pk4_i8(sp[12 * 33], sp[13 * 33], sp[14 * 33], sp[15 * 33]);
        *(u32x4*)(WT + (size_t)(n0 + n) * Kout + k0 + 16 * c) = o; }
    LDS_WAIT(); asm volatile("" ::: "memory");
}
__device__ __forceinline__ int invmap(int kind, int half, int sc) {
    if (kind == 1) return sc < half ? 2 * sc : 2 * (sc - half) + 1;
    if (kind == 2 || (kind == 3 && sc < QW)) { const int hd = sc >> 6, d = sc & 63; return hd * 64 + (d < 32 ? 2 * d : 2 * (d - 32) + 1); }
    return sc;
}
constexpr int CV_STRIDE = 68;
__device__ __forceinline__ void cvt_item64(const float* W, int ldw, bf16_t* WT, int Kout, int nblk, int kind, int half, LAS bf16_t* scr, int item, int lane) {
    const int kb = item / nblk, nb = item % nblk, k0 = 64 * kb, n0 = 64 * nb;
    const int c4 = lane & 15, kr = lane >> 4;
    f32x4 v[8][2];
#pragma unroll
    for (int i = 0; i < 8; ++i)
#pragma unroll
        for (int e = 0; e < 2; ++e) v[i][e] = __builtin_nontemporal_load((const f32x4*)(W + (size_t)(k0 + 8 * i + 2 * kr + e) * ldw + n0 + 4 * c4));
#pragma unroll
    for (int i = 0; i < 8; ++i)
#pragma unroll
        for (int e = 0; e < 4; ++e) *(LAS unsigned*)(scr + (4 * c4 + e) * CV_STRIDE + 8 * i + 2 * kr) = cvt_pk_bf16(v[i][0][e], v[i][1][e]);
    LDS_WAIT(); asm volatile("" ::: "memory");
    const int c = lane & 7;
#pragma unroll
    for (int j = 0; j < 8; ++j) { const int n = (lane >> 3) + 8 * j; const LAS bf16_t* sp = scr + n * CV_STRIDE + 8 * c;
        const u32x2 a = *(const LAS u32x2*)sp, b = *(const LAS u32x2*)(sp + 4);
        *(u32x4*)(WT + (size_t)invmap(kind, half, n0 + n) * Kout + k0 + 8 * c) = (u32x4){a.x, a.y, b.x, b.y}; }
    LDS_WAIT(); asm volatile("" ::: "memory");
}
constexpr int CV8_STRIDE = 80;
__device__ __forceinline__ void cvt_item64_q8(const float* W, int ldw, unsigned char* WT, int Kout, int nblk, int kind, int half, float scale, LAS unsigned char* scr, int item, int lane) {
    const int kb = item / nblk, nb = item % nblk, k0 = 64 * kb, n0 = 64 * nb;
    const int c4 = lane & 15, kr = lane >> 4;
    f32x4 v[4][4];
#pragma unroll
    for (int i = 0; i < 4; ++i)
#pragma unroll
        for (int e = 0; e < 4; ++e) v[i][e] = __builtin_nontemporal_load((const f32x4*)(W + (size_t)(k0 + 16 * i + 4 * kr + e) * ldw + n0 + 4 * c4));
#pragma unroll
    for (int i = 0; i < 4; ++i)
#pragma unroll
        for (int e = 0; e < 4; ++e) *(LAS unsigned*)(scr + (4 * c4 + e) * CV8_STRIDE + 16 * i + 4 * kr) = pk4_i8(v[i][0][e] * scale, v[i][1][e] * scale, v[i][2][e] * scale, v[i][3][e] * scale);
    LDS_WAIT(); asm volatile("" ::: "memory");
    const int c = lane & 3;
#pragma unroll
    for (int j = 0; j < 4; ++j) { const int n = (lane >> 2) + 16 * j;
        *(u32x4*)(WT + (size_t)invmap(kind, half, n0 + n) * Kout + k0 + 16 * c) = *(const LAS u32x4*)(scr + n * CV8_STRIDE + 16 * c); }
    LDS_WAIT(); asm volatile("" ::: "memory");
}
__device__ __forceinline__ void p0_prologue(Frame& F) {
    {
        LAS float* part = (LAS float*)F.lds;
        const float* c = F.in[1]; const float* aw = F.in[2]; const float* ab = F.in[3]; float* MOD = WSP(float, WS_MOD);
        for (int it = F.vcu; it < ADA_W / 64; it += F.G) {
            const int j = it * 64 + F.lane; float s0 = 0.f, s1 = 0.f;
#pragma unroll 8
            for (int k = F.wave * 128; k < F.wave * 128 + 128; ++k) { const float w = aw[(size_t)k * ADA_W + j]; s0 += siluf_(c[k]) * w; s1 += siluf_(c[D + k]) * w; }
            part[(F.wave * 2 + 0) * 64 + F.lane] = s0; part[(F.wave * 2 + 1) * 64 + F.lane] = s1;
            __syncthreads();
            if (F.wave < 2) { float s = ab[j];
#pragma unroll
                for (int w = 0; w < 8; ++w) s += part[(w * 2 + F.wave) * 64 + F.lane];
                MOD[F.wave * ADA_W + j] = s; }
            __syncthreads();
        }
    }
    {
        float* cs = WSP(float, WS_ROPE); float* sn = cs + SEQ * 32;
        for (int idx = F.vcu * 512 + F.tid; idx < SEQ * 32; idx += F.G * 512) {
            const int t = idx >> 5, i = idx & 31;
            const float inv = powf(10000.0f, -(float)i / 32.0f); const float ang = (float)t * inv;
            cs[idx] = cosf(ang); sn[idx] = sinf(ang);
        }
    }
    LAS float* scr = (LAS float*)(F.lds + F.wave * 16384);
    LAS bf16_t* scrh = (LAS bf16_t*)(F.lds + F.wave * 16384);
    const int gw = F.vcu * NWAVES + F.wave, NGW = F.G * NWAVES;
    {
        constexpr int J_MGU = 16 * 112, J_MDN = 56 * 16, J_RKV = 16 * 48, J_OUT = 16 * 16, J_FGU = 16 * 88, J_FDN = 44 * 16, J_KV = 16 * 48, J_Q = 16 * 24, J_O = 8 * 16;
        constexpr int NJ = 8 * J_MGU + 8 * J_MDN + J_RKV + J_OUT + J_FGU + J_FDN + J_KV + J_Q + J_O;
        for (int it = gw; it < NJ; it += NGW) {
            int r = it;
            if (r < 8 * J_MGU) { const int e = r / J_MGU; cvt_item64_q8(F.in[28] + (size_t)e * D * 2 * DFE, 2 * DFE, WSP(unsigned char, WS_WMGU) + (size_t)e * 2 * DFE * D, D, 112, 1, DFE, QW_INV, (LAS unsigned char*)scrh, r % J_MGU, F.lane); continue; } r -= 8 * J_MGU;
            if (r < 8 * J_MDN) { const int e = r / J_MDN; cvt_item64(F.in[29] + (size_t)e * DFE * D, D, WSP(bf16_t, WS_WMDN) + (size_t)e * D * DFE, DFE, 16, 0, 0, scrh, r % J_MDN, F.lane); continue; } r -= 8 * J_MDN;
            if (r < J_RKV) { cvt_item64_q8(F.in[7], 3 * D, WSP(unsigned char, WS_WRKV), D, 48, 0, 0, QW_INV, (LAS unsigned char*)scrh, r, F.lane); continue; } r -= J_RKV;
            if (r < J_OUT) { cvt_item64(F.in[21], D, WSP(bf16_t, WS_WOUT), D, 16, 0, 0, scrh, r, F.lane); continue; } r -= J_OUT;
            if (r < J_FGU) { cvt_item64_q8(F.in[25], 2 * DFF, WSP(unsigned char, WS_WFGU), D, 88, 1, DFF, QW_INV, (LAS unsigned char*)scrh, r, F.lane); continue; } r -= J_FGU;
            if (r < J_FDN) { cvt_item64(F.in[26], D, WSP(bf16_t, WS_WFDN), DFF, 16, 0, 0, scrh, r, F.lane); continue; } r -= J_FDN;
            if (r < J_KV) { cvt_item64_q8(F.in[22], 2 * QW, WSP(unsigned char, WS_WKV), D, 48, 3, 0, QW_INV, (LAS unsigned char*)scrh, r, F.lane); continue; } r -= J_KV;
            if (r < J_Q) { cvt_item64_q8(F.in[23], QW, WSP(unsigned char, WS_WQ), D, 24, 2, 0, QW_INV, (LAS unsigned char*)scrh, r, F.lane); continue; } r -= J_Q;
            cvt_item64(F.in[24], D, WSP(bf16_t, WS_WO), AOUT, 16, 0, 0, scrh, r, F.lane);
        }
    }
    {
        constexpr int I_L1 = 16 * 8, I_L2 = 4 * 32;
        for (int it = gw; it < 3 * I_L1 + 3 * I_L2; it += NGW) {
            int r = it;
            if (r < I_L1) { cvt_item_q8(F.in[9], 64, D, 64, WSP(unsigned char, WS_WL1), D, 256, QW_INV, scr, r, F.lane); continue; } r -= I_L1;
            if (r < I_L1) { cvt_item_q8(F.in[12], 64, D, 64, WSP(unsigned char, WS_WL1) + 256 * D, D, 256, QW_INV, scr, r, F.lane); continue; } r -= I_L1;
            if (r < I_L1) { cvt_item_q8(F.in[14], 160, D, 160, WSP(unsigned char, WS_WL1) + 2 * 256 * D, D, 256, QW_INV, scr, r, F.lane); continue; } r -= I_L1;
            if (r < I_L2) { cvt_item(F.in[10], D, 64, D, WSP(bf16_t, WS_WL2), 256, D, 0, 0, scr, r, F.lane); continue; } r -= I_L2;
            if (r < I_L2) { cvt_item(F.in[13], D, 64, D, WSP(bf16_t, WS_WL2) + D * 256, 256, D, 0, 0, scr, r, F.lane); continue; } r -= I_L2;
            cvt_item(F.in[15], D, 160, D, WSP(bf16_t, WS_WL2) + 2 * D * 256, 256, D, 0, 0, scr, r, F.lane);
        }
    }
}

__device__ __forceinline__ void p1_lerp(Frame& F) {
    const int gw = F.vcu * NWAVES + F.wave, NGW = F.G * NWAVES;
    const float* x = F.in[0]; const float* mu = F.in[6]; const float* MOD = WSP(float, WS_MOD);
    unsigned char* A6Q = WSP(unsigned char, WS_A6Q); float* RSA = WSP(float, WS_RSA);
    const int rpw = (T + NGW - 1) / NGW;
    const int m_lo = gw * rpw, m_hi = (m_lo + rpw < T) ? m_lo + rpw : T;
    f32x4 hp[4];
    for (int m = m_lo; m < m_hi; ++m) {
        const int b = m >> 14, t = m & (SEQ - 1);
        f32x4 hc[4], xx[4];
#pragma unroll
        for (int j = 0; j < 4; ++j) {
            const int c = 4 * F.lane + 256 * j;
            const f32x4 sh = *(const f32x4*)(MOD + b * ADA_W + 0 * D + c), sc = *(const f32x4*)(MOD + b * ADA_W + 1 * D + c);
            hc[j] = *(const f32x4*)(x + (size_t)m * D + c) * (1.f + sc) + sh;
            if (t == 0) hp[j] = (f32x4){0.f, 0.f, 0.f, 0.f};
            else if (m == m_lo) hp[j] = *(const f32x4*)(x + (size_t)(m - 1) * D + c) * (1.f + sc) + sh;
            xx[j] = hp[j] - hc[j];
        }
#pragma unroll
        for (int p = 0; p < 6; ++p) {
            f32x4 q[4]; float v = 0.f;
#pragma unroll
            for (int j = 0; j < 4; ++j) { const f32x4 o = hc[j] + xx[j] * *(const f32x4*)(mu + p * D + 4 * F.lane + 256 * j); q[j] = o;
                v = fmaxf(v, fmaxf(fmaxf(fabsf(o[0]), fabsf(o[1])), fmaxf(fabsf(o[2]), fabsf(o[3])))); }
#pragma unroll
            for (int of = 1; of < 64; of <<= 1) v = fmaxf(v, __shfl_xor(v, of));
            v = fmaxf(v, 1e-20f); const float inv = 127.f / v;
            if (F.lane == 0) RSA[p * T + m] = v * (1.f / 127.f);
#pragma unroll
            for (int j = 0; j < 4; ++j) *(unsigned*)(A6Q + (size_t)p * T * D + (size_t)m * D + 4 * F.lane + 256 * j) = pk4_i8(q[j][0] * inv, q[j][1] * inv, q[j][2] * inv, q[j][3] * inv);
        }
#pragma unroll
        for (int j = 0; j < 4; ++j) hp[j] = hc[j];
    }
}

template <int CTRL> __device__ __forceinline__ float dpp_mov(float v) { return __int_as_float(__builtin_amdgcn_update_dpp(0, __float_as_int(v), CTRL, 0xF, 0xF, false)); }
__device__ __forceinline__ float sum16(float v) { v += dpp_mov<0xB1>(v); v += dpp_mov<0x4E>(v); v += dpp_mov<0x141>(v); v += dpp_mov<0x140>(v); return v; }
__device__ __forceinline__ float rdl(float v, int l) { return __int_as_float(__builtin_amdgcn_readlane(__float_as_int(v), l)); }
__device__ __forceinline__ float wsum(float v) { v = sum16(v); return (rdl(v, 0) + rdl(v, 16)) + (rdl(v, 32) + rdl(v, 48)); }
__device__ __forceinline__ unsigned short bf1(float x) { return (unsigned short)(cvt_pk_bf16(x, x) & 0xffffu); }
constexpr int CH = 64, NCH = SEQ / CH, NUNIT = BATCH * 16 * NCH;
constexpr int CS = 72;
constexpr int L_AT = 0, L_RT = 9216, L_BT = 18432, L_KT = 27648, L_ATT = 36864, L_BTT = 46080, L_KTT = 55296, L_VT = 64512, L_AAB = 73728, L_AAK = 82944, L_ARB = 92160, L_ARK = 101376;
constexpr int L_XT = L_BT;
constexpr int L_TI = 110592, L_WC = 112640, L_TOT = 112896;
#define FRAG(base, row, ks) (*(const LAS bf16x8*)((base) + (row) * CS + 32 * (ks) + 8 * qd))
#define MF(a, b, c) __builtin_amdgcn_mfma_f32_16x16x32_bf16((a), (b), (c), 0, 0, 0)
__device__ __forceinline__ bf16x8 pack8(const f32x4 a, const f32x4 b) { union { bf16x8 v; unsigned u[4]; } t; t.u[0] = cvt_pk_bf16(a[0], a[1]); t.u[1] = cvt_pk_bf16(a[2], a[3]); t.u[2] = cvt_pk_bf16(b[0], b[1]); t.u[3] = cvt_pk_bf16(b[2], b[3]); return t.v; }
__device__ __forceinline__ f32x4 unpk4(const u32x2 w) { return (f32x4){bflo(w.x), bfhi(w.x), bflo(w.y), bfhi(w.y)}; }

#define LDS_BAR() do { asm volatile("s_waitcnt lgkmcnt(0)" ::: "memory"); __builtin_amdgcn_s_barrier(); asm volatile("" ::: "memory"); } while (0)
struct ChIn { unsigned short r[8], k[8], v[8], a[8]; float wl[8]; };
__device__ __forceinline__ void ch_load(ChIn& I, const bf16_t* RB, const bf16_t* KB, const bf16_t* VB, const bf16_t* AS, const float* WLOG, size_t m0, int col) {
#pragma unroll
    for (int i = 0; i < 8; ++i) { const size_t o = (m0 + i) * D + col; I.r[i] = RB[o]; I.k[i] = KB[o]; I.v[i] = VB[o]; I.a[i] = AS[o]; I.wl[i] = WLOG[o]; }
}
__device__ __forceinline__ void p4a_chunk(Frame& F) {
    LAS unsigned char* L = F.lds;
    LAS bf16_t* At = (LAS bf16_t*)(L + L_AT); LAS bf16_t* Rt = (LAS bf16_t*)(L + L_RT); LAS bf16_t* Bt = (LAS bf16_t*)(L + L_BT); LAS bf16_t* Kt = (LAS bf16_t*)(L + L_KT);
    LAS bf16_t* AtT = (LAS bf16_t*)(L + L_ATT); LAS bf16_t* BtT = (LAS bf16_t*)(L + L_BTT); LAS bf16_t* KtT = (LAS bf16_t*)(L + L_KTT); LAS bf16_t* VT = (LAS bf16_t*)(L + L_VT);
    LAS bf16_t* AAB = (LAS bf16_t*)(L + L_AAB); LAS bf16_t* AAK = (LAS bf16_t*)(L + L_AAK); LAS bf16_t* ARB = (LAS bf16_t*)(L + L_ARB); LAS bf16_t* ARK = (LAS bf16_t*)(L + L_ARK);
    LAS bf16_t* XT = (LAS bf16_t*)(L + L_XT); LAS bf16_t* TI = (LAS bf16_t*)(L + L_TI); LAS float* WC = (LAS float*)(L + L_WC); LAS float* TOT = (LAS float*)(L + L_TOT);
    const bf16_t* RB = WSP(bf16_t, WS_RB); const bf16_t* KB = WSP(bf16_t, WS_KB); const bf16_t* VB = WSP(bf16_t, WS_VB); const bf16_t* AS = WSP(bf16_t, WS_AS); const float* WLOG = F.out;
    u32x4* PF = WSP(u32x4, WS_PF); u32x4* QF = WSP(u32x4, WS_QF); u32x4* RF = WSP(u32x4, WS_RF); u32x4* YF = WSP(u32x4, WS_YF); float* WCF = WSP(float, WS_WCF); float* BON = WSP(float, WS_BON);
    const int lane = F.lane, w = F.wave, q16 = lane & 15, qd = lane >> 4;
    ChIn I;
    int unit = F.vcu;
    if (unit < NUNIT) { const int bh = unit >> 8, ch = unit & 255; ch_load(I, RB, KB, VB, AS, WLOG, (size_t)(bh >> 4) * SEQ + ch * CH + 8 * w, (bh & 15) * 64 + lane); }
    for (; unit < NUNIT; unit += F.G) {
        const int bh = unit >> 8, ch = unit & 255, b = bh >> 4, h = bh & 15;
        const size_t m0 = (size_t)b * SEQ + (size_t)ch * CH;
        const int col = h * 64 + lane;
        float r_[8], kp_[8], kn_[8], a_[8], cwl[8];
        {
            const float kkc = F.in[16][col], kac = F.in[17][col], rkc = F.in[18][col];
            float run = 0.f;
#pragma unroll
            for (int i = 0; i < 8; ++i) {
                const float r = __uint_as_float((unsigned)I.r[i] << 16), k = __uint_as_float((unsigned)I.k[i] << 16), a = __uint_as_float((unsigned)I.a[i] << 16);
                run += I.wl[i]; cwl[i] = run;
                const float kkv = k * kkc; const float ss = wsum(kkv * kkv); const float inv = 1.f / fmaxf(sqrtf(ss), 1e-12f);
                const float kp = k * (1.f + (a - 1.f) * kac); const float bn = wsum(r * kp * rkc);
                if (lane == 0) BON[(m0 + 8 * w + i) * 16 + h] = bn;
                r_[i] = r; kp_[i] = kp; kn_[i] = kkv * inv; a_[i] = a;
            }
            TOT[w * 64 + lane] = run;
        }
        LDS_BAR();
        {
            float off = 0.f, tot = 0.f;
#pragma unroll
            for (int ww = 0; ww < 8; ++ww) { const float tv = TOT[ww * 64 + lane]; tot += tv; off += (ww < w) ? tv : 0.f; }
            if (w == 0) { WC[lane] = __expf(tot); WCF[(size_t)unit * 64 + lane] = __expf(tot); }
            float at[8], bt[8], kt[8];
#pragma unroll
            for (int i = 0; i < 8; ++i) {
                const float cw = off + cwl[i]; const float ein = __expf(cw), eex = __expf(cw - I.wl[i]), einv = __expf(-cw);
                at[i] = -kn_[i] * eex; bt[i] = kn_[i] * a_[i] * einv; kt[i] = kp_[i] * einv; const float rt = r_[i] * ein;
                const int t = 8 * w + i;
                At[t * CS + lane] = bf1(at[i]); Rt[t * CS + lane] = bf1(rt); Bt[t * CS + lane] = bf1(bt[i]); Kt[t * CS + lane] = bf1(kt[i]);
            }
            u32x4 pa, pb, pk, pv;
            pa.x = cvt_pk_bf16(at[0], at[1]); pa.y = cvt_pk_bf16(at[2], at[3]); pa.z = cvt_pk_bf16(at[4], at[5]); pa.w = cvt_pk_bf16(at[6], at[7]);
            pb.x = cvt_pk_bf16(bt[0], bt[1]); pb.y = cvt_pk_bf16(bt[2], bt[3]); pb.z = cvt_pk_bf16(bt[4], bt[5]); pb.w = cvt_pk_bf16(bt[6], bt[7]);
            pk.x = cvt_pk_bf16(kt[0], kt[1]); pk.y = cvt_pk_bf16(kt[2], kt[3]); pk.z = cvt_pk_bf16(kt[4], kt[5]); pk.w = cvt_pk_bf16(kt[6], kt[7]);
            pv.x = (unsigned)I.v[0] | ((unsigned)I.v[1] << 16); pv.y = (unsigned)I.v[2] | ((unsigned)I.v[3] << 16); pv.z = (unsigned)I.v[4] | ((unsigned)I.v[5] << 16); pv.w = (unsigned)I.v[6] | ((unsigned)I.v[7] << 16);
            *(LAS u32x4*)(AtT + lane * CS + 8 * w) = pa; *(LAS u32x4*)(BtT + lane * CS + 8 * w) = pb; *(LAS u32x4*)(KtT + lane * CS + 8 * w) = pk; *(LAS u32x4*)(VT + lane * CS + 8 * w) = pv;
        }
        { const int nu = unit + F.G; if (nu < NUNIT) { const int nbh = nu >> 8, nch = nu & 255; ch_load(I, RB, KB, VB, AS, WLOG, (size_t)(nbh >> 4) * SEQ + nch * CH + 8 * w, (nbh & 15) * 64 + lane); } }
        LDS_BAR();
        {
            const int tt = w >> 1, half = w & 1;
            const LAS bf16_t* src = half ? Rt : At; LAS bf16_t* d0 = half ? ARB : AAB; LAS bf16_t* d1 = half ? ARK : AAK;
            const bf16x8 s0 = FRAG(src, 16 * tt + q16, 0), s1 = FRAG(src, 16 * tt + q16, 1);
#pragma unroll
            for (int jt = 0; jt < 4; ++jt) {
                f32x4 e0 = (f32x4){0.f, 0.f, 0.f, 0.f}, e1 = e0;
                if (jt <= tt) {
                    e0 = MF(FRAG(Bt, 16 * jt + q16, 0), s0, e0); e0 = MF(FRAG(Bt, 16 * jt + q16, 1), s1, e0);
                    e1 = MF(FRAG(Kt, 16 * jt + q16, 0), s0, e1); e1 = MF(FRAG(Kt, 16 * jt + q16, 1), s1, e1);
#pragma unroll
                    for (int r = 0; r < 4; ++r) { const int j = 16 * jt + 4 * qd + r, t = 16 * tt + q16; const bool ok = half ? (j <= t) : (j < t); e0[r] = ok ? e0[r] : 0.f; e1[r] = ok ? e1[r] : 0.f; }
                }
                u32x2 o0, o1; o0.x = cvt_pk_bf16(e0[0], e0[1]); o0.y = cvt_pk_bf16(e0[2], e0[3]); o1.x = cvt_pk_bf16(e1[0], e1[1]); o1.y = cvt_pk_bf16(e1[2], e1[3]);
                *(LAS u32x2*)(d0 + (16 * tt + q16) * CS + 16 * jt + 4 * qd) = o0; *(LAS u32x2*)(d1 + (16 * tt + q16) * CS + 16 * jt + 4 * qd) = o1;
            }
        }
        LDS_BAR();
        f32x4 Z[4];
        if (w < 4) {
            float Tc[16];
#pragma unroll
            for (int r = 0; r < 16; ++r) Tc[r] = (r == q16) ? 1.f : 0.f;
#pragma unroll
            for (int r = 1; r < 16; ++r) {
                const LAS bf16_t* np_ = AAB + (16 * w + r) * CS + 16 * w;
                const u32x4 n0 = *(const LAS u32x4*)np_, n1 = *(const LAS u32x4*)(np_ + 8);
                const float nv[16] = {bflo(n0.x), bfhi(n0.x), bflo(n0.y), bfhi(n0.y), bflo(n0.z), bfhi(n0.z), bflo(n0.w), bfhi(n0.w), bflo(n1.x), bfhi(n1.x), bflo(n1.y), bfhi(n1.y), bflo(n1.z), bfhi(n1.z), bflo(n1.w), bfhi(n1.w)};
                float acc = Tc[r];
#pragma unroll
                for (int s = 0; s < r; ++s) acc += nv[s] * Tc[s];
                Tc[r] = acc;
            }
            if (qd == 0) {
#pragma unroll
                for (int r = 0; r < 16; ++r) TI[(w * 16 + r) * 16 + q16] = bf1(Tc[r]);
            }
#pragma unroll
            for (int i = 0; i < 4; ++i) Z[i] = unpk4(*(const LAS u32x2*)(AtT + (16 * w + q16) * CS + 16 * i + 4 * qd));
        } else {
            const int vt = w - 4;
            const bf16x8 v0 = FRAG(VT, 16 * vt + q16, 0), v1 = FRAG(VT, 16 * vt + q16, 1);
#pragma unroll
            for (int i = 0; i < 4; ++i) {
                f32x4 g = (f32x4){0.f, 0.f, 0.f, 0.f};
                g = MF(FRAG(AAK, 16 * i + q16, 0), v0, g);
                if (i >= 2) g = MF(FRAG(AAK, 16 * i + q16, 1), v1, g);
                Z[i] = g;
            }
        }
        LDS_BAR();
        {
            const f32x4 zz = (f32x4){0.f, 0.f, 0.f, 0.f};
            f32x4 X[4];
#pragma unroll
            for (int i = 0; i < 4; ++i) {
                if (i >= 1) {
                    union { bf16x8 v; u32x2 h[2]; } af;
                    af.h[0] = *(const LAS u32x2*)(AAB + (16 * i + q16) * CS + 0 + 4 * qd);
                    af.h[1] = (i >= 2) ? *(const LAS u32x2*)(AAB + (16 * i + q16) * CS + 16 + 4 * qd) : (u32x2){0u, 0u};
                    Z[i] = MF(af.v, pack8(X[0], (i >= 2) ? X[1] : zz), Z[i]);
                    if (i == 3) { af.h[0] = *(const LAS u32x2*)(AAB + (16 * i + q16) * CS + 32 + 4 * qd); af.h[1] = (u32x2){0u, 0u}; Z[i] = MF(af.v, pack8(X[2], zz), Z[i]); }
                }
                union { bf16x8 v; u32x2 h[2]; } tf; tf.h[0] = *(const LAS u32x2*)(TI + (i * 16 + q16) * 16 + 4 * qd); tf.h[1] = (u32x2){0u, 0u};
                X[i] = MF(tf.v, pack8(Z[i], zz), zz);
                u32x2 o; o.x = cvt_pk_bf16(X[i][0], X[i][1]); o.y = cvt_pk_bf16(X[i][2], X[i][3]);
                *(LAS u32x2*)(XT + (16 * w + q16) * CS + 16 * i + 4 * qd) = o;
            }
        }
        LDS_BAR();
        {
            const int hi = w >> 1, lo = w & 1;
            const size_t fo = ((size_t)unit * 8 + w) * 64 + lane;
            {
                const bf16x8 b0 = FRAG(BtT, 16 * hi + q16, 0), b1 = FRAG(BtT, 16 * hi + q16, 1);
                f32x4 d[2];
#pragma unroll
                for (int e = 0; e < 2; ++e) { const int kt = 2 * lo + e; f32x4 a = (f32x4){0.f, 0.f, 0.f, 0.f}; a = MF(FRAG(XT, 16 * kt + q16, 0), b0, a); a = MF(FRAG(XT, 16 * kt + q16, 1), b1, a); d[e] = a * WC[16 * hi + q16]; }
                const bf16x8 o = pack8(d[0], d[1]); PF[fo] = *(const u32x4*)&o;
            }
            {
                const bf16x8 u0 = FRAG(XT, 64 + 16 * hi + q16, 0), u1 = FRAG(XT, 64 + 16 * hi + q16, 1), v0 = FRAG(VT, 16 * hi + q16, 0), v1 = FRAG(VT, 16 * hi + q16, 1);
                f32x4 d[2];
#pragma unroll
                for (int e = 0; e < 2; ++e) { const int kt = 2 * lo + e; f32x4 a = (f32x4){0.f, 0.f, 0.f, 0.f};
                    a = MF(FRAG(BtT, 16 * kt + q16, 0), u0, a); a = MF(FRAG(BtT, 16 * kt + q16, 1), u1, a); a = MF(FRAG(KtT, 16 * kt + q16, 0), v0, a); a = MF(FRAG(KtT, 16 * kt + q16, 1), v1, a);
                    d[e] = a * *(const LAS f32x4*)(WC + 16 * kt + 4 * qd); }
                const bf16x8 o = pack8(d[0], d[1]); QF[fo] = *(const u32x4*)&o;
            }
            {
                const bf16x8 b0 = FRAG(ARB, 16 * hi + q16, 0), b1 = FRAG(ARB, 16 * hi + q16, 1);
                f32x4 d[2];
#pragma unroll
                for (int e = 0; e < 2; ++e) { const int ct = 2 * lo + e; f32x4 a = unpk4(*(const LAS u32x2*)(Rt + (16 * hi + q16) * CS + 16 * ct + 4 * qd));
                    a = MF(FRAG(XT, 16 * ct + q16, 0), b0, a); if (hi >= 2) a = MF(FRAG(XT, 16 * ct + q16, 1), b1, a); d[e] = a; }
                const bf16x8 o = pack8(d[0], d[1]); RF[fo] = *(const u32x4*)&o;
            }
            {
                const bf16x8 b0 = FRAG(ARB, 16 * hi + q16, 0), b1 = FRAG(ARB, 16 * hi + q16, 1), k0 = FRAG(ARK, 16 * hi + q16, 0), k1 = FRAG(ARK, 16 * hi + q16, 1);
                f32x4 d[2];
#pragma unroll
                for (int e = 0; e < 2; ++e) { const int vt = 2 * lo + e; f32x4 a = (f32x4){0.f, 0.f, 0.f, 0.f};
                    a = MF(FRAG(XT, 64 + 16 * vt + q16, 0), b0, a); a = MF(FRAG(VT, 16 * vt + q16, 0), k0, a);
                    if (hi >= 2) { a = MF(FRAG(XT, 64 + 16 * vt + q16, 1), b1, a); a = MF(FRAG(VT, 16 * vt + q16, 1), k1, a); }
                    d[e] = a; }
                const bf16x8 o = pack8(d[0], d[1]); YF[fo] = *(const u32x4*)&o;
            }
        }
    }
}
__device__ __forceinline__ void p4b_chain(Frame& F) {
    if (F.wave != 0) return;
    const u32x4* PF = WSP(u32x4, WS_PF); const u32x4* QF = WSP(u32x4, WS_QF); const float* WCF = WSP(float, WS_WCF); u32x4* SF = WSP(u32x4, WS_SF);
    const int lane = F.lane, qd = lane >> 4;
    for (int job = F.vcu; job < BATCH * 16 * 4; job += F.G) {
        const int bh = job >> 2, vt = job & 3;
        f32x4 S[4];
#pragma unroll
        for (int kt = 0; kt < 4; ++kt) S[kt] = (f32x4){0.f, 0.f, 0.f, 0.f};
        u32x4 pf[2][8], qf[2][2]; f32x4 wc[2][4];
#define CHAIN_LOAD(buf, u) do { _Pragma("unroll") for (int x = 0; x < 8; ++x) pf[buf][x] = PF[((size_t)(u) * 8 + x) * 64 + lane]; \
        _Pragma("unroll") for (int x = 0; x < 2; ++x) qf[buf][x] = QF[((size_t)(u) * 8 + vt * 2 + x) * 64 + lane]; \
        _Pragma("unroll") for (int kt = 0; kt < 4; ++kt) wc[buf][kt] = *(const f32x4*)(WCF + (size_t)(u) * 64 + 16 * kt + 4 * qd); } while (0)
#define CHAIN_STEP(buf, u) do { \
        const bf16x8 s0 = pack8(S[0], S[1]), s1 = pack8(S[2], S[3]); \
        SF[((size_t)(u) * 8 + vt * 2 + 0) * 64 + lane] = *(const u32x4*)&s0; SF[((size_t)(u) * 8 + vt * 2 + 1) * 64 + lane] = *(const u32x4*)&s1; \
        f32x4 n[4]; \
        n[0] = unpk4((u32x2){qf[buf][0].x, qf[buf][0].y}) + wc[buf][0] * S[0]; n[1] = unpk4((u32x2){qf[buf][0].z, qf[buf][0].w}) + wc[buf][1] * S[1]; \
        n[2] = unpk4((u32x2){qf[buf][1].x, qf[buf][1].y}) + wc[buf][2] * S[2]; n[3] = unpk4((u32x2){qf[buf][1].z, qf[buf][1].w}) + wc[buf][3] * S[3]; \
        _Pragma("unroll") for (int kt = 0; kt < 4; ++kt) { n[kt] = MF(*(const bf16x8*)&pf[buf][kt * 2 + 0], s0, n[kt]); n[kt] = MF(*(const bf16x8*)&pf[buf][kt * 2 + 1], s1, n[kt]); } \
        _Pragma("unroll") for (int kt = 0; kt < 4; ++kt) S[kt] = n[kt]; } while (0)
        const size_t u0 = (size_t)bh * NCH;
        CHAIN_LOAD(0, u0);
        for (int c = 0; c < NCH; c += 2) {
            CHAIN_LOAD(1, u0 + c + 1);
            CHAIN_STEP(0, u0 + c);
            if (c + 2 < NCH) CHAIN_LOAD(0, u0 + c + 2);
            CHAIN_STEP(1, u0 + c + 1);
        }
#undef CHAIN_LOAD
#undef CHAIN_STEP
    }
}
__device__ __forceinline__ void p5_chunk_out(Frame& F) {
    const u32x4* SF = WSP(u32x4, WS_SF); const u32x4* RF = WSP(u32x4, WS_RF); const u32x4* YF = WSP(u32x4, WS_YF); const float* BON = WSP(float, WS_BON);
    const bf16_t* VB = WSP(bf16_t, WS_VB); const bf16_t* GG = WSP(bf16_t, WS_G); bf16_t* YG = WSP(bf16_t, WS_YG);
    const int lane = F.lane, q16 = lane & 15, qd = lane >> 4;
    const int gw = F.vcu * NWAVES + F.wave, NGW = F.G * NWAVES;
    struct CJob { u32x4 r0, r1, y0, y1, sf[4][2]; u32x2 vw[4], gw_[4]; float bn; };
#define CJ_LOAD(J, job_) do { const int unit_ = (job_) >> 2, tt_ = (job_) & 3, bh_ = unit_ >> 8, ch_ = unit_ & 255; \
        const size_t m_ = (size_t)(bh_ >> 4) * SEQ + (size_t)ch_ * CH + 16 * tt_ + q16; \
        J.r0 = RF[((size_t)unit_ * 8 + tt_ * 2 + 0) * 64 + lane]; J.r1 = RF[((size_t)unit_ * 8 + tt_ * 2 + 1) * 64 + lane]; \
        J.y0 = YF[((size_t)unit_ * 8 + tt_ * 2 + 0) * 64 + lane]; J.y1 = YF[((size_t)unit_ * 8 + tt_ * 2 + 1) * 64 + lane]; \
        _Pragma("unroll") for (int vt = 0; vt < 4; ++vt) { J.sf[vt][0] = SF[((size_t)unit_ * 8 + vt * 2 + 0) * 64 + lane]; J.sf[vt][1] = SF[((size_t)unit_ * 8 + vt * 2 + 1) * 64 + lane]; \
            const size_t off_ = m_ * D + (bh_ & 15) * 64 + 16 * vt + 4 * qd; J.vw[vt] = *(const u32x2*)(VB + off_); J.gw_[vt] = *(const u32x2*)(GG + off_); } \
        J.bn = BON[m_ * 16 + (bh_ & 15)]; } while (0)
    CJob N;
    if (gw < NUNIT * 4) CJ_LOAD(N, gw);
    for (int job = gw; job < NUNIT * 4; job += NGW) {
        const int unit = job >> 2, tt = job & 3, bh = unit >> 8, ch = unit & 255, b = bh >> 4, h = bh & 15;
        const size_t m = (size_t)b * SEQ + (size_t)ch * CH + 16 * tt + q16;
        const CJob J = N;
        if (job + NGW < NUNIT * 4) CJ_LOAD(N, job + NGW);
        const float bn = J.bn;
        f32x4 y[4];
        y[0] = unpk4((u32x2){J.y0.x, J.y0.y}); y[1] = unpk4((u32x2){J.y0.z, J.y0.w}); y[2] = unpk4((u32x2){J.y1.x, J.y1.y}); y[3] = unpk4((u32x2){J.y1.z, J.y1.w});
#pragma unroll
        for (int vt = 0; vt < 4; ++vt) { y[vt] = MF(*(const bf16x8*)&J.sf[vt][0], *(const bf16x8*)&J.r0, y[vt]); y[vt] = MF(*(const bf16x8*)&J.sf[vt][1], *(const bf16x8*)&J.r1, y[vt]); }
        float s = 0.f;
#pragma unroll
        for (int vt = 0; vt < 4; ++vt) s += (y[vt][0] + y[vt][1]) + (y[vt][2] + y[vt][3]);
        s += __shfl_xor(s, 16); s += __shfl_xor(s, 32);
        const float mean = s * (1.f / 64.f); float qv = 0.f;
#pragma unroll
        for (int vt = 0; vt < 4; ++vt) { y[vt] = y[vt] - mean; qv += (y[vt][0] * y[vt][0] + y[vt][1] * y[vt][1]) + (y[vt][2] * y[vt][2] + y[vt][3] * y[vt][3]); }
        qv += __shfl_xor(qv, 16); qv += __shfl_xor(qv, 32);
        const float rstd = 1.f / sqrtf(qv * (1.f / 64.f) + LNX_EPS);
#pragma unroll
        for (int vt = 0; vt < 4; ++vt) {
            const int c = h * 64 + 16 * vt + 4 * qd; const size_t off = m * D + c;
            const f32x4 vv = unpk4(J.vw[vt]), gg = unpk4(J.gw_[vt]);
            const f32x4 o = ((y[vt] * rstd) * *(const f32x4*)(F.in[19] + c) + *(const f32x4*)(F.in[20] + c) + bn * vv) * gg;
            u32x2 wv; wv.x = cvt_pk_bf16(o[0], o[1]); wv.y = cvt_pk_bf16(o[2], o[3]);
            *(u32x2*)(YG + off) = wv;
        }
    }
#undef CJ_LOAD
}
#undef FRAG
#undef MF

__device__ __forceinline__ void ln_apply(f32x4 (&v)[4], const float* g, const float* b, int lane) {
    float s = 0.f;
#pragma unroll
    for (int j = 0; j < 4; ++j) s += (v[j][0] + v[j][1]) + (v[j][2] + v[j][3]);
    const float mean = wave_sum(s) * (1.f / D); float s2 = 0.f;
#pragma unroll
    for (int j = 0; j < 4; ++j) { v[j] = v[j] - mean; s2 += (v[j][0] * v[j][0] + v[j][1] * v[j][1]) + (v[j][2] * v[j][2] + v[j][3] * v[j][3]); }
    const float rstd = 1.f / sqrtf(wave_sum(s2) * (1.f / D) + LN_EPS);
#pragma unroll
    for (int j = 0; j < 4; ++j) { const int c = 4 * lane + 256 * j; v[j] = v[j] * rstd * *(const f32x4*)(g + c) + *(const f32x4*)(b + c); }
}
__device__ __forceinline__ void mod_store(const f32x4 (&v)[4], const float* shift, const float* scale, bf16_t* orow, int lane) {
#pragma unroll
    for (int j = 0; j < 4; ++j) { const int c = 4 * lane + 256 * j; const f32x4 o = v[j] * (1.f + *(const f32x4*)(scale + c)) + *(const f32x4*)(shift + c);
        u32x2 w; w.x = cvt_pk_bf16(o[0], o[1]); w.y = cvt_pk_bf16(o[2], o[3]); *(u32x2*)(orow + c) = w; }
}
__device__ __forceinline__ void mod_store_q8(const f32x4 (&v)[4], const float* shift, const float* scale, unsigned char* orow, float* rs, int lane) {
    f32x4 o[4]; float mx = 0.f;
#pragma unroll
    for (int j = 0; j < 4; ++j) { const int c = 4 * lane + 256 * j; o[j] = v[j] * (1.f + *(const f32x4*)(scale + c)) + *(const f32x4*)(shift + c);
        mx = fmaxf(mx, fmaxf(fmaxf(fabsf(o[j][0]), fabsf(o[j][1])), fmaxf(fabsf(o[j][2]), fabsf(o[j][3])))); }
#pragma unroll
    for (int of = 1; of < 64; of <<= 1) mx = fmaxf(mx, __shfl_xor(mx, of));
    mx = fmaxf(mx, 1e-20f); const float inv = 127.f / mx;
    if (lane == 0) *rs = mx * (1.f / 127.f);
#pragma unroll
    for (int j = 0; j < 4; ++j) *(unsigned*)(orow + 4 * lane + 256 * j) = pk4_i8(o[j][0] * inv, o[j][1] * inv, o[j][2] * inv, o[j][3] * inv);
}
__device__ __forceinline__ void p_postnorm(Frame& F, const float* xres, const bf16_t* xres16, const bf16_t* y, bf16_t* xout, int sub, int modA, bf16_t* outA, int modB, bf16_t* outB, int modQ = 0, unsigned char* outQ = nullptr, float* rsQ = nullptr, int modQ2 = 0, unsigned char* outQ2 = nullptr, float* rsQ2 = nullptr) {
    const int gw = F.vcu * NWAVES + F.wave, NGW = F.G * NWAVES;
    const float* MOD = WSP(float, WS_MOD); const float* g = F.in[4] + sub * D; const float* bb = F.in[5] + sub * D;
#define PN_LOADX(row, j, c) (xres ? *(const f32x4*)(xres + (size_t)(row) * D + (c)) : unpk4(*(const u32x2*)(xres16 + (size_t)(row) * D + (c))))
    f32x4 xn[4]; u32x2 yn[4];
#pragma unroll
    for (int j = 0; j < 4; ++j) { const int c = 4 * F.lane + 256 * j; xn[j] = PN_LOADX(gw, j, c); yn[j] = *(const u32x2*)(y + (size_t)gw * D + c); }
    for (int m = gw; m < T; m += NGW) {
        const int b = m >> 14; const float* gate = MOD + b * ADA_W + (sub * 3 + 2) * D;
        f32x4 v[4], xc[4]; u32x2 yc[4];
#pragma unroll
        for (int j = 0; j < 4; ++j) { xc[j] = xn[j]; yc[j] = yn[j]; }
        if (m + NGW < T) {
#pragma unroll
            for (int j = 0; j < 4; ++j) { const int c = 4 * F.lane + 256 * j; xn[j] = PN_LOADX(m + NGW, j, c); yn[j] = *(const u32x2*)(y + (size_t)(m + NGW) * D + c); }
        }
#pragma unroll
        for (int j = 0; j < 4; ++j) { const int c = 4 * F.lane + 256 * j;
            const f32x4 yv = (f32x4){bflo(yc[j].x), bfhi(yc[j].x), bflo(yc[j].y), bfhi(yc[j].y)};
            v[j] = DN_ALPHA * xc[j] + (1.f + *(const f32x4*)(gate + c)) * yv; }
        ln_apply(v, g, bb, F.lane);
#pragma unroll
        for (int j = 0; j < 4; ++j) { u32x2 w; w.x = cvt_pk_bf16(v[j][0], v[j][1]); w.y = cvt_pk_bf16(v[j][2], v[j][3]); *(u32x2*)(xout + (size_t)m * D + 4 * F.lane + 256 * j) = w; }
        if (outA) mod_store(v, MOD + b * ADA_W + modA, MOD + b * ADA_W + modA + D, outA + (size_t)m * D, F.lane);
        if (outB) mod_store(v, MOD + b * ADA_W + modB, MOD + b * ADA_W + modB + D, outB + (size_t)m * D, F.lane);
        if (outQ) mod_store_q8(v, MOD + b * ADA_W + modQ, MOD + b * ADA_W + modQ + D, outQ + (size_t)m * D, rsQ + m, F.lane);
        if (outQ2) mod_store_q8(v, MOD + b * ADA_W + modQ2, MOD + b * ADA_W + modQ2 + D, outQ2 + (size_t)m * D, rsQ2 + m, F.lane);
    }
}

constexpr int KS_STRIDE = 72;
typedef short v4i16_t __attribute__((ext_vector_type(4)));
__device__ __forceinline__ void p12_attn(Frame& F) {
    LAS bf16_t* Ks = (LAS bf16_t*)F.lds;
    LAS bf16_t* Vs = Ks + 256 * KS_STRIDE;
    const bf16_t* Q2 = WSP(bf16_t, WS_Q2); const bf16_t* K2 = WSP(bf16_t, WS_K2); const bf16_t* V2 = WSP(bf16_t, WS_V2);
    bf16_t* OG = WSP(bf16_t, WS_OG); float* LSE = WSP(float, WS_LSE);
    const int lane = F.lane, w = F.wave, q16 = lane & 15, qd = lane >> 4;
    for (int unit = F.vcu; unit < BATCH * 3 * 8 * 128; unit += F.G) {
        const int pb = unit & 127, hg = (unit >> 7) & 7, gb = unit >> 10, g = gb % 3, b = gb / 3;
        const int dil = g == 0 ? 1 : (g == 1 ? 4 : 16), nb = 128 / dil, phase = pb / nb, blk = pb % nb;
        const int hcol = (g * 8 + hg) * 64;
#pragma unroll
        for (int i = 0; i < 4; ++i) {
            const int ch = F.tid + 512 * i, key = ch >> 3, c8 = (ch & 7) * 8;
            const int pos = (blk - 1) * 128 + key;
            u32x4 kv = (u32x4){0u, 0u, 0u, 0u}, vv = (u32x4){0u, 0u, 0u, 0u};
            if (pos >= 0) { const size_t row = (size_t)b * SEQ + (size_t)pos * dil + phase;
                kv = *(const u32x4*)(K2 + row * QW + hcol + c8); vv = *(const u32x4*)(V2 + row * QW + hcol + c8); }
            *(LAS u32x4*)(Ks + key * KS_STRIDE + c8) = kv;
            *(LAS u32x4*)(Vs + key * KS_STRIDE + c8) = vv;
        }
        const int qi = 16 * w + q16;
        const size_t qrow = (size_t)b * SEQ + (size_t)(blk * 128 + qi) * dil + phase;
        const bf16x8 qf0 = *(const bf16x8*)(Q2 + qrow * QW + hcol + 8 * qd), qf1 = *(const bf16x8*)(Q2 + qrow * QW + hcol + 32 + 8 * qd);
        __syncthreads();
        const int kt0 = w < 6 ? w : 6;
        f32x4 s[10];
#pragma unroll
        for (int i = 0; i < 10; ++i) {
            const LAS bf16_t* kp = Ks + (16 * (kt0 + i) + q16) * KS_STRIDE + 8 * qd;
            const bf16x8 k0 = *(const LAS bf16x8*)kp, k1 = *(const LAS bf16x8*)(kp + 32);
            f32x4 a = (f32x4){0.f, 0.f, 0.f, 0.f};
            a = __builtin_amdgcn_mfma_f32_16x16x32_bf16(k0, qf0, a, 0, 0, 0);
            a = __builtin_amdgcn_mfma_f32_16x16x32_bf16(k1, qf1, a, 0, 0, 0);
            s[i] = a;
        }
        float mx = -1e30f;
#pragma unroll
        for (int i = 0; i < 10; ++i)
#pragma unroll
            for (int r = 0; r < 4; ++r) { const int kidx = 16 * (kt0 + i) + 4 * qd + r; const bool ok = (kidx >= qi) && (kidx <= qi + 128) && (blk > 0 || kidx >= 128);
                s[i][r] = ok ? s[i][r] : -1e30f; mx = fmaxf(mx, s[i][r]); }
        mx = fmaxf(mx, __shfl_xor(mx, 16)); mx = fmaxf(mx, __shfl_xor(mx, 32));
        float l = 0.f;
#pragma unroll
        for (int i = 0; i < 10; ++i)
#pragma unroll
            for (int r = 0; r < 4; ++r) { const float p = __expf(s[i][r] - mx); s[i][r] = p; l += p; }
        l += __shfl_xor(l, 16); l += __shfl_xor(l, 32);
        f32x4 o[4];
#pragma unroll
        for (int dt = 0; dt < 4; ++dt) o[dt] = (f32x4){0.f, 0.f, 0.f, 0.f};
#pragma unroll
        for (int i = 0; i < 5; ++i) {
            union { bf16x8 v; unsigned u[4]; } pf;
            pf.u[0] = cvt_pk_bf16(s[2 * i][0], s[2 * i][1]); pf.u[1] = cvt_pk_bf16(s[2 * i][2], s[2 * i][3]);
            pf.u[2] = cvt_pk_bf16(s[2 * i + 1][0], s[2 * i + 1][1]); pf.u[3] = cvt_pk_bf16(s[2 * i + 1][2], s[2 * i + 1][3]);
#pragma unroll
            for (int dt = 0; dt < 4; ++dt) {
                const LAS bf16_t* vp = Vs + (16 * (kt0 + 2 * i) + 4 * qd + (q16 >> 2)) * KS_STRIDE + 16 * dt + 4 * (q16 & 3);
                union { bf16x8 v; s16x4 h[2]; } vf;
                vf.h[0] = __builtin_bit_cast(s16x4, __builtin_amdgcn_ds_read_tr16_b64_v4i16((LAS v4i16_t*)vp));
                vf.h[1] = __builtin_bit_cast(s16x4, __builtin_amdgcn_ds_read_tr16_b64_v4i16((LAS v4i16_t*)(vp + 16 * KS_STRIDE)));
                o[dt] = __builtin_amdgcn_mfma_f32_16x16x32_bf16(vf.v, pf.v, o[dt], 0, 0, 0);
            }
        }
        const float il = 1.f / l;
        bf16_t* op = OG + (size_t)g * T * AOUT + qrow * AOUT + hg * 64 + 4 * qd;
#pragma unroll
        for (int dt = 0; dt < 4; ++dt) { u32x2 wv; wv.x = cvt_pk_bf16(o[dt][0] * il, o[dt][1] * il); wv.y = cvt_pk_bf16(o[dt][2] * il, o[dt][3] * il); *(u32x2*)(op + 16 * dt) = wv; }
        if (qd == 0) LSE[(size_t)g * T * 8 + qrow * 8 + hg] = mx + __logf(l);
        __syncthreads();
    }
}
__device__ __forceinline__ void p13_merge(Frame& F) {
    const bf16_t* OG = WSP(bf16_t, WS_OG); const float* LSE = WSP(float, WS_LSE); bf16_t* OM = WSP(bf16_t, WS_OM);
    for (int idx = F.vcu * 512 + F.tid; idx < T * 64; idx += F.G * 512) {
        const int m = idx >> 6, hg = (idx >> 3) & 7, c8 = (idx & 7) * 8;
        const float l0 = LSE[(size_t)0 * T * 8 + m * 8 + hg], l1 = LSE[(size_t)1 * T * 8 + m * 8 + hg], l2 = LSE[(size_t)2 * T * 8 + m * 8 + hg];
        const float mx = fmaxf(l0, fmaxf(l1, l2)); float w0 = __expf(l0 - mx), w1 = __expf(l1 - mx), w2 = __expf(l2 - mx); const float inv = 1.f / (w0 + w1 + w2); w0 *= inv; w1 *= inv; w2 *= inv;
        const size_t off = (size_t)m * AOUT + hg * 64 + c8;
        const u32x4 a = *(const u32x4*)(OG + off), bq = *(const u32x4*)(OG + (size_t)T * AOUT + off), c = *(const u32x4*)(OG + (size_t)2 * T * AOUT + off);
        u32x4 o;
        o.x = cvt_pk_bf16(w0 * bflo(a.x) + w1 * bflo(bq.x) + w2 * bflo(c.x), w0 * bfhi(a.x) + w1 * bfhi(bq.x) + w2 * bfhi(c.x));
        o.y = cvt_pk_bf16(w0 * bflo(a.y) + w1 * bflo(bq.y) + w2 * bflo(c.y), w0 * bfhi(a.y) + w1 * bfhi(bq.y) + w2 * bfhi(c.y));
        o.z = cvt_pk_bf16(w0 * bflo(a.z) + w1 * bflo(bq.z) + w2 * bflo(c.z), w0 * bfhi(a.z) + w1 * bfhi(bq.z) + w2 * bfhi(c.z));
        o.w = cvt_pk_bf16(w0 * bflo(a.w) + w1 * bflo(bq.w) + w2 * bflo(c.w), w0 * bfhi(a.w) + w1 * bfhi(bq.w) + w2 * bfhi(c.w));
        *(u32x4*)(OM + off) = o;
    }
}

__device__ __forceinline__ void p15_ln_route(Frame& F) {
    LAS float* RT = (LAS float*)F.lds;
    LAS int* lcnt = (LAS int*)(F.lds + 32768);
    LAS int* lbase = lcnt + 8;
    LAS int* lte = lcnt + 16;
    LAS int* ltr = lte + 256;
    LAS float* ltw = (LAS float*)(ltr + 256);
    const float* MOD = WSP(float, WS_MOD); const float* g = F.in[4] + 2 * D; const float* bb = F.in[5] + 2 * D;
    const bf16_t* X2 = WSP(bf16_t, WS_X2); const bf16_t* Y3 = WSP(bf16_t, WS_Y3); float* X3 = F.out; unsigned char* H4 = WSP(unsigned char, WS_H4); float* RSH4 = (float*)(F.ws + WS_ROUTE + RT_RSH4);
    int* TOKE = (int*)(F.ws + WS_ROUTE + RT_TOKE); int* TOKR = (int*)(F.ws + WS_ROUTE + RT_TOKR); float* TOKW = (float*)(F.ws + WS_ROUTE + RT_TOKW);
    int* ROWTOK = (int*)(F.ws + WS_ROUTE + RT_ROWTOK);
    for (int i = F.tid; i < D * 8; i += 512) RT[i] = F.in[27][i];
    for (int i = F.vcu * 512 + F.tid; i < RMAX; i += F.G * 512) ROWTOK[i] = T;
    if (F.vcu == 0) { for (int i = F.tid; i < D / 4; i += 512) ((unsigned*)(H4 + (size_t)T * D))[i] = 0u; if (F.tid == 0) RSH4[T] = 0.f; }
    __syncthreads();
    for (int chunk = F.vcu; chunk < T / 128; chunk += F.G) {
        if (F.tid < 8) lcnt[F.tid] = 0;
        __syncthreads();
        f32x4 xn[4]; u32x2 yn[4];
        for (int i = 0; i < 16; ++i) {
            const int lr = F.wave * 16 + i, m = chunk * 128 + lr, b = m >> 14;
            const float* gate = MOD + b * ADA_W + (2 * 3 + 2) * D;
            f32x4 v[4], xc[4]; u32x2 yc[4];
            if (i == 0) {
#pragma unroll
                for (int j = 0; j < 4; ++j) { const int c = 4 * F.lane + 256 * j; xn[j] = unpk4(*(const u32x2*)(X2 + (size_t)m * D + c)); yn[j] = *(const u32x2*)(Y3 + (size_t)m * D + c); }
            }
#pragma unroll
            for (int j = 0; j < 4; ++j) { xc[j] = xn[j]; yc[j] = yn[j]; }
            if (i < 15) {
#pragma unroll
                for (int j = 0; j < 4; ++j) { const int c = 4 * F.lane + 256 * j; xn[j] = unpk4(*(const u32x2*)(X2 + (size_t)(m + 1) * D + c)); yn[j] = *(const u32x2*)(Y3 + (size_t)(m + 1) * D + c); }
            }
#pragma unroll
            for (int j = 0; j < 4; ++j) { const int c = 4 * F.lane + 256 * j;
                const f32x4 yv = (f32x4){bflo(yc[j].x), bfhi(yc[j].x), bflo(yc[j].y), bfhi(yc[j].y)};
                v[j] = DN_ALPHA * xc[j] + (1.f + *(const f32x4*)(gate + c)) * yv; }
            ln_apply(v, g, bb, F.lane);
#pragma unroll
            for (int j = 0; j < 4; ++j) *(f32x4*)(X3 + (size_t)m * D + 4 * F.lane + 256 * j) = v[j];
            const float* shift = MOD + b * ADA_W + (3 * 3 + 0) * D; const float* scale = MOD + b * ADA_W + (3 * 3 + 1) * D;
            float lg[8];
#pragma unroll
            for (int e = 0; e < 8; ++e) lg[e] = 0.f;
            f32x4 hq[4]; float mx = 0.f;
#pragma unroll
            for (int j = 0; j < 4; ++j) { const int c = 4 * F.lane + 256 * j; const f32x4 hh = v[j] * (1.f + *(const f32x4*)(scale + c)) + *(const f32x4*)(shift + c);
                hq[j] = hh; mx = fmaxf(mx, fmaxf(fmaxf(fabsf(hh[0]), fabsf(hh[1])), fmaxf(fabsf(hh[2]), fabsf(hh[3]))));
#pragma unroll
                for (int q = 0; q < 4; ++q) { const f32x4 r0 = *(const LAS f32x4*)(RT + (c + q) * 8), r1 = *(const LAS f32x4*)(RT + (c + q) * 8 + 4);
                    lg[0] += hh[q] * r0[0]; lg[1] += hh[q] * r0[1]; lg[2] += hh[q] * r0[2]; lg[3] += hh[q] * r0[3];
                    lg[4] += hh[q] * r1[0]; lg[5] += hh[q] * r1[1]; lg[6] += hh[q] * r1[2]; lg[7] += hh[q] * r1[3]; } }
#pragma unroll
            for (int of = 1; of < 64; of <<= 1) mx = fmaxf(mx, __shfl_xor(mx, of));
            mx = fmaxf(mx, 1e-20f); { const float inv = 127.f / mx;
#pragma unroll
                for (int j = 0; j < 4; ++j) *(unsigned*)(H4 + (size_t)m * D + 4 * F.lane + 256 * j) = pk4_i8(hq[j][0] * inv, hq[j][1] * inv, hq[j][2] * inv, hq[j][3] * inv);
                if (F.lane == 0) RSH4[m] = mx * (1.f / 127.f); }
#pragma unroll
            for (int e = 0; e < 8; ++e) lg[e] = wsum(lg[e]);
            int e1 = 0; float m1 = lg[0];
#pragma unroll
            for (int e = 1; e < 8; ++e) if (lg[e] > m1) { m1 = lg[e]; e1 = e; }
            int e2 = -1; float m2 = -3.0e38f;
#pragma unroll
            for (int e = 0; e < 8; ++e) if (e != e1 && lg[e] > m2) { m2 = lg[e]; e2 = e; }
            if (e2 < 0) { e2 = (e1 + 1) & 7; m2 = m1; }
            if (F.lane == 0) {
                const float w1 = 1.f / (1.f + __expf(m2 - m1));
                lte[lr * 2] = e1; lte[lr * 2 + 1] = e2; ltw[lr * 2] = w1; ltw[lr * 2 + 1] = 1.f - w1;
                ltr[lr * 2] = atomicAdd((int*)&lcnt[e1], 1); ltr[lr * 2 + 1] = atomicAdd((int*)&lcnt[e2], 1);
            }
        }
        __syncthreads();
        if (F.tid < 8) lbase[F.tid] = (int)__hip_atomic_fetch_add((unsigned*)(F.ctl + CW_CNT + F.tid), (unsigned)lcnt[F.tid], RLX_AGENT);
        __syncthreads();
        if (F.tid < 256) { const int m = chunk * 128 + (F.tid >> 1), s = F.tid & 1; const int e = lte[F.tid];
            TOKE[m * 2 + s] = e; TOKR[m * 2 + s] = lbase[e] + ltr[F.tid]; TOKW[m * 2 + s] = ltw[F.tid]; }
        __syncthreads();
    }
}
__device__ __forceinline__ void p16_place(Frame& F) {
    int* TOKE = (int*)(F.ws + WS_ROUTE + RT_TOKE); int* TOKR = (int*)(F.ws + WS_ROUTE + RT_TOKR);
    int* ROWTOK = (int*)(F.ws + WS_ROUTE + RT_ROWTOK); int* BLKEXP = (int*)(F.ws + WS_ROUTE + RT_BLKEXP);
    int pstart[8], pend[8]; int acc = 0;
#pragma unroll
    for (int e = 0; e < 8; ++e) { const int c = (int)__hip_atomic_load((unsigned*)(F.ctl + CW_CNT + e), RLX_AGENT); pstart[e] = acc; acc += (c + 255) / 256 * 256; pend[e] = acc; }
    for (int idx = F.vcu * 512 + F.tid; idx < T * 2; idx += F.G * 512) {
        const int e = TOKE[idx]; int ps = 0;
#pragma unroll
        for (int j = 0; j < 8; ++j) ps = (e == j) ? pstart[j] : ps;
        const int dest = ps + TOKR[idx]; ROWTOK[dest] = idx >> 1; TOKR[idx] = dest;
    }
    if (F.vcu == 0) {
        for (int blk = F.tid; blk < NBLKMAX; blk += 512) { int e = 0;
#pragma unroll
            for (int j = 0; j < 8; ++j) e += (pend[j] <= blk * 256) ? 1 : 0;
            BLKEXP[blk] = e < 8 ? e : 7; }
        if (F.tid == 0) __hip_atomic_store((unsigned*)(F.ctl + CW_NBLK), (unsigned)(acc / 256), RLX_AGENT);
    }
}
__device__ __forceinline__ void p19_final(Frame& F) {
    const int gw = F.vcu * NWAVES + F.wave, NGW = F.G * NWAVES;
    const float* MOD = WSP(float, WS_MOD); const float* g = F.in[4] + 3 * D; const float* bb = F.in[5] + 3 * D;
    const bf16_t* YB = WSP(bf16_t, WS_YB); const int* TOKR = (const int*)(F.ws + WS_ROUTE + RT_TOKR); const float* TOKW = (const float*)(F.ws + WS_ROUTE + RT_TOKW);
    float* X = F.out;
    int di0 = TOKR[gw * 2], di1 = TOKR[gw * 2 + 1]; float wi0 = TOKW[gw * 2], wi1 = TOKW[gw * 2 + 1];
    f32x4 xn[4]; u32x2 an[4], qn[4]; float w0n = wi0, w1n = wi1;
#pragma unroll
    for (int j = 0; j < 4; ++j) { const int c = 4 * F.lane + 256 * j; xn[j] = *(const f32x4*)(X + (size_t)gw * D + c); an[j] = *(const u32x2*)(YB + (size_t)di0 * D + c); qn[j] = *(const u32x2*)(YB + (size_t)di1 * D + c); }
    if (gw + NGW < T) { di0 = TOKR[(gw + NGW) * 2]; di1 = TOKR[(gw + NGW) * 2 + 1]; wi0 = TOKW[(gw + NGW) * 2]; wi1 = TOKW[(gw + NGW) * 2 + 1]; }
    for (int m = gw; m < T; m += NGW) {
        const int b = m >> 14; const float* gate = MOD + b * ADA_W + (3 * 3 + 2) * D;
        f32x4 v[4], xc[4]; u32x2 ac[4], qc[4]; const float w0 = w0n, w1 = w1n;
#pragma unroll
        for (int j = 0; j < 4; ++j) { xc[j] = xn[j]; ac[j] = an[j]; qc[j] = qn[j]; }
        if (m + NGW < T) {
            const int mn = m + NGW; w0n = wi0; w1n = wi1;
#pragma unroll
            for (int j = 0; j < 4; ++j) { const int c = 4 * F.lane + 256 * j; xn[j] = *(const f32x4*)(X + (size_t)mn * D + c); an[j] = *(const u32x2*)(YB + (size_t)di0 * D + c); qn[j] = *(const u32x2*)(YB + (size_t)di1 * D + c); }
            if (mn + NGW < T) { di0 = TOKR[(mn + NGW) * 2]; di1 = TOKR[(mn + NGW) * 2 + 1]; wi0 = TOKW[(mn + NGW) * 2]; wi1 = TOKW[(mn + NGW) * 2 + 1]; }
        }
#pragma unroll
        for (int j = 0; j < 4; ++j) { const int c = 4 * F.lane + 256 * j;
            const f32x4 y = (f32x4){w0 * bflo(ac[j].x) + w1 * bflo(qc[j].x), w0 * bfhi(ac[j].x) + w1 * bfhi(qc[j].x), w0 * bflo(ac[j].y) + w1 * bflo(qc[j].y), w0 * bfhi(ac[j].y) + w1 * bfhi(qc[j].y)};
            v[j] = DN_ALPHA * xc[j] + (1.f + *(const f32x4*)(gate + c)) * y; }
        ln_apply(v, g, bb, F.lane);
#pragma unroll
        for (int j = 0; j < 4; ++j) *(f32x4*)(X + (size_t)m * D + 4 * F.lane + 256 * j) = v[j];
    }
}

struct Args { const float* in[30]; float* out; unsigned char* ws; int ph_lo, ph_hi, li, pad; };
__global__ void __launch_bounds__(NWAVES * 64, 2) fwd(Args args) {
    extern __shared__ __attribute__((aligned(16))) unsigned char lds[];
    Frame F;
    F.lds = (LAS unsigned char*)lds;
    F.MISC = (volatile LAS unsigned*)(F.lds + MISC_OFF);
    F.tid = threadIdx.x; F.lane = F.tid & 63; F.wave = __builtin_amdgcn_readfirstlane(F.tid >> 6);
    F.G = gridDim.x; { const int bx = blockIdx.x; F.vcu = (F.G % 8 == 0) ? (bx % 8) * (F.G / 8) + bx / 8 : bx; }
    F.ws = args.ws; F.ctl = (gu32*)(args.ws + WS_CTL); F.out = args.out;
    F.in = args.in;
    for (int u = F.tid; u < (LDS_BYTES - LDSCTL_OFF) / 4; u += NWAVES * 64) ((LAS unsigned*)(F.lds + LDSCTL_OFF))[u] = 0u;
    __syncthreads();
    XcdBarrier bar; bar.bar = (unsigned*)(F.ctl + CW_BAR); bar.x = 0; bar.st = nullptr;
    if (N_LAUNCHES != NPH) bar = xcd_barrier_post((unsigned*)(F.ctl + CW_BAR) + args.li * XCD_BAR_WORDS, F.MISC + 8);
#define GRID_BAR() do { if (N_LAUNCHES != NPH) xcd_barrier(bar); } while (0)
    const int lo = args.ph_lo, hi = args.ph_hi;
#define IN(k) (lo <= (k) && (k) < hi)
#define BOTH(k) (IN(k) && IN((k) + 1))
    using namespace pg8;
    const int cid = (int)blockIdx.x;

    if (IN(0)) { p0_prologue(F); if (BOTH(0)) GRID_BAR(); }
    if (IN(1)) { p1_lerp(F); if (BOTH(1)) GRID_BAR(); }
    if (IN(2)) {
        Gemm g{(const bf16_t*)(WSP(unsigned char, WS_A6Q) + (size_t)3 * T * D), WSP(bf16_t, WS_WL1), D / 2, D / 2, (size_t)T * D, (size_t)256 * D, nullptr, nullptr, 0};
        StaticOrder S; S.init(T / 256, 1, 3, F.G, cid);
        EpiActQ<1, 0, 2> E{WSP(bf16_t, WS_L1), 256, (size_t)T * 256, WSP(float, WS_RSA) + (size_t)3 * T, (size_t)T, QW_STEP};
        gemm_phase<EpiActQ<1, 0, 2>, StaticOrder, true, 1>(F.lds, g, S, E);
        if (BOTH(2)) GRID_BAR();
    }
    if (IN(3)) {
        { Gemm g{WSP(bf16_t, WS_A6Q), WSP(bf16_t, WS_WRKV), D / 2, D / 2, (size_t)T * D, (size_t)D * D, nullptr, nullptr, 0};
          StaticOrder S; S.init(T / 256, D / 256, 3, F.G, cid);
          EpiBf16Q E{WSP(bf16_t, WS_RB), D, (size_t)T * D, WSP(float, WS_RSA), (size_t)T, QW_STEP};
          gemm_phase<EpiBf16Q, StaticOrder, true, 1>(F.lds, g, S, E); }
        { Gemm g{WSP(bf16_t, WS_L1), WSP(bf16_t, WS_WL2), 256, 256, (size_t)T * 256 * 2, (size_t)D * 256 * 2, nullptr, nullptr, 0};
          StaticOrder S; S.init(T / 256, D / 256, 3, F.G, cid);
          EpiLora2 E{F.out, WSP(bf16_t, WS_AS), WSP(bf16_t, WS_G), F.in[8], F.in[11]};
          gemm_phase<EpiLora2, StaticOrder, true>(F.lds, g, S, E); }
        if (BOTH(3)) GRID_BAR();
    }
    if (IN(4)) { p4a_chunk(F); GRID_BAR(); p4b_chain(F); if (BOTH(4)) GRID_BAR(); }
    if (IN(5)) { p5_chunk_out(F); if (BOTH(5)) GRID_BAR(); }
    if (IN(6)) {
        Gemm g{WSP(bf16_t, WS_YG), WSP(bf16_t, WS_WOUT), D, D, 0, 0, nullptr, nullptr, 0};
        StaticOrder S; S.init(T / 256, D / 256, 1, F.G, cid);
        EpiBf16Z<0, 0, 0> E{WSP(bf16_t, WS_Y1), D, 0};
        gemm_phase<EpiBf16Z<0, 0, 0>, StaticOrder, true>(F.lds, g, S, E);
        if (BOTH(6)) GRID_BAR();
    }
    if (IN(7)) { p_postnorm(F, F.in[0], nullptr, WSP(bf16_t, WS_Y1), WSP(bf16_t, WS_X1), 0, 0, nullptr, 0, nullptr, (1 * 3 + 0) * D, WSP(unsigned char, WS_H2), WSP(float, WS_RSH2)); if (BOTH(7)) GRID_BAR(); }
    if (IN(8)) {
        Gemm g{WSP(bf16_t, WS_H2), WSP(bf16_t, WS_WFGU), D / 2, D / 2, 0, 0, nullptr, nullptr, 0};
        StaticOrder S; S.init(T / 256, 2 * DFF / 256, 1, F.G, cid);
        EpiSwigluQ E{WSP(bf16_t, WS_ACT), DFF, WSP(float, WS_RSH2), nullptr, QW_STEP};
        gemm_phase<EpiSwigluQ, StaticOrder, true, 1>(F.lds, g, S, E);
        if (BOTH(8)) GRID_BAR();
    }
    if (IN(9)) {
        Gemm g{WSP(bf16_t, WS_ACT), WSP(bf16_t, WS_WFDN), DFF, DFF, 0, 0, nullptr, nullptr, 0};
        StaticOrder S; S.init(T / 256, D / 256, 1, F.G, cid);
        EpiBf16Z<0, 0, 0> E{WSP(bf16_t, WS_Y2), D, 0};
        gemm_phase<EpiBf16Z<0, 0, 0>, StaticOrder, true>(F.lds, g, S, E);
        if (BOTH(9)) GRID_BAR();
    }
    if (IN(10)) { p_postnorm(F, nullptr, WSP(bf16_t, WS_X1), WSP(bf16_t, WS_Y2), WSP(bf16_t, WS_X2), 1, 0, nullptr, 0, nullptr, 12 * D, WSP(unsigned char, WS_HKV), WSP(float, WS_RSKV), (2 * 3 + 0) * D, WSP(unsigned char, WS_H3), WSP(float, WS_RSKV) + T); if (BOTH(10)) GRID_BAR(); }
    if (IN(11)) {
        const float* cs = WSP(float, WS_ROPE); const float* sn = cs + SEQ * 32;
        { Gemm g{WSP(bf16_t, WS_HKV), WSP(bf16_t, WS_WKV), D / 2, D / 2, 0, 0, nullptr, nullptr, 0};
          StaticOrder S; S.init(T / 256, 2 * QW / 256, 1, F.G, cid);
          EpiRope E{WSP(bf16_t, WS_K2), WSP(bf16_t, WS_V2), QW, cs, sn, 1.f, WSP(float, WS_RSKV), QW_STEP};
          gemm_phase<EpiRope, StaticOrder, true, 1>(F.lds, g, S, E); }
        { Gemm g{WSP(bf16_t, WS_H3), WSP(bf16_t, WS_WQ), D / 2, D / 2, 0, 0, nullptr, nullptr, 0};
          StaticOrder S; S.init(T / 256, QW / 256, 1, F.G, cid);
          EpiRope E{WSP(bf16_t, WS_Q2), WSP(bf16_t, WS_Q2), QW, cs, sn, 0.125f, WSP(float, WS_RSKV) + T, QW_STEP};
          gemm_phase<EpiRope, StaticOrder, true, 1>(F.lds, g, S, E); }
        if (BOTH(11)) GRID_BAR();
    }
    if (IN(12)) { p12_attn(F); if (BOTH(12)) GRID_BAR(); }
    if (IN(13)) { p13_merge(F); if (BOTH(13)) GRID_BAR(); }
    if (IN(14)) {
        Gemm g{WSP(bf16_t, WS_OM), WSP(bf16_t, WS_WO), AOUT, AOUT, 0, 0, nullptr, nullptr, 0};
        StaticOrder S; S.init(T / 256, D / 256, 1, F.G, cid);
        EpiBf16Z<0, 0, 0> E{WSP(bf16_t, WS_Y3), D, 0};
        gemm_phase<EpiBf16Z<0, 0, 0>, StaticOrder, true>(F.lds, g, S, E);
        if (BOTH(14)) GRID_BAR();
    }
    if (IN(15)) { p15_ln_route(F); if (BOTH(15)) GRID_BAR(); }
    if (IN(16)) { p16_place(F); if (BOTH(16)) GRID_BAR(); }
    if (IN(17)) {
        const int nblk = (int)__hip_atomic_load((unsigned*)(F.ctl + CW_NBLK), RLX_AGENT);
        Gemm g{WSP(bf16_t, WS_H4), WSP(bf16_t, WS_WMGU), D / 2, D / 2, 0, 0, (const int*)(F.ws + WS_ROUTE + RT_ROWTOK), (const int*)(F.ws + WS_ROUTE + RT_BLKEXP), (size_t)2 * DFE * D};
        StaticOrder S; S.init(nblk, 2 * DFE / 256, 1, F.G, cid);
        EpiSwigluQ E{WSP(bf16_t, WS_ACT2), DFE, (const float*)(F.ws + WS_ROUTE + RT_RSH4), (const int*)(F.ws + WS_ROUTE + RT_ROWTOK), QW_STEP};
        gemm_phase<EpiSwigluQ, StaticOrder, true, 1>(F.lds, g, S, E);
        if (BOTH(17)) GRID_BAR();
    }
    if (IN(18)) {
        const int nblk = (int)__hip_atomic_load((unsigned*)(F.ctl + CW_NBLK), RLX_AGENT);
        Gemm g{WSP(bf16_t, WS_ACT2), WSP(bf16_t, WS_WMDN), DFE, DFE, 0, 0, nullptr, (const int*)(F.ws + WS_ROUTE + RT_BLKEXP), (size_t)D * DFE * 2};
        StaticOrder S; S.init(nblk, D / 256, 1, F.G, cid);
        EpiBf16Z<0, 0, 0> E{WSP(bf16_t, WS_YB), D, 0};
        gemm_phase<EpiBf16Z<0, 0, 0>, StaticOrder, true>(F.lds, g, S, E);
        if (BOTH(18)) GRID_BAR();
    }
    if (IN(19)) { p19_final(F); }
#undef IN
#undef BOTH
}

extern "C" void kernel_launch(void* const* d_in, const int* in_sizes, int n_in, void* d_out, int out_size, void* d_ws, size_t ws_size, hipStream_t stream) {
    static int grid = 0;
    if (grid == 0) {
        if (n_in != 30 || in_sizes[0] != T * D || out_size != T * D || ws_size < WS_END) { fprintf(stderr, "kernel_launch: unexpected shapes / workspace (%d inputs, ws %zu)\n", n_in, ws_size); grid = -1; return; }
        int dev = 0, cus = 0, per_cu = 0;
        if (hipGetDevice(&dev) != hipSuccess || hipDeviceGetAttribute(&cus, hipDeviceAttributeMultiprocessorCount, dev) != hipSuccess) { grid = -1; return; }
        if (hipFuncSetAttribute((const void*)fwd, hipFuncAttributeMaxDynamicSharedMemorySize, LDS_BYTES) != hipSuccess) { fprintf(stderr, "kernel_launch: hipFuncSetAttribute failed\n"); grid = -1; return; }
        if (hipOccupancyMaxActiveBlocksPerMultiprocessor(&per_cu, (const void*)fwd, NWAVES * 64, LDS_BYTES) != hipSuccess || per_cu < 1)
            fprintf(stderr, "kernel_launch: occupancy query reports %d workgroups per CU\n", per_cu);
        (void)hipGetLastError();
        grid = cus;
    }
    if (grid < 0) return;
    if (hipMemsetAsync((char*)d_ws + WS_CTL, 0, CTL_ZERO_BYTES, stream) != hipSuccess) return;
    Args a{};
    for (int i = 0; i < 30; ++i) a.in[i] = (const float*)d_in[i];
    a.out = (float*)d_out; a.ws = (unsigned char*)d_ws;
    for (int li = 0; li < N_LAUNCHES; ++li) {
        a.ph_lo = (N_LAUNCHES == NPH) ? li : 0; a.ph_hi = (N_LAUNCHES == NPH) ? li + 1 : NPH; a.li = (N_LAUNCHES == NPH) ? 0 : li;
        hipLaunchKernelGGL(fwd, dim3(grid), dim3(NWAVES * 64), LDS_BYTES, stream, a);
        if (hipPeekAtLastError() != hipSuccess) { fprintf(stderr, "kernel_launch: launch %d failed\n", li); break; }
    }
}
```
